# Optimizing an MI355X kernel written in HIP

```python
import math
import jax
import jax.numpy as jnp
from jax import lax
import numpy as np

D_MODEL = 4096
BATCH = 2
SEQ = 4096
DEPTH = 2

HEAD_DIM = 128
D_MIX = D_MODEL
DN_WIDTH = 3 * D_MIX // 8
LRU_WIDTH = 3 * D_MIX // 8
SG_WIDTH = D_MIX - DN_WIDTH - LRU_WIDTH
DN_HEADS = DN_WIDTH // HEAD_DIM
LRU_BLOCKS = LRU_WIDTH // HEAD_DIM
SG_GROUPS = SG_WIDTH // HEAD_DIM
DN_CHUNK = 64
SG_CHUNK = 128
SHORT_CONV = 4
FFN_CONV = 3
D_FF = ((8 * D_MODEL // 3 + 255) // 256) * 256
LRU_C = 8.0
EPS = 1e-6
IN_SIZES = (DN_WIDTH, DN_WIDTH, DN_WIDTH, DN_WIDTH, DN_HEADS, DN_HEADS,
            LRU_WIDTH, LRU_WIDTH, SG_WIDTH, SG_WIDTH)
D_IN = sum(IN_SIZES)

kernel_name = "hybrid_deltanet_rglru_sgmlp_block"


def rms_norm(x, w):
    xf = x.astype(jnp.float32)
    y = xf * lax.rsqrt(jnp.mean(xf * xf, axis=-1, keepdims=True) + EPS)
    return (y * w.astype(jnp.float32)).astype(x.dtype)


def group_rms_norm(x, w, groups):
    b, s, c = x.shape
    xg = x.astype(jnp.float32).reshape(b, s, groups, c // groups)
    y = xg * lax.rsqrt(jnp.mean(xg * xg, axis=-1, keepdims=True) + EPS)
    return y.reshape(b, s, c) * w.astype(jnp.float32)


def causal_dwconv(x, w):
    k_w = w.shape[0]
    s = x.shape[1]
    xp = jnp.pad(x, ((0, 0), (k_w - 1, 0), (0, 0)))
    return sum(xp[:, j:j + s] * w[j] for j in range(k_w))


def chunk_heads(t):
    b, s, h = t.shape[:3]
    t = t.reshape(b, s // DN_CHUNK, DN_CHUNK, h, *t.shape[3:])
    return jnp.moveaxis(t, 3, 1)


def gated_delta_rule(q, k, v, g, beta):
    b, s, h, d = q.shape
    q, k, v = chunk_heads(q) * d ** -0.5, chunk_heads(k), chunk_heads(v)
    g, beta = chunk_heads(g), chunk_heads(beta)
    gc = jnp.cumsum(g, axis=-1)
    causal = jnp.tril(jnp.ones((DN_CHUNK, DN_CHUNK), dtype=bool))
    strict = jnp.tril(jnp.ones((DN_CHUNK, DN_CHUNK), dtype=bool), k=-1)
    decay = jnp.exp(jnp.where(causal, gc[..., :, None] - gc[..., None, :], -jnp.inf))
    k_beta = k * beta[..., None]
    a_low = jnp.where(strict, jnp.einsum('bhnid,bhnjd->bhnij', k_beta, k) * decay, 0.0)
    rhs = jnp.concatenate([v * beta[..., None], k_beta * jnp.exp(gc)[..., None]], axis=-1)
    sol = lax.linalg.triangular_solve(a_low, rhs, left_side=True, lower=True, unit_diagonal=True)
    u, w = sol[..., :d], sol[..., d:]
    attn = jnp.einsum('bhnid,bhnjd->bhnij', q, k) * decay
    q_dec = q * jnp.exp(gc)[..., None]
    k_dec = k * jnp.exp(gc[..., -1:] - gc)[..., None]
    chunk_decay = jnp.exp(gc[..., -1])

    def step(state, inp):
        u_n, w_n, q_n, k_n, a_n, d_n = inp
        v_new = u_n - jnp.einsum('bhcd,bhde->bhce', w_n, state)
        o_n = (jnp.einsum('bhcd,bhde->bhce', q_n, state)
               + jnp.einsum('bhcj,bhje->bhce', a_n, v_new))
        state = state * d_n[..., None, None] + jnp.einsum('bhcd,bhce->bhde', k_n, v_new)
        return state, o_n

    xs = tuple(jnp.moveaxis(t, 2, 0) for t in (u, w, q_dec, k_dec, attn, chunk_decay))
    state0 = jnp.zeros((b, h, d, d), jnp.float32)
    _, o = lax.scan(step, state0, xs)
    return jnp.transpose(o, (1, 0, 3, 2, 4)).reshape(b, s, h, d)


def deltanet_group(q, k, v, z, b_raw, a_raw, conv_w, a_log, dt_bias, norm_w):
    bsz, s = q.shape[:2]
    qkv = jax.nn.silu(causal_dwconv(jnp.concatenate([q, k, v], axis=-1), conv_w))
    qkv = qkv.astype(jnp.float32).reshape(bsz, s, 3, DN_HEADS, HEAD_DIM)
    q, k, v = qkv[:, :, 0], qkv[:, :, 1], qkv[:, :, 2]
    q = q * lax.rsqrt(jnp.sum(q * q, axis=-1, keepdims=True) + EPS)
    k = k * lax.rsqrt(jnp.sum(k * k, axis=-1, keepdims=True) + EPS)
    beta = jax.nn.sigmoid(b_raw.astype(jnp.float32))
    g = -jnp.exp(a_log.astype(jnp.float32)) * jax.nn.softplus(
        a_raw.astype(jnp.float32) + dt_bias.astype(jnp.float32))
    o = gated_delta_rule(q, k, v, g, beta)
    zg = jax.nn.silu(z.astype(jnp.float32).reshape(bsz, s, DN_HEADS, HEAD_DIM))
    o = o * lax.rsqrt(jnp.mean(o * o, axis=-1, keepdims=True) + EPS) * norm_w.astype(jnp.float32) * zg
    return o.reshape(bsz, s, DN_WIDTH)


def _linear_combine(left, right):
    a_l, b_l = left
    a_r, b_r = right
    return a_l * a_r, a_r * b_l + b_r


def rglru_group(xb, gate, conv_w, conv_b, w_a, b_a, w_x, b_x, lam, norm_w):
    bsz, s, _ = xb.shape
    xc = (causal_dwconv(xb, conv_w) + conv_b).astype(jnp.float32)
    xh = xc.reshape(bsz, s, LRU_BLOCKS, HEAD_DIM)
    r = jax.nn.sigmoid(jnp.einsum('bsgi,gij->bsgj', xh, w_a.astype(jnp.float32)).reshape(bsz, s, LRU_WIDTH)
                       + b_a.astype(jnp.float32))
    i_g = jax.nn.sigmoid(jnp.einsum('bsgi,gij->bsgj', xh, w_x.astype(jnp.float32)).reshape(bsz, s, LRU_WIDTH)
                         + b_x.astype(jnp.float32))
    log_a = -LRU_C * r * jax.nn.softplus(-lam.astype(jnp.float32))
    a = jnp.exp(log_a)
    inp = jnp.sqrt(-jnp.expm1(2.0 * log_a)) * (i_g * xc)
    _, h = lax.associative_scan(_linear_combine, (a, inp), axis=1)
    y = h * jax.nn.gelu(gate.astype(jnp.float32))
    return group_rms_norm(y, norm_w, LRU_BLOCKS)


def spatial_gating_group(u, v, ln_w, ln_b, w_s, b_s, norm_w):
    bsz, s, _ = u.shape
    u = jax.nn.gelu(u.astype(jnp.float32))
    v = jax.nn.gelu(v.astype(jnp.float32))
    mu = jnp.mean(v, axis=-1, keepdims=True)
    var = jnp.mean(jnp.square(v - mu), axis=-1, keepdims=True)
    v = (v - mu) * lax.rsqrt(var + EPS) * ln_w.astype(jnp.float32) + ln_b.astype(jnp.float32)
    v = v.reshape(bsz, s // SG_CHUNK, SG_CHUNK, SG_GROUPS, HEAD_DIM)
    w_causal = jnp.tril(w_s.astype(jnp.float32))
    z = jnp.einsum('gts,bnsgc->bntgc', w_causal, v) + b_s.astype(jnp.float32).T[:, :, None]
    y = u * z.reshape(bsz, s, SG_WIDTH)
    return group_rms_norm(y, norm_w, SG_GROUPS)


def setup_inputs(seed: int = 0) -> dict:
    key = jax.random.key(seed)
    ks = jax.random.split(key, 27)
    L = DEPTH

    def nrm(k, shape, scale):
        return jax.random.normal(k, shape, jnp.float32) * scale

    def gain(k, shape):
        return 1.0 + nrm(k, shape, 0.02)

    dt = jnp.exp(jax.random.uniform(ks[5], (L, DN_HEADS), jnp.float32, math.log(1e-3), math.log(1e-1)))
    a_target = jax.random.uniform(ks[13], (L, LRU_WIDTH), jnp.float32, 0.9, 0.999)
    sig = a_target ** (1.0 / LRU_C)
    return {
        "x": nrm(ks[0], (BATCH, SEQ, D_MODEL), 1.0),
        "norm_mix": gain(ks[1], (L, D_MODEL)),
        "w_in": nrm(ks[2], (L, D_MODEL, D_IN), D_MODEL ** -0.5),
        "dn_conv_w": nrm(ks[3], (L, SHORT_CONV, 3 * DN_WIDTH), SHORT_CONV ** -0.5),
        "dn_a_log": jnp.log(jax.random.uniform(ks[4], (L, DN_HEADS), jnp.float32, 1.0, 16.0)),
        "dn_dt_bias": dt + jnp.log(-jnp.expm1(-dt)),
        "dn_norm_w": gain(ks[6], (L, HEAD_DIM)),
        "lru_conv_w": nrm(ks[7], (L, SHORT_CONV, LRU_WIDTH), SHORT_CONV ** -0.5),
        "lru_conv_b": nrm(ks[8], (L, LRU_WIDTH), 0.02),
        "lru_w_a": nrm(ks[9], (L, LRU_BLOCKS, HEAD_DIM, HEAD_DIM), HEAD_DIM ** -0.5),
        "lru_b_a": nrm(ks[10], (L, LRU_WIDTH), 0.02),
        "lru_w_x": nrm(ks[11], (L, LRU_BLOCKS, HEAD_DIM, HEAD_DIM), HEAD_DIM ** -0.5),
        "lru_b_x": nrm(ks[12], (L, LRU_WIDTH), 0.02),
        "lru_lambda": jnp.log(sig) - jnp.log1p(-sig),
        "lru_norm_w": gain(ks[14], (L, LRU_WIDTH)),
        "sg_ln_w": gain(ks[15], (L, SG_WIDTH)),
        "sg_ln_b": nrm(ks[16], (L, SG_WIDTH), 0.02),
        "sg_w_s": nrm(ks[17], (L, SG_GROUPS, SG_CHUNK, SG_CHUNK), SG_CHUNK ** -0.5),
        "sg_b_s": gain(ks[18], (L, SG_GROUPS, SG_CHUNK)),
        "sg_norm_w": gain(ks[19], (L, SG_WIDTH)),
        "w_out": nrm(ks[20], (L, D_MIX, D_MODEL), D_MIX ** -0.5),
        "norm_ffn": gain(ks[21], (L, D_MODEL)),
        "w_up": nrm(ks[22], (L, D_MODEL, 2 * D_FF), D_MODEL ** -0.5),
        "ffn_conv_w": nrm(ks[23], (L, FFN_CONV, 2 * D_FF), FFN_CONV ** -0.5),
        "ffn_conv_b": nrm(ks[24], (L, 2 * D_FF), 0.02),
        "w_down": nrm(ks[25], (L, D_FF, D_MODEL), D_FF ** -0.5),
        "norm_final": gain(ks[26], (D_MODEL,)),
    }


def reference(x, norm_mix, w_in, dn_conv_w, dn_a_log, dn_dt_bias, dn_norm_w,
              lru_conv_w, lru_conv_b, lru_w_a, lru_b_a, lru_w_x, lru_b_x, lru_lambda, lru_norm_w,
              sg_ln_w, sg_ln_b, sg_w_s, sg_b_s, sg_norm_w, w_out,
              norm_ffn, w_up, ffn_conv_w, ffn_conv_b, w_down, norm_final):
    split_idx = [int(i) for i in np.cumsum(IN_SIZES)[:-1]]
    for l in range(DEPTH):
        h = rms_norm(x, norm_mix[l])
        proj = h @ w_in[l]
        q, k, v, z, b_raw, a_raw, lx, lg, su, sv = jnp.split(proj, split_idx, axis=-1)
        y_a = deltanet_group(q, k, v, z, b_raw, a_raw, dn_conv_w[l], dn_a_log[l], dn_dt_bias[l], dn_norm_w[l])
        y_b = rglru_group(lx, lg, lru_conv_w[l], lru_conv_b[l], lru_w_a[l], lru_b_a[l],
                          lru_w_x[l], lru_b_x[l], lru_lambda[l], lru_norm_w[l])
        y_c = spatial_gating_group(su, sv, sg_ln_w[l], sg_ln_b[l], sg_w_s[l], sg_b_s[l], sg_norm_w[l])
        mix = jnp.concatenate([y_a, y_b, y_c], axis=-1).astype(x.dtype)
        x = x + mix @ w_out[l]
        h = rms_norm(x, norm_ffn[l])
        hid = causal_dwconv(h @ w_up[l], ffn_conv_w[l]) + ffn_conv_b[l]
        gate, up = jnp.split(hid, 2, axis=-1)
        x = x + (jax.nn.silu(gate) * up) @ w_down[l]
    return rms_norm(x, norm_final)
```

```cpp
#include <hip/hip_runtime.h>
#include <cstdio>
#include <cstdint>
namespace pg8 {
#define PG8_LAS __attribute__((address_space(3)))
typedef unsigned short bf16_t;
typedef short bf16x8 __attribute__((ext_vector_type(8)));
typedef float f32x4 __attribute__((ext_vector_type(4)));
typedef unsigned u32x4 __attribute__((ext_vector_type(4)));
constexpr int BM = 256, BK = 64, HALF = 128, HTB = HALF * BK * 2  , STAGE_BYTES = 8 * HTB, NXCD = 8, WGM = 8;

__host__ __device__ __forceinline__ int lds_byte(int r, int c) { const int st = (r >> 4) * 2 + (c >> 5), rr = r & 15, cc = c & 31, ob = rr * 64 + cc * 2; return st * 1024 + (ob ^ (((ob >> 9) & 1) << 5)); }
__host__ __device__ __forceinline__ void stage_rc(int b, int& R, int& C) { const int st = b / 1024, sb = b % 1024, swz = sb ^ (((sb >> 9) & 1) << 5); R = (st >> 1) * 16 + swz / 64; C = (st & 1) * 32 + (swz % 64) / 2; }
__host__ __device__ __forceinline__ int perm32(int rho) { const int n = rho >> 4, i = rho & 15; return 8 * (i >> 2) + 4 * n + (i & 3); }

struct Unit { int pm, pn; };
struct Gemm { const bf16_t* A; const bf16_t* Bt; int M, N, K; };

struct StaticOrder {
    int nM, nN, nwg, G, c;
    __host__ __device__ void init(int M, int N, int G_, int c_) { nM = M / BM; nN = N / BM; nwg = nM * nN; G = G_; c = c_; }
    __host__ __device__ bool next(int i, Unit& u) const {
        const long L = (long)i * G + c; if (L >= nwg) return false;
        int wgid = (int)L; { const int q = nwg / NXCD, r = nwg % NXCD, xcd = wgid % NXCD, off = wgid / NXCD; wgid = (xcd < r ? xcd * (q + 1) : r * (q + 1) + (xcd - r) * q) + off; }
        const int nig = WGM * nN, gid = wgid / nig, fm = gid * WGM, gsz = (nM - fm) < WGM ? (nM - fm) : WGM;
        u.pm = fm + ((wgid % nig) % gsz); u.pn = (wgid % nig) / gsz; return true;
    }
    __device__ __forceinline__ void a_ready(const Unit&) const {}
    __device__ __forceinline__ void done(const Unit&) const {}
};

__device__ __forceinline__ unsigned cvt_pk_bf16(float lo, float hi) { unsigned r; asm volatile("v_cvt_pk_bf16_f32 %0, %1, %2" : "=v"(r) : "v"(lo), "v"(hi)); return r; }
typedef float f32x2 __attribute__((ext_vector_type(2)));
__device__ __forceinline__ f32x2 gelu_pk(f32x2 v) {
    const f32x2 av = __builtin_elementwise_abs(v), d = av * 0.2316418882f + 1.0f;
    f32x2 t; t.x = __builtin_amdgcn_rcpf(d.x); t.y = __builtin_amdgcn_rcpf(d.y);
    f32x2 q = t * 0.5307027145f + (-0.7265760135f); q = q * t + 0.7107068705f; q = q * t + (-0.142248368f); q = q * t + 0.127414796f; q = q * t;
    const f32x2 s = (v * v) * (-0.72134752044f);
    f32x2 e; e.x = __builtin_amdgcn_exp2f(s.x); e.y = __builtin_amdgcn_exp2f(s.y);
    const f32x2 m = v * (q * e), r = v - m;
    f32x2 o; o.x = v.x < 0.f ? m.x : r.x; o.y = v.y < 0.f ? m.y : r.y; return o;
}

template <int ACT  > struct EpiBf16 {
    static constexpr bool PERM = true, AFTER_DRAIN = false; static_assert(ACT == 0 || ACT == 1, "EpiBf16: ACT is 0 (none) or 1 (gelu_pk)");
    bf16_t* O; int ldc; const float* bias; int split_cols; size_t split_stride; float scale0;
    __device__ __forceinline__ void operator()(const f32x4 (&acc)[2][2][4][2], const Unit& u, int wr, int wc, int fr, int fq) const {
        const int row0 = u.pm * BM + wr * 64 + fr; int colt = u.pn * BM; bf16_t* base = O;
        float sc = 1.f; if (split_cols) { const int t = colt / split_cols; base += (size_t)t * split_stride; colt -= t * split_cols; if (t == 0) sc = scale0; }
        const int col0 = colt + wc * 32 + 8 * fq, bcol0 = u.pn * BM + wc * 32 + 8 * fq;
        f32x4 bv[2][2];
#pragma unroll
        for (int bj = 0; bj < 2; ++bj)
#pragma unroll
            for (int n = 0; n < 2; ++n) bv[bj][n] = bias ? *(const f32x4*)(bias + bcol0 + bj * HALF + 4 * n) : (f32x4){0.f, 0.f, 0.f, 0.f};
#pragma unroll
        for (int ai = 0; ai < 2; ++ai)
#pragma unroll
            for (int m = 0; m < 4; ++m) { bf16_t* rowp = base + (size_t)(row0 + ai * HALF + m * 16) * ldc + col0;
#pragma unroll
                for (int bj = 0; bj < 2; ++bj) { f32x4 v0 = acc[ai][bj][m][0] + bv[bj][0], v1 = acc[ai][bj][m][1] + bv[bj][1];
                    if (ACT == 1) { f32x2 a = gelu_pk((f32x2){v0[0], v0[1]}), b = gelu_pk((f32x2){v0[2], v0[3]}), c = gelu_pk((f32x2){v1[0], v1[1]}), d = gelu_pk((f32x2){v1[2], v1[3]});
                        v0 = (f32x4){a.x, a.y, b.x, b.y}; v1 = (f32x4){c.x, c.y, d.x, d.y}; }
                    v0 = v0 * sc; v1 = v1 * sc; u32x4 w; w.x = cvt_pk_bf16(v0[0], v0[1]); w.y = cvt_pk_bf16(v0[2], v0[3]); w.z = cvt_pk_bf16(v1[0], v1[1]); w.w = cvt_pk_bf16(v1[2], v1[3]);
                    *(u32x4*)(rowp + bj * HALF) = w; } }
    }
};

template <class Epi, class Sched, bool ALIGN_EPI = false, bool SP2 = false>
__device__ __forceinline__ void gemm_phase(PG8_LAS unsigned char* lds, const Gemm g, const Sched& S, const Epi& E) {
    const int tid = threadIdx.x, wid = __builtin_amdgcn_readfirstlane(tid >> 6), lane = tid & 63, wr = wid >> 2, wc = wid & 3, fr = lane & 15, fq = lane >> 4;
    const int K = g.K, nt = K / BK;
    unsigned voffA[2], voffB[2];
#pragma unroll
    for (int i = 0; i < 2; ++i) { int R, C; stage_rc(tid * 16 + i * 8192, R, C); const int Rb = Epi::PERM ? ((R & ~31) + perm32(R & 31)) : R;
        voffA[i] = (unsigned)(R * K + C) * 2u; voffB[i] = (unsigned)(Rb * K + C) * 2u; }
    const size_t kstep = (size_t)(BK * 2);
    const size_t hstep = (size_t)HALF * K * 2;
    const size_t tstep = 2 * hstep;
    const unsigned ldsw = (unsigned)wid * 1024u;
    const int aoff = lds_byte(wr * 64 + fr, fq * 8), boff = lds_byte(wc * 32 + fr, fq * 8);
#define PG8_SA(b, h) (((b) * 2 + (h)) * HTB)
#define PG8_SB(b, h) ((4 + (b) * 2 + (h)) * HTB)
#define PG8_STAGE(bufoff, gbase, voff) do { _Pragma("unroll") for (int _i = 0; _i < 2; ++_i) \
        __builtin_amdgcn_global_load_lds((const unsigned*)((const char*)(gbase) + (voff)[_i]), (PG8_LAS unsigned*)(lds + (bufoff) + ldsw + _i * 8192), 16, 0, 0); } while (0)
#define PG8_LDA(dst, b, h) do { _Pragma("unroll") for (int m = 0; m < 4; ++m) _Pragma("unroll") for (int k = 0; k < 2; ++k) dst[m][k] = *(const PG8_LAS bf16x8*)(lds + PG8_SA(b, h) + aoff + m * 2048 + k * 1024); } while (0)
#define PG8_LDB(dst, b, h) do { _Pragma("unroll") for (int n = 0; n < 2; ++n) _Pragma("unroll") for (int k = 0; k < 2; ++k) dst[n][k] = *(const PG8_LAS bf16x8*)(lds + PG8_SB(b, h) + boff + n * 2048 + k * 1024); } while (0)
#define PG8_MMA(ai, bj, At, Bt) do { __builtin_amdgcn_s_setprio(1); _Pragma("unroll") for (int m = 0; m < 4; ++m) _Pragma("unroll") for (int n = 0; n < 2; ++n) _Pragma("unroll") for (int k = 0; k < 2; ++k) \
        acc[ai][bj][m][n] = __builtin_amdgcn_mfma_f32_16x16x32_bf16(Bt[n][k], At[m][k], acc[ai][bj][m][n], 0, 0, 0); __builtin_amdgcn_s_setprio(0); } while (0)
#define PG8_WAIT_V(n) asm volatile("s_waitcnt vmcnt(" #n ")" ::: "memory")
#define PG8_WAIT_L(n) asm volatile("s_waitcnt lgkmcnt(" #n ")" ::: "memory")
#define PG8_BAR __builtin_amdgcn_s_barrier()
#define PG8_SCHED __builtin_amdgcn_sched_barrier(0)
    Unit cur, nxt; int ui = 0;
    if (!S.next(0, cur)) return;
    f32x4 acc[2][2][4][2];
#pragma unroll
    for (int a = 0; a < 2; ++a)
#pragma unroll
        for (int b = 0; b < 2; ++b)
#pragma unroll
            for (int m = 0; m < 4; ++m)
#pragma unroll
                for (int n = 0; n < 2; ++n) acc[a][b][m][n] = (f32x4){0.f, 0.f, 0.f, 0.f};
    bf16x8 At[4][2], B0[2][2], B1[2][2];
    const char* cA = (const char*)g.A + (size_t)cur.pm * tstep; const char* cB = (const char*)g.Bt + (size_t)cur.pn * tstep;
    S.a_ready(cur);
    if constexpr (SP2) {
        PG8_STAGE(PG8_SB(0, 0), cB, voffB); PG8_STAGE(PG8_SB(0, 1), cB + hstep, voffB); PG8_STAGE(PG8_SA(0, 0), cA, voffA); PG8_STAGE(PG8_SA(0, 1), cA + hstep, voffA);
        if (wr == 1) PG8_BAR;
        PG8_WAIT_V(2); PG8_BAR;
        PG8_STAGE(PG8_SB(1, 0), cB + kstep, voffB); PG8_STAGE(PG8_SA(1, 0), cA + kstep, voffA); PG8_STAGE(PG8_SB(1, 1), cB + hstep + kstep, voffB);
        PG8_WAIT_V(6); PG8_BAR;
    } else {
        PG8_STAGE(PG8_SB(0, 0), cB, voffB); PG8_STAGE(PG8_SA(0, 0), cA, voffA); PG8_STAGE(PG8_SB(0, 1), cB + hstep, voffB); PG8_STAGE(PG8_SA(0, 1), cA + hstep, voffA);
        if (wr == 1) PG8_BAR;
        PG8_WAIT_V(4); PG8_BAR;
        PG8_STAGE(PG8_SB(1, 0), cB + kstep, voffB); PG8_STAGE(PG8_SA(1, 0), cA + kstep, voffA); PG8_STAGE(PG8_SB(1, 1), cB + hstep + kstep, voffB);
        PG8_WAIT_V(6); PG8_BAR;
    }
    for (;;) {
        const bool has_next = S.next(ui + 1, nxt);
        const char* nA = has_next ? (const char*)g.A + (size_t)nxt.pm * tstep : cA; const char* nB = has_next ? (const char*)g.Bt + (size_t)nxt.pn * tstep : cB;
        for (int t = 0; t < nt; t += 2) {
            const bool last = (t == nt - 2);
            const char* a1 = cA + (size_t)(t + 1) * kstep;
            const char* a2 = last ? nA : cA + (size_t)(t + 2) * kstep; const char* b2 = last ? nB : cB + (size_t)(t + 2) * kstep;
            const char* a3 = a2 + kstep; const char* b3 = b2 + kstep;
            if (last && has_next) S.a_ready(nxt);
            if constexpr (SP2) {
            PG8_LDB(B0, 0, 0); PG8_LDB(B1, 0, 1); PG8_SCHED; PG8_LDA(At, 0, 0); PG8_STAGE(PG8_SA(1, 1), a1 + hstep, voffA);
            PG8_WAIT_V(8); PG8_WAIT_L(0); PG8_BAR; PG8_MMA(0, 0, At, B0); PG8_MMA(0, 1, At, B1); PG8_BAR; PG8_SCHED;
            PG8_LDA(At, 0, 1); PG8_STAGE(PG8_SB(0, 0), b2, voffB); PG8_STAGE(PG8_SB(0, 1), b2 + hstep, voffB); PG8_STAGE(PG8_SA(0, 0), a2, voffA);
            PG8_WAIT_V(8); PG8_WAIT_L(0); PG8_BAR; PG8_MMA(1, 0, At, B0); PG8_MMA(1, 1, At, B1); PG8_BAR; PG8_SCHED;
            PG8_LDB(B0, 1, 0); PG8_LDB(B1, 1, 1); PG8_SCHED; PG8_LDA(At, 1, 0); PG8_STAGE(PG8_SA(0, 1), a2 + hstep, voffA);
            PG8_WAIT_V(8); PG8_WAIT_L(0); PG8_BAR; PG8_MMA(0, 0, At, B0); PG8_MMA(0, 1, At, B1); PG8_BAR; PG8_SCHED;
            PG8_LDA(At, 1, 1); PG8_STAGE(PG8_SB(1, 0), b3, voffB); PG8_STAGE(PG8_SB(1, 1), b3 + hstep, voffB); PG8_STAGE(PG8_SA(1, 0), a3, voffA);
            PG8_WAIT_V(8); PG8_WAIT_L(0); PG8_BAR; PG8_MMA(1, 0, At, B0); PG8_MMA(1, 1, At, B1); PG8_BAR; PG8_SCHED;
            } else {
            PG8_LDB(B0, 0, 0); PG8_SCHED; PG8_LDA(At, 0, 0); PG8_STAGE(PG8_SA(1, 1), a1 + hstep, voffA);
            PG8_WAIT_L(8); PG8_BAR; PG8_WAIT_L(0); PG8_MMA(0, 0, At, B0); PG8_BAR; PG8_SCHED;
            PG8_LDB(B1, 0, 1); PG8_STAGE(PG8_SB(0, 0), b2, voffB);
            PG8_BAR; PG8_WAIT_L(0); PG8_MMA(0, 1, At, B1); PG8_BAR;
            PG8_LDA(At, 0, 1); PG8_STAGE(PG8_SA(0, 0), a2, voffA);
            PG8_BAR; PG8_WAIT_L(0); PG8_MMA(1, 0, At, B0); PG8_BAR; PG8_SCHED;
            PG8_STAGE(PG8_SB(0, 1), b2 + hstep, voffB);
            PG8_WAIT_V(6); PG8_BAR; PG8_MMA(1, 1, At, B1); PG8_BAR;
            PG8_LDB(B0, 1, 0); PG8_SCHED; PG8_LDA(At, 1, 0); PG8_STAGE(PG8_SA(0, 1), a2 + hstep, voffA);
            PG8_WAIT_L(8); PG8_BAR; PG8_WAIT_L(0); PG8_MMA(0, 0, At, B0); PG8_BAR; PG8_SCHED;
            PG8_LDB(B1, 1, 1); PG8_STAGE(PG8_SB(1, 0), b3, voffB);
            PG8_BAR; PG8_WAIT_L(0); PG8_MMA(0, 1, At, B1); PG8_BAR;
            PG8_LDA(At, 1, 1); PG8_STAGE(PG8_SA(1, 0), a3, voffA);
            PG8_BAR; PG8_WAIT_L(0); PG8_MMA(1, 0, At, B0); PG8_BAR; PG8_SCHED;
            PG8_STAGE(PG8_SB(1, 1), b3 + hstep, voffB);
            PG8_WAIT_V(6); PG8_BAR; PG8_MMA(1, 1, At, B1); PG8_BAR;
            }
        }
        if constexpr (ALIGN_EPI) { if (wr == 0) PG8_BAR; }
        if constexpr (!Epi::AFTER_DRAIN) { E(acc, cur, wr, wc, fr, fq); S.done(cur); }
        if (!has_next) break;
#pragma unroll
        for (int a = 0; a < 2; ++a)
#pragma unroll
            for (int b = 0; b < 2; ++b)
#pragma unroll
                for (int m = 0; m < 4; ++m)
#pragma unroll
                    for (int n = 0; n < 2; ++n) acc[a][b][m][n] = (f32x4){0.f, 0.f, 0.f, 0.f};
        cur = nxt; cA = nA; cB = nB; ++ui;
        if constexpr (ALIGN_EPI) { if (wr == 1) PG8_BAR; }
    }
    PG8_WAIT_V(0);
    if constexpr (!ALIGN_EPI) { if (wr == 0) PG8_BAR; }
    PG8_BAR;
    if constexpr (Epi::AFTER_DRAIN) { E.fused(acc, cur, wr, wc, fr, fq, lds, wid, lane); S.done(cur); }
#undef PG8_SA
#undef PG8_SB
#undef PG8_STAGE
#undef PG8_LDA
#undef PG8_LDB
#undef PG8_MMA
#undef PG8_WAIT_V
#undef PG8_WAIT_L
#undef PG8_BAR
#undef PG8_SCHED
}
}
constexpr int BATCH = 2, SEQ = 4096, M = BATCH * SEQ, DM = 4096, DEPTH = 2, HD = 128;
constexpr int DNW = 1536, LRW = 1536, SGW = 1024, DNH = 12, LRB = 12, SGG = 8, DFF = 11008, DIN = 11288, DINP = 11520;
constexpr int Q0 = 0, K0 = 1536, V0 = 3072, Z0 = 4608, LX0 = 6144, LG0 = 7680, SU0 = 9216, SV0 = 10240, BA0 = 11264;
constexpr float EPS = 1e-6f;
typedef unsigned short bf16;
typedef float f32x4 __attribute__((ext_vector_type(4)));
typedef unsigned u32x4 __attribute__((ext_vector_type(4)));
typedef unsigned u32x2 __attribute__((ext_vector_type(2)));
#define LAS __attribute__((address_space(3)))
__device__ __forceinline__ unsigned f2bf(float f) { unsigned u = __builtin_bit_cast(unsigned, f); return (u + 0x7fffu + ((u >> 16) & 1u)) >> 16; }
__device__ __forceinline__ unsigned pk2(float lo, float hi) { return f2bf(lo) | (f2bf(hi) << 16); }
__device__ __forceinline__ float bf2f(unsigned short b) { return __builtin_bit_cast(float, ((unsigned)b) << 16); }
__device__ __forceinline__ float bflo(unsigned w) { return __builtin_bit_cast(float, w << 16); }
__device__ __forceinline__ float bfhi(unsigned w) { return __builtin_bit_cast(float, w & 0xffff0000u); }
__device__ __forceinline__ float sigmoidf_(float x) { return 1.0f / (1.0f + __expf(-x)); }
__device__ __forceinline__ float siluf_(float x) { return x * sigmoidf_(x); }
__device__ __forceinline__ float geluf_(float x) { const float u = 0.7978845608028654f * (x + 0.044715f * x * x * x); return 0.5f * x * (1.0f + tanhf(u)); }
__device__ __forceinline__ float softplusf_(float x) { return x > 20.f ? x : log1pf(expf(x)); }
__device__ __forceinline__ float wave_sum(float v) {
#pragma unroll
    for (int o = 1; o < 64; o <<= 1) v += __shfl_xor(v, o);
    return v;
}

__device__ __forceinline__ void transpose_item(const float* W, int K, int Nsrc, bf16* WT, int dst_row0, int src_col0, int nvalid, LAS float* scr, int kb, int lane) {
    const int k0 = 64 * kb;
#pragma unroll 8
    for (int i = 0; i < 32; ++i) { const int kk = 2 * i + (lane >> 5), n = lane & 31; scr[kk * 33 + n] = (n < nvalid) ? W[(size_t)(k0 + kk) * Nsrc + src_col0 + n] : 0.f; }
    asm volatile("s_waitcnt lgkmcnt(0)" ::: "memory");
    const int c = lane & 7;
#pragma unroll
    for (int j = 0; j < 4; ++j) { const int n = (lane >> 3) + 8 * j; const LAS float* s = scr + (8 * c) * 33 + n;
        u32x4 o; o.x = pk2(s[0 * 33], s[1 * 33]); o.y = pk2(s[2 * 33], s[3 * 33]); o.z = pk2(s[4 * 33], s[5 * 33]); o.w = pk2(s[6 * 33], s[7 * 33]);
        *(u32x4*)(WT + (size_t)(dst_row0 + n) * K + k0 + 8 * c) = o; }
    asm volatile("s_waitcnt lgkmcnt(0)" ::: "memory");
}
__global__ __launch_bounds__(256) void k_transpose(const float* W, int K, int Nsrc, int Ndst, bf16* WT, int mode) {
    __shared__ float scr_all[4 * 64 * 33];
    const int lane = threadIdx.x & 63, wave = threadIdx.x >> 6;
    LAS float* scr = (LAS float*)scr_all + wave * 64 * 33;
    const int nblk = Ndst / 32, nitems = nblk * (K / 64);
    for (int it = blockIdx.x * 4 + wave; it < nitems; it += gridDim.x * 4) {
        const int kb = it / nblk, nb = it % nblk, n0 = nb * 32; int src = n0, nv = 32;
        if (mode == 1) { if (n0 < 6144) { src = n0; } else if (n0 < 11264) { src = n0 + 24; } else if (n0 == 11264) { src = 6144; nv = 24; } else { src = 0; nv = 0; } }
        transpose_item(W, K, Nsrc, WT, n0, src, nv, scr, kb, lane);
    }
}

__global__ __launch_bounds__(256) void k_rmsnorm(const float* x, const float* w, bf16* ob, float* of) {
    const int lane = threadIdx.x & 63, row = blockIdx.x * 4 + (threadIdx.x >> 6);
    const f32x4* xr = (const f32x4*)(x + (size_t)row * DM) + lane; const f32x4* wr = (const f32x4*)w + lane;
    f32x4 v[16]; float s = 0.f;
#pragma unroll
    for (int j = 0; j < 16; ++j) { v[j] = xr[64 * j]; s += (v[j].x * v[j].x + v[j].y * v[j].y) + (v[j].z * v[j].z + v[j].w * v[j].w); }
    const float rstd = 1.0f / sqrtf(wave_sum(s) * (1.0f / DM) + EPS);
#pragma unroll
    for (int j = 0; j < 16; ++j) { const f32x4 o = v[j] * rstd * wr[64 * j];
        if (ob) { u32x2 p; p.x = pk2(o.x, o.y); p.y = pk2(o.z, o.w); *((u32x2*)(ob + (size_t)row * DM) + lane + 64 * j) = p; }
        else *((f32x4*)(of + (size_t)row * DM) + lane + 64 * j) = o; }
}

struct EpiResF32 {
    static constexpr bool PERM = false, AFTER_DRAIN = false;
    const float* R; float* C; int ldc;
    __device__ __forceinline__ void operator()(const pg8::f32x4 (&acc)[2][2][4][2], const pg8::Unit& u, int wr, int wc, int fr, int fq) const {
        const int row0 = u.pm * 256 + wr * 64 + fr, col0 = u.pn * 256 + wc * 32 + 4 * fq;
#pragma unroll
        for (int ai = 0; ai < 2; ++ai)
#pragma unroll
            for (int m = 0; m < 4; ++m) { const size_t off = (size_t)(row0 + ai * 128 + m * 16) * ldc + col0;
#pragma unroll
                for (int bj = 0; bj < 2; ++bj)
#pragma unroll
                    for (int n = 0; n < 2; ++n) *(pg8::f32x4*)(C + off + bj * 128 + n * 16) = *(const pg8::f32x4*)(R + off + bj * 128 + n * 16) + acc[ai][bj][m][n]; }
    }
};
__global__ __launch_bounds__(512, 2) void k_gemm_bf16(const bf16* A, const bf16* Bt, int Mm, int N, int K, bf16* O, int ldc) {
    extern __shared__ __attribute__((aligned(16))) unsigned char shm[];
    pg8::Gemm g{A, Bt, Mm, N, K}; pg8::StaticOrder S; S.init(Mm, N, (int)gridDim.x, (int)blockIdx.x);
    pg8::EpiBf16<0> E{O, ldc, nullptr, 0, 0, 1.f};
    pg8::gemm_phase<pg8::EpiBf16<0>, pg8::StaticOrder, true, true>((PG8_LAS unsigned char*)shm, g, S, E);
}
__global__ __launch_bounds__(512, 2) void k_gemm_res(const bf16* A, const bf16* Bt, int Mm, int N, int K, const float* R, float* C, int ldc) {
    extern __shared__ __attribute__((aligned(16))) unsigned char shm[];
    pg8::Gemm g{A, Bt, Mm, N, K}; pg8::StaticOrder S; S.init(Mm, N, (int)gridDim.x, (int)blockIdx.x);
    EpiResF32 E{R, C, ldc};
    pg8::gemm_phase<EpiResF32, pg8::StaticOrder, true, true>((PG8_LAS unsigned char*)shm, g, S, E);
}

__global__ __launch_bounds__(128) void k_dn_prep(const bf16* proj, const float* convw, const float* a_log, const float* dt_bias, float* qf, float* kf, float* vf, float* beta, float* gg) {
    __shared__ float red[2];
    const int m = blockIdx.x / DNH, h = blockIdx.x % DNH, d = threadIdx.x, t = m % SEQ;
    float y[3];
#pragma unroll
    for (int p = 0; p < 3; ++p) { const int c = p * DNW + h * HD + d; float a = 0.f;
#pragma unroll
        for (int j = 0; j < 4; ++j) { const int tt = t - 3 + j; if (tt >= 0) a += convw[j * 3 * DNW + c] * bf2f(proj[(size_t)(m - 3 + j) * DINP + c]); }
        y[p] = siluf_(a); }
#pragma unroll
    for (int p = 0; p < 2; ++p) { const float s = wave_sum(y[p] * y[p]); __syncthreads(); if ((d & 63) == 0) red[d >> 6] = s; __syncthreads(); y[p] *= 1.0f / sqrtf(red[0] + red[1] + EPS); }
    const size_t o = (size_t)m * DNW + h * HD + d; qf[o] = y[0]; kf[o] = y[1]; vf[o] = y[2];
    if (d == 0) { beta[m * DNH + h] = sigmoidf_(bf2f(proj[(size_t)m * DINP + BA0 + h]));
        gg[m * DNH + h] = -expf(a_log[h]) * softplusf_(bf2f(proj[(size_t)m * DINP + BA0 + DNH + h]) + dt_bias[h]); }
}
__global__ __launch_bounds__(128) void k_dn_scan(const float* qf, const float* kf, const float* vf, const float* beta, const float* gg, float* o) {
    __shared__ float ks[HD], qs[HD];
    const int b = blockIdx.x / DNH, h = blockIdx.x % DNH, e = threadIdx.x;
    float S[HD];
#pragma unroll
    for (int d = 0; d < HD; ++d) S[d] = 0.f;
    size_t m = (size_t)b * SEQ; size_t idx = m * DNW + h * HD + e;
    float kn = kf[idx], qn = qf[idx], vn = vf[idx], bn = beta[m * DNH + h], gn = gg[m * DNH + h];
    for (int t = 0; t < SEQ; ++t) {
        __syncthreads(); ks[e] = kn; qs[e] = qn; const float v = vn, bt = bn, dec = expf(gn); const size_t oidx = idx; __syncthreads();
        if (t + 1 < SEQ) { m += 1; idx += DNW; kn = kf[idx]; qn = qf[idx]; vn = vf[idx]; bn = beta[m * DNH + h]; gn = gg[m * DNH + h]; }
        float kS = 0.f;
#pragma unroll
        for (int d = 0; d < HD; ++d) kS += ks[d] * S[d];
        const float c = bt * (v - dec * kS); float acc = 0.f;
#pragma unroll
        for (int d = 0; d < HD; ++d) { S[d] = dec * S[d] + ks[d] * c; acc += qs[d] * S[d]; }
        o[oidx] = acc * 0.08838834764831845f;
    }
}
__global__ __launch_bounds__(256) void k_groupnorm(const float* y, int W, const float* w, const bf16* proj, bf16* mix, int coff, int mode) {
    const int lane = threadIdx.x & 63, gw = blockIdx.x * 4 + (threadIdx.x >> 6), ng = W / HD, m = gw / ng, g = gw % ng;
    const float* yr = y + (size_t)m * W + g * HD; const float a = yr[lane], b = yr[lane + 64];
    const float rstd = 1.0f / sqrtf(wave_sum(a * a + b * b) * (1.0f / HD) + EPS);
    float oa, ob;
    if (mode == 0) { oa = a * rstd * w[lane] * siluf_(bf2f(proj[(size_t)m * DINP + Z0 + g * HD + lane])); ob = b * rstd * w[lane + 64] * siluf_(bf2f(proj[(size_t)m * DINP + Z0 + g * HD + lane + 64])); }
    else { oa = a * rstd * w[g * HD + lane]; ob = b * rstd * w[g * HD + lane + 64]; }
    bf16* mr = mix + (size_t)m * DM + coff + g * HD; mr[lane] = (bf16)f2bf(oa); mr[lane + 64] = (bf16)f2bf(ob);
}
__global__ __launch_bounds__(128) void k_lru_gates(const bf16* proj, const float* convw, const float* convb, const float* wa, const float* ba, const float* wx, const float* bx, const float* lam, float* A, float* I) {
    __shared__ float xs[HD];
    const int m = blockIdx.x / LRB, g = blockIdx.x % LRB, j = threadIdx.x, t = m % SEQ, c = g * HD + j;
    float a = convb[c];
#pragma unroll
    for (int jj = 0; jj < 4; ++jj) { const int tt = t - 3 + jj; if (tt >= 0) a += convw[jj * LRW + c] * bf2f(proj[(size_t)(m - 3 + jj) * DINP + LX0 + c]); }
    xs[j] = a; __syncthreads();
    float ra = 0.f, rx = 0.f; const float* wap = wa + (size_t)g * HD * HD + j; const float* wxp = wx + (size_t)g * HD * HD + j;
#pragma unroll 8
    for (int i = 0; i < HD; ++i) { ra += xs[i] * wap[i * HD]; rx += xs[i] * wxp[i * HD]; }
    const float r = sigmoidf_(ra + ba[c]), ig = sigmoidf_(rx + bx[c]);
    const float log_a = -8.0f * r * softplusf_(-lam[c]);
    A[(size_t)m * LRW + c] = expf(log_a); I[(size_t)m * LRW + c] = sqrtf(-expm1f(2.0f * log_a)) * (ig * a);
}
__global__ __launch_bounds__(64) void k_lru_scan(const float* A, float* I, const bf16* proj) {
    const int gid = blockIdx.x * 64 + threadIdx.x, b = gid / LRW, c = gid % LRW; float h = 0.f;
    size_t idx = (size_t)b * SEQ * LRW + c; const bf16* gp = proj + (size_t)b * SEQ * DINP + LG0 + c;
#pragma unroll 8
    for (int t = 0; t < SEQ; ++t) { h = A[idx] * h + I[idx]; I[idx] = h * geluf_(bf2f(gp[(size_t)t * DINP])); idx += LRW; }
}
__global__ __launch_bounds__(256) void k_sg_ln(const bf16* proj, const float* lnw, const float* lnb, float* vln) {
    __shared__ float red[8];
    const int m = blockIdx.x, tid = threadIdx.x; float v[4]; float s = 0.f, s2 = 0.f;
#pragma unroll
    for (int i = 0; i < 4; ++i) { v[i] = geluf_(bf2f(proj[(size_t)m * DINP + SV0 + tid + 256 * i])); s += v[i]; }
    s = wave_sum(s); if ((tid & 63) == 0) red[tid >> 6] = s; __syncthreads();
    const float mu = (red[0] + red[1] + red[2] + red[3]) * (1.0f / SGW);
#pragma unroll
    for (int i = 0; i < 4; ++i) { const float d = v[i] - mu; s2 += d * d; }
    s2 = wave_sum(s2); if ((tid & 63) == 0) red[4 + (tid >> 6)] = s2; __syncthreads();
    const float rstd = 1.0f / sqrtf((red[4] + red[5] + red[6] + red[7]) * (1.0f / SGW) + EPS);
#pragma unroll
    for (int i = 0; i < 4; ++i) { const int c = tid + 256 * i; vln[(size_t)m * SGW + c] = (v[i] - mu) * rstd * lnw[c] + lnb[c]; }
}
__global__ __launch_bounds__(128) void k_sg_mix(const float* vln, const float* ws, const float* bs, const bf16* proj, float* Y) {
    __shared__ float vs[128 * 128];
    const int blk = blockIdx.x, g = blk % SGG, bn = blk / SGG, c = threadIdx.x; const size_t m0 = (size_t)bn * 128;
    for (int s = 0; s < 128; ++s) vs[s * 128 + c] = vln[(m0 + s) * SGW + g * HD + c];
    __syncthreads();
    for (int tl = 0; tl < 128; ++tl) { const float* wr = ws + ((size_t)g * 128 + tl) * 128; float acc = 0.f;
        for (int s = 0; s <= tl; ++s) acc += wr[s] * vs[s * 128 + c];
        const float z = acc + bs[g * 128 + tl];
        Y[(m0 + tl) * SGW + g * HD + c] = geluf_(bf2f(proj[(m0 + tl) * DINP + SU0 + g * HD + c])) * z; }
}
__global__ __launch_bounds__(256) void k_ffn_act(const bf16* hid, const float* cw, const float* cb, bf16* act) {
    const size_t gid = (size_t)blockIdx.x * 256 + threadIdx.x; const int cg = (int)(gid % (DFF / 8)), m = (int)(gid / (DFF / 8)), t = m % SEQ, c0 = cg * 8;
    float ga[8], up[8];
#pragma unroll
    for (int i = 0; i < 8; ++i) { ga[i] = cb[c0 + i]; up[i] = cb[DFF + c0 + i]; }
#pragma unroll
    for (int j = 0; j < 3; ++j) { const int tt = t - 2 + j; if (tt >= 0) {
        const u32x4 hg = *(const u32x4*)(hid + (size_t)(m - 2 + j) * (2 * DFF) + c0), hu = *(const u32x4*)(hid + (size_t)(m - 2 + j) * (2 * DFF) + DFF + c0);
        const unsigned gw[4] = {hg.x, hg.y, hg.z, hg.w}, uw[4] = {hu.x, hu.y, hu.z, hu.w};
#pragma unroll
        for (int i = 0; i < 4; ++i) { ga[2 * i] += cw[j * 2 * DFF + c0 + 2 * i] * bflo(gw[i]); ga[2 * i + 1] += cw[j * 2 * DFF + c0 + 2 * i + 1] * bfhi(gw[i]);
            up[2 * i] += cw[j * 2 * DFF + DFF + c0 + 2 * i] * bflo(uw[i]); up[2 * i + 1] += cw[j * 2 * DFF + DFF + c0 + 2 * i + 1] * bfhi(uw[i]); } } }
    u32x4 o; o.x = pk2(siluf_(ga[0]) * up[0], siluf_(ga[1]) * up[1]); o.y = pk2(siluf_(ga[2]) * up[2], siluf_(ga[3]) * up[3]);
    o.z = pk2(siluf_(ga[4]) * up[4], siluf_(ga[5]) * up[5]); o.w = pk2(siluf_(ga[6]) * up[6], siluf_(ga[7]) * up[7]);
    *(u32x4*)(act + (size_t)m * DFF + c0) = o;
}

constexpr size_t MiB = 1u << 20;
constexpr size_t SZ_WIN = (size_t)DINP * DM * 2, SZ_WOUT = (size_t)DM * DM * 2, SZ_WUP = (size_t)2 * DFF * DM * 2, SZ_WDN = (size_t)DM * DFF * 2;
constexpr size_t WS_W = 1 * MiB, SZ_WL = SZ_WIN + SZ_WOUT + SZ_WUP + SZ_WDN;
constexpr size_t WS_HB = WS_W + 2 * SZ_WL, WS_PROJ = WS_HB + (size_t)M * DM * 2, WS_MIX = WS_PROJ + (size_t)M * DINP * 2, WS_XA = WS_MIX + (size_t)M * DM * 2, WS_XB = WS_XA + (size_t)M * DM * 4;
constexpr size_t WS_HID = WS_XB + (size_t)M * DM * 4, WS_ACT = WS_HID + (size_t)M * 2 * DFF * 2, WS_SCR = WS_ACT + (size_t)M * DFF * 2;
constexpr size_t SZ_F1536 = (size_t)M * 1536 * 4, SZ_F1024 = (size_t)M * 1024 * 4;
constexpr size_t WS_QF = WS_SCR, WS_KF = WS_QF + SZ_F1536, WS_VF = WS_KF + SZ_F1536, WS_OF = WS_VF + SZ_F1536, WS_LA = WS_OF + SZ_F1536, WS_LI = WS_LA + SZ_F1536,
                 WS_SV = WS_LI + SZ_F1536, WS_SY = WS_SV + SZ_F1024, WS_BG = WS_SY + SZ_F1024, WS_END = WS_BG + 2 * MiB;

extern "C" void kernel_launch(void* const* d_in, const int* in_sizes, int n_in, void* d_out, int out_size, void* d_ws, size_t ws_size, hipStream_t stream) {
    if (n_in != 27 || out_size != M * DM || ws_size < WS_END) { fprintf(stderr, "kernel_launch: unexpected shapes (n_in %d out %d ws %zu need %zu)\n", n_in, out_size, ws_size, (size_t)WS_END); return; }
    static bool attr = false;
    if (!attr) { (void)hipFuncSetAttribute((const void*)k_gemm_bf16, hipFuncAttributeMaxDynamicSharedMemorySize, 131072); (void)hipFuncSetAttribute((const void*)k_gemm_res, hipFuncAttributeMaxDynamicSharedMemorySize, 131072); attr = true; }
    const float* const* in = (const float* const*)d_in; unsigned char* ws = (unsigned char*)d_ws;
    const float* x = in[0];
    bf16* hb = (bf16*)(ws + WS_HB); bf16* proj = (bf16*)(ws + WS_PROJ); bf16* mix = (bf16*)(ws + WS_MIX); float* xa = (float*)(ws + WS_XA); float* xb = (float*)(ws + WS_XB);
    bf16* hid = (bf16*)(ws + WS_HID); bf16* act = (bf16*)(ws + WS_ACT);
    float *qf = (float*)(ws + WS_QF), *kf = (float*)(ws + WS_KF), *vf = (float*)(ws + WS_VF), *of = (float*)(ws + WS_OF), *la = (float*)(ws + WS_LA), *li = (float*)(ws + WS_LI), *sv = (float*)(ws + WS_SV), *sy = (float*)(ws + WS_SY);
    float* beta = (float*)(ws + WS_BG); float* gg = beta + M * DNH;
    const int G = 256;
    for (int l = 0; l < DEPTH; ++l) {
        bf16* win = (bf16*)(ws + WS_W + l * SZ_WL); bf16* wout = (bf16*)((unsigned char*)win + SZ_WIN); bf16* wup = (bf16*)((unsigned char*)wout + SZ_WOUT); bf16* wdn = (bf16*)((unsigned char*)wup + SZ_WUP);
        hipLaunchKernelGGL(k_transpose, dim3(2048), dim3(256), 0, stream, in[2] + (size_t)l * DM * DIN, DM, DIN, DINP, win, 1);
        hipLaunchKernelGGL(k_transpose, dim3(2048), dim3(256), 0, stream, in[20] + (size_t)l * DM * DM, DM, DM, DM, wout, 0);
        hipLaunchKernelGGL(k_transpose, dim3(2048), dim3(256), 0, stream, in[22] + (size_t)l * DM * 2 * DFF, DM, 2 * DFF, 2 * DFF, wup, 0);
        hipLaunchKernelGGL(k_transpose, dim3(2048), dim3(256), 0, stream, in[25] + (size_t)l * DFF * DM, DFF, DM, DM, wdn, 0);
    }
    const float* xin = x;
    for (int l = 0; l < DEPTH; ++l) {
        bf16* win = (bf16*)(ws + WS_W + l * SZ_WL); bf16* wout = (bf16*)((unsigned char*)win + SZ_WIN); bf16* wup = (bf16*)((unsigned char*)wout + SZ_WOUT); bf16* wdn = (bf16*)((unsigned char*)wup + SZ_WUP);
        hipLaunchKernelGGL(k_rmsnorm, dim3(M / 4), dim3(256), 0, stream, xin, in[1] + l * DM, hb, (float*)nullptr);
        hipLaunchKernelGGL(k_gemm_bf16, dim3(G), dim3(512), 131072, stream, (const bf16*)hb, (const bf16*)win, M, DINP, DM, proj, DINP);
        hipLaunchKernelGGL(k_dn_prep, dim3(M * DNH), dim3(128), 0, stream, (const bf16*)proj, in[3] + (size_t)l * 4 * 3 * DNW, in[4] + l * DNH, in[5] + l * DNH, qf, kf, vf, beta, gg);
        hipLaunchKernelGGL(k_dn_scan, dim3(BATCH * DNH), dim3(128), 0, stream, (const float*)qf, (const float*)kf, (const float*)vf, (const float*)beta, (const float*)gg, of);
        hipLaunchKernelGGL(k_groupnorm, dim3(M * DNH / 4), dim3(256), 0, stream, (const float*)of, DNW, in[6] + l * HD, (const bf16*)proj, mix, 0, 0);
        hipLaunchKernelGGL(k_lru_gates, dim3(M * LRB), dim3(128), 0, stream, (const bf16*)proj, in[7] + (size_t)l * 4 * LRW, in[8] + l * LRW, in[9] + (size_t)l * LRB * HD * HD, in[10] + l * LRW, in[11] + (size_t)l * LRB * HD * HD, in[12] + l * LRW, in[13] + l * LRW, la, li);
        hipLaunchKernelGGL(k_lru_scan, dim3(BATCH * LRW / 64), dim3(64), 0, stream, (const float*)la, li, (const bf16*)proj);
        hipLaunchKernelGGL(k_groupnorm, dim3(M * LRB / 4), dim3(256), 0, stream, (const float*)li, LRW, in[14] + l * LRW, (const bf16*)proj, mix, DNW, 1);
        hipLaunchKernelGGL(k_sg_ln, dim3(M), dim3(256), 0, stream, (const bf16*)proj, in[15] + l * SGW, in[16] + l * SGW, sv);
        hipLaunchKernelGGL(k_sg_mix, dim3(BATCH * (SEQ / 128) * SGG), dim3(128), 0, stream, (const float*)sv, in[17] + (size_t)l * SGG * 128 * 128, in[18] + l * SGG * 128, (const bf16*)proj, sy);
        hipLaunchKernelGGL(k_groupnorm, dim3(M * SGG / 4), dim3(256), 0, stream, (const float*)sy, SGW, in[19] + l * SGW, (const bf16*)proj, mix, DNW + LRW, 1);
        hipLaunchKernelGGL(k_gemm_res, dim3(G), dim3(512), 131072, stream, (const bf16*)mix, (const bf16*)wout, M, DM, DM, xin, xa, DM);
        hipLaunchKernelGGL(k_rmsnorm, dim3(M / 4), dim3(256), 0, stream, (const float*)xa, in[21] + l * DM, hb, (float*)nullptr);
        hipLaunchKernelGGL(k_gemm_bf16, dim3(G), dim3(512), 131072, stream, (const bf16*)hb, (const bf16*)wup, M, 2 * DFF, DM, hid, 2 * DFF);
        hipLaunchKernelGGL(k_ffn_act, dim3((unsigned)((size_t)M * (DFF / 8) / 256)), dim3(256), 0, stream, (const bf16*)hid, in[23] + (size_t)l * 3 * 2 * DFF, in[24] + (size_t)l * 2 * DFF, act);
        hipLaunchKernelGGL(k_gemm_res, dim3(G), dim3(512), 131072, stream, (const bf16*)act, (const bf16*)wdn, M, DM, DFF, (const float*)xa, xb, DM);
        xin = xb;
    }
    hipLaunchKernelGGL(k_rmsnorm, dim3(M / 4), dim3(256), 0, stream, xin, in[26], (bf16*)nullptr, (float*)d_out);
}
```

```cpp
#include <hip/hip_runtime.h>
#include <cstdio>
#include <cstdint>
#define USE_DN 1
#define USE_LRU 1
#define USE_SG 1
namespace pg8 {
#define PG8_LAS __attribute__((address_space(3)))
typedef unsigned short bf16_t;
typedef short bf16x8 __attribute__((ext_vector_type(8)));
typedef float f32x4 __attribute__((ext_vector_type(4)));
typedef unsigned u32x4 __attribute__((ext_vector_type(4)));
constexpr int BM = 256, BK = 64, HALF = 128, HTB = HALF * BK * 2  , STAGE_BYTES = 8 * HTB, NXCD = 8, WGM = 8;

__host__ __device__ __forceinline__ int lds_byte(int r, int c) { const int st = (r >> 4) * 2 + (c >> 5), rr = r & 15, cc = c & 31, ob = rr * 64 + cc * 2; return st * 1024 + (ob ^ (((ob >> 9) & 1) << 5)); }
__host__ __device__ __forceinline__ void stage_rc(int b, int& R, int& C) { const int st = b / 1024, sb = b % 1024, swz = sb ^ (((sb >> 9) & 1) << 5); R = (st >> 1) * 16 + swz / 64; C = (st & 1) * 32 + (swz % 64) / 2; }
__host__ __device__ __forceinline__ int perm32(int rho) { const int n = rho >> 4, i = rho & 15; return 8 * (i >> 2) + 4 * n + (i & 3); }

struct Unit { int pm, pn; };
struct Gemm { const bf16_t* A; const bf16_t* Bt; int M, N, K; };

struct StaticOrder {
    int nM, nN, nwg, G, c;
    __host__ __device__ void init(int M, int N, int G_, int c_) { nM = M / BM; nN = N / BM; nwg = nM * nN; G = G_; c = c_; }
    __host__ __device__ bool next(int i, Unit& u) const {
        const long L = (long)i * G + c; if (L >= nwg) return false;
        int wgid = (int)L; { const int q = nwg / NXCD, r = nwg % NXCD, xcd = wgid % NXCD, off = wgid / NXCD; wgid = (xcd < r ? xcd * (q + 1) : r * (q + 1) + (xcd - r) * q) + off; }
        const int nig = WGM * nN, gid = wgid / nig, fm = gid * WGM, gsz = (nM - fm) < WGM ? (nM - fm) : WGM;
        u.pm = fm + ((wgid % nig) % gsz); u.pn = (wgid % nig) / gsz; return true;
    }
    __device__ __forceinline__ void a_ready(const Unit&) const {}
    __device__ __forceinline__ void done(const Unit&) const {}
};

__device__ __forceinline__ unsigned cvt_pk_bf16(float lo, float hi) { unsigned r; asm volatile("v_cvt_pk_bf16_f32 %0, %1, %2" : "=v"(r) : "v"(lo), "v"(hi)); return r; }
typedef float f32x2 __attribute__((ext_vector_type(2)));
__device__ __forceinline__ f32x2 gelu_pk(f32x2 v) {
    const f32x2 av = __builtin_elementwise_abs(v), d = av * 0.2316418882f + 1.0f;
    f32x2 t; t.x = __builtin_amdgcn_rcpf(d.x); t.y = __builtin_amdgcn_rcpf(d.y);
    f32x2 q = t * 0.5307027145f + (-0.7265760135f); q = q * t + 0.7107068705f; q = q * t + (-0.142248368f); q = q * t + 0.127414796f; q = q * t;
    const f32x2 s = (v * v) * (-0.72134752044f);
    f32x2 e; e.x = __builtin_amdgcn_exp2f(s.x); e.y = __builtin_amdgcn_exp2f(s.y);
    const f32x2 m = v * (q * e), r = v - m;
    f32x2 o; o.x = v.x < 0.f ? m.x : r.x; o.y = v.y < 0.f ? m.y : r.y; return o;
}

template <int ACT  > struct EpiBf16 {
    static constexpr bool PERM = true, AFTER_DRAIN = false; static_assert(ACT == 0 || ACT == 1, "EpiBf16: ACT is 0 (none) or 1 (gelu_pk)");
    bf16_t* O; int ldc; const float* bias; int split_cols; size_t split_stride; float scale0;
    __device__ __forceinline__ void operator()(const f32x4 (&acc)[2][2][4][2], const Unit& u, int wr, int wc, int fr, int fq) const {
        const int row0 = u.pm * BM + wr * 64 + fr; int colt = u.pn * BM; bf16_t* base = O;
        float sc = 1.f; if (split_cols) { const int t = colt / split_cols; base += (size_t)t * split_stride; colt -= t * split_cols; if (t == 0) sc = scale0; }
        const int col0 = colt + wc * 32 + 8 * fq, bcol0 = u.pn * BM + wc * 32 + 8 * fq;
        f32x4 bv[2][2];
#pragma unroll
        for (int bj = 0; bj < 2; ++bj)
#pragma unroll
            for (int n = 0; n < 2; ++n) bv[bj][n] = bias ? *(const f32x4*)(bias + bcol0 + bj * HALF + 4 * n) : (f32x4){0.f, 0.f, 0.f, 0.f};
#pragma unroll
        for (int ai = 0; ai < 2; ++ai)
#pragma unroll
            for (int m = 0; m < 4; ++m) { bf16_t* rowp = base + (size_t)(row0 + ai * HALF + m * 16) * ldc + col0;
#pragma unroll
                for (int bj = 0; bj < 2; ++bj) { f32x4 v0 = acc[ai][bj][m][0] + bv[bj][0], v1 = acc[ai][bj][m][1] + bv[bj][1];
                    if (ACT == 1) { f32x2 a = gelu_pk((f32x2){v0[0], v0[1]}), b = gelu_pk((f32x2){v0[2], v0[3]}), c = gelu_pk((f32x2){v1[0], v1[1]}), d = gelu_pk((f32x2){v1[2], v1[3]});
                        v0 = (f32x4){a.x, a.y, b.x, b.y}; v1 = (f32x4){c.x, c.y, d.x, d.y}; }
                    v0 = v0 * sc; v1 = v1 * sc; u32x4 w; w.x = cvt_pk_bf16(v0[0], v0[1]); w.y = cvt_pk_bf16(v0[2], v0[3]); w.z = cvt_pk_bf16(v1[0], v1[1]); w.w = cvt_pk_bf16(v1[2], v1[3]);
                    *(u32x4*)(rowp + bj * HALF) = w; } }
    }
};

template <class Epi, class Sched, bool ALIGN_EPI = false, bool SP2 = false>
__device__ __forceinline__ void gemm_phase(PG8_LAS unsigned char* lds, const Gemm g, const Sched& S, const Epi& E) {
    int tid_l = threadIdx.x; asm volatile("" : "+v"(tid_l));
    const int tid = tid_l, wid = __builtin_amdgcn_readfirstlane(tid >> 6), lane = tid & 63, wr = wid >> 2, wc = wid & 3, fr = lane & 15, fq = lane >> 4;
    const int K = g.K, nt = K / BK;
    unsigned voffA[2], voffB[2];
#pragma unroll
    for (int i = 0; i < 2; ++i) { int R, C; stage_rc(tid * 16 + i * 8192, R, C); const int Rb = Epi::PERM ? ((R & ~31) + perm32(R & 31)) : R;
        voffA[i] = (unsigned)(R * K + C) * 2u; voffB[i] = (unsigned)(Rb * K + C) * 2u; }
    const size_t kstep = (size_t)(BK * 2);
    const size_t hstep = (size_t)HALF * K * 2;
    const size_t tstep = 2 * hstep;
    const unsigned ldsw = (unsigned)wid * 1024u;
    const int aoff = lds_byte(wr * 64 + fr, fq * 8), boff = lds_byte(wc * 32 + fr, fq * 8);
#define PG8_SA(b, h) (((b) * 2 + (h)) * HTB)
#define PG8_SB(b, h) ((4 + (b) * 2 + (h)) * HTB)
#define PG8_STAGE(bufoff, gbase, voff) do { _Pragma("unroll") for (int _i = 0; _i < 2; ++_i) \
        __builtin_amdgcn_global_load_lds((const unsigned*)((const char*)(gbase) + (voff)[_i]), (PG8_LAS unsigned*)(lds + (bufoff) + ldsw + _i * 8192), 16, 0, 0); } while (0)
#define PG8_LDA(dst, b, h) do { _Pragma("unroll") for (int m = 0; m < 4; ++m) _Pragma("unroll") for (int k = 0; k < 2; ++k) dst[m][k] = *(const PG8_LAS bf16x8*)(lds + PG8_SA(b, h) + aoff + m * 2048 + k * 1024); } while (0)
#define PG8_LDB(dst, b, h) do { _Pragma("unroll") for (int n = 0; n < 2; ++n) _Pragma("unroll") for (int k = 0; k < 2; ++k) dst[n][k] = *(const PG8_LAS bf16x8*)(lds + PG8_SB(b, h) + boff + n * 2048 + k * 1024); } while (0)
#define PG8_MMA(ai, bj, At, Bt) do { __builtin_amdgcn_s_setprio(1); _Pragma("unroll") for (int m = 0; m < 4; ++m) _Pragma("unroll") for (int n = 0; n < 2; ++n) _Pragma("unroll") for (int k = 0; k < 2; ++k) \
        acc[ai][bj][m][n] = __builtin_amdgcn_mfma_f32_16x16x32_bf16(Bt[n][k], At[m][k], acc[ai][bj][m][n], 0, 0, 0); __builtin_amdgcn_s_setprio(0); } while (0)
#define PG8_WAIT_V(n) asm volatile("s_waitcnt vmcnt(" #n ")" ::: "memory")
#define PG8_WAIT_L(n) asm volatile("s_waitcnt lgkmcnt(" #n ")" ::: "memory")
#define PG8_BAR __builtin_amdgcn_s_barrier()
#define PG8_SCHED __builtin_amdgcn_sched_barrier(0)
    Unit cur, nxt; int ui = 0;
    if (!S.next(0, cur)) return;
    f32x4 acc[2][2][4][2];
#pragma unroll
    for (int a = 0; a < 2; ++a)
#pragma unroll
        for (int b = 0; b < 2; ++b)
#pragma unroll
            for (int m = 0; m < 4; ++m)
#pragma unroll
                for (int n = 0; n < 2; ++n) acc[a][b][m][n] = (f32x4){0.f, 0.f, 0.f, 0.f};
    bf16x8 At[4][2], B0[2][2], B1[2][2];
    const char* cA = (const char*)g.A + (size_t)cur.pm * tstep; const char* cB = (const char*)g.Bt + (size_t)cur.pn * tstep;
    S.a_ready(cur);
    if constexpr (SP2) {
        PG8_STAGE(PG8_SB(0, 0), cB, voffB); PG8_STAGE(PG8_SB(0, 1), cB + hstep, voffB); PG8_STAGE(PG8_SA(0, 0), cA, voffA); PG8_STAGE(PG8_SA(0, 1), cA + hstep, voffA);
        if (wr == 1) PG8_BAR;
        PG8_WAIT_V(2); PG8_BAR;
        PG8_STAGE(PG8_SB(1, 0), cB + kstep, voffB); PG8_STAGE(PG8_SA(1, 0), cA + kstep, voffA); PG8_STAGE(PG8_SB(1, 1), cB + hstep + kstep, voffB);
        PG8_WAIT_V(6); PG8_BAR;
    } else {
        PG8_STAGE(PG8_SB(0, 0), cB, voffB); PG8_STAGE(PG8_SA(0, 0), cA, voffA); PG8_STAGE(PG8_SB(0, 1), cB + hstep, voffB); PG8_STAGE(PG8_SA(0, 1), cA + hstep, voffA);
        if (wr == 1) PG8_BAR;
        PG8_WAIT_V(4); PG8_BAR;
        PG8_STAGE(PG8_SB(1, 0), cB + kstep, voffB); PG8_STAGE(PG8_SA(1, 0), cA + kstep, voffA); PG8_STAGE(PG8_SB(1, 1), cB + hstep + kstep, voffB);
        PG8_WAIT_V(6); PG8_BAR;
    }
    for (;;) {
        const bool has_next = S.next(ui + 1, nxt);
        const char* nA = has_next ? (const char*)g.A + (size_t)nxt.pm * tstep : cA; const char* nB = has_next ? (const char*)g.Bt + (size_t)nxt.pn * tstep : cB;
        for (int t = 0; t < nt; t += 2) {
            const bool last = (t == nt - 2);
            const char* a1 = cA + (size_t)(t + 1) * kstep;
            const char* a2 = last ? nA : cA + (size_t)(t + 2) * kstep; const char* b2 = last ? nB : cB + (size_t)(t + 2) * kstep;
            const char* a3 = a2 + kstep; const char* b3 = b2 + kstep;
            if (last && has_next) S.a_ready(nxt);
            if constexpr (SP2) {
            PG8_LDB(B0, 0, 0); PG8_LDB(B1, 0, 1); PG8_SCHED; PG8_LDA(At, 0, 0); PG8_STAGE(PG8_SA(1, 1), a1 + hstep, voffA);
            PG8_WAIT_V(8); PG8_WAIT_L(0); PG8_BAR; PG8_MMA(0, 0, At, B0); PG8_MMA(0, 1, At, B1); PG8_BAR; PG8_SCHED;
            PG8_LDA(At, 0, 1); PG8_STAGE(PG8_SB(0, 0), b2, voffB); PG8_STAGE(PG8_SB(0, 1), b2 + hstep, voffB); PG8_STAGE(PG8_SA(0, 0), a2, voffA);
            PG8_WAIT_V(8); PG8_WAIT_L(0); PG8_BAR; PG8_MMA(1, 0, At, B0); PG8_MMA(1, 1, At, B1); PG8_BAR; PG8_SCHED;
            PG8_LDB(B0, 1, 0); PG8_LDB(B1, 1, 1); PG8_SCHED; PG8_LDA(At, 1, 0); PG8_STAGE(PG8_SA(0, 1), a2 + hstep, voffA);
            PG8_WAIT_V(8); PG8_WAIT_L(0); PG8_BAR; PG8_MMA(0, 0, At, B0); PG8_MMA(0, 1, At, B1); PG8_BAR; PG8_SCHED;
            PG8_LDA(At, 1, 1); PG8_STAGE(PG8_SB(1, 0), b3, voffB); PG8_STAGE(PG8_SB(1, 1), b3 + hstep, voffB); PG8_STAGE(PG8_SA(1, 0), a3, voffA);
            PG8_WAIT_V(8); PG8_WAIT_L(0); PG8_BAR; PG8_MMA(1, 0, At, B0); PG8_MMA(1, 1, At, B1); PG8_BAR; PG8_SCHED;
            } else {
            PG8_LDB(B0, 0, 0); PG8_SCHED; PG8_LDA(At, 0, 0); PG8_STAGE(PG8_SA(1, 1), a1 + hstep, voffA);
            PG8_WAIT_L(8); PG8_BAR; PG8_WAIT_L(0); PG8_MMA(0, 0, At, B0); PG8_BAR; PG8_SCHED;
            PG8_LDB(B1, 0, 1); PG8_STAGE(PG8_SB(0, 0), b2, voffB);
            PG8_BAR; PG8_WAIT_L(0); PG8_MMA(0, 1, At, B1); PG8_BAR;
            PG8_LDA(At, 0, 1); PG8_STAGE(PG8_SA(0, 0), a2, voffA);
            PG8_BAR; PG8_WAIT_L(0); PG8_MMA(1, 0, At, B0); PG8_BAR; PG8_SCHED;
            PG8_STAGE(PG8_SB(0, 1), b2 + hstep, voffB);
            PG8_WAIT_V(6); PG8_BAR; PG8_MMA(1, 1, At, B1); PG8_BAR;
            PG8_LDB(B0, 1, 0); PG8_SCHED; PG8_LDA(At, 1, 0); PG8_STAGE(PG8_SA(0, 1), a2 + hstep, voffA);
            PG8_WAIT_L(8); PG8_BAR; PG8_WAIT_L(0); PG8_MMA(0, 0, At, B0); PG8_BAR; PG8_SCHED;
            PG8_LDB(B1, 1, 1); PG8_STAGE(PG8_SB(1, 0), b3, voffB);
            PG8_BAR; PG8_WAIT_L(0); PG8_MMA(0, 1, At, B1); PG8_BAR;
            PG8_LDA(At, 1, 1); PG8_STAGE(PG8_SA(1, 0), a3, voffA);
            PG8_BAR; PG8_WAIT_L(0); PG8_MMA(1, 0, At, B0); PG8_BAR; PG8_SCHED;
            PG8_STAGE(PG8_SB(1, 1), b3 + hstep, voffB);
            PG8_WAIT_V(6); PG8_BAR; PG8_MMA(1, 1, At, B1); PG8_BAR;
            }
        }
        if constexpr (ALIGN_EPI) { if (wr == 0) PG8_BAR; }
        if constexpr (!Epi::AFTER_DRAIN) { E(acc, cur, wr, wc, fr, fq); S.done(cur); }
        if (!has_next) break;
#pragma unroll
        for (int a = 0; a < 2; ++a)
#pragma unroll
            for (int b = 0; b < 2; ++b)
#pragma unroll
                for (int m = 0; m < 4; ++m)
#pragma unroll
                    for (int n = 0; n < 2; ++n) acc[a][b][m][n] = (f32x4){0.f, 0.f, 0.f, 0.f};
        cur = nxt; cA = nA; cB = nB; ++ui;
        if constexpr (ALIGN_EPI) { if (wr == 1) PG8_BAR; }
    }
    PG8_WAIT_V(0);
    if constexpr (!ALIGN_EPI) { if (wr == 0) PG8_BAR; }
    PG8_BAR;
    if constexpr (Epi::AFTER_DRAIN) { E.fused(acc, cur, wr, wc, fr, fq, lds, wid, lane); S.done(cur); }
#undef PG8_SA
#undef PG8_SB
#undef PG8_STAGE
#undef PG8_LDA
#undef PG8_LDB
#undef PG8_MMA
#undef PG8_WAIT_V
#undef PG8_WAIT_L
#undef PG8_BAR
#undef PG8_SCHED
}
}
constexpr int BATCH = 2, SEQ = 4096, M = BATCH * SEQ, DM = 4096, DEPTH = 2, HD = 128;
constexpr int DNW = 1536, LRW = 1536, SGW = 1024, DNH = 12, LRB = 12, SGG = 8, DFF = 11008, DIN = 11288, DINP = 11520;
constexpr int Q0 = 0, K0 = 1536, V0 = 3072, Z0 = 4608, LX0 = 6144, LG0 = 7680, SU0 = 9216, SV0 = 10240, BA0 = 11264;
constexpr float EPS = 1e-6f;
typedef unsigned short bf16;
typedef float f32x4 __attribute__((ext_vector_type(4)));
typedef unsigned u32x4 __attribute__((ext_vector_type(4)));
typedef unsigned u32x2 __attribute__((ext_vector_type(2)));
#define LAS __attribute__((address_space(3)))
__device__ __forceinline__ unsigned f2bf(float f) { unsigned u = __builtin_bit_cast(unsigned, f); return (u + 0x7fffu + ((u >> 16) & 1u)) >> 16; }
__device__ __forceinline__ unsigned pk2(float lo, float hi) { return f2bf(lo) | (f2bf(hi) << 16); }
__device__ __forceinline__ float bf2f(unsigned short b) { return __builtin_bit_cast(float, ((unsigned)b) << 16); }
__device__ __forceinline__ float bflo(unsigned w) { return __builtin_bit_cast(float, w << 16); }
__device__ __forceinline__ float bfhi(unsigned w) { return __builtin_bit_cast(float, w & 0xffff0000u); }
__device__ __forceinline__ float sigmoidf_(float x) { return 1.0f / (1.0f + __expf(-x)); }
__device__ __forceinline__ float siluf_(float x) { return x * sigmoidf_(x); }
__device__ __forceinline__ float geluf_(float x) { const float u = 0.7978845608028654f * (x + 0.044715f * x * x * x); return 0.5f * x * (1.0f + tanhf(u)); }
__device__ __forceinline__ float softplusf_(float x) { return x > 20.f ? x : log1pf(expf(x)); }
__device__ __forceinline__ float wave_sum(float v) {
#pragma unroll
    for (int o = 1; o < 64; o <<= 1) v += __shfl_xor(v, o);
    return v;
}

__device__ __forceinline__ void transpose_item(const float* W, int K, int Nsrc, bf16* WT, int dst_row0, int src_col0, int nvalid, LAS float* scr, int kb, int lane) {
    const int k0 = 64 * kb;
#pragma unroll 8
    for (int i = 0; i < 32; ++i) { const int kk = 2 * i + (lane >> 5), n = lane & 31; scr[kk * 33 + n] = (n < nvalid) ? W[(size_t)(k0 + kk) * Nsrc + src_col0 + n] : 0.f; }
    asm volatile("s_waitcnt lgkmcnt(0)" ::: "memory");
    const int c = lane & 7;
#pragma unroll
    for (int j = 0; j < 4; ++j) { const int n = (lane >> 3) + 8 * j; const LAS float* s = scr + (8 * c) * 33 + n;
        u32x4 o; o.x = pk2(s[0 * 33], s[1 * 33]); o.y = pk2(s[2 * 33], s[3 * 33]); o.z = pk2(s[4 * 33], s[5 * 33]); o.w = pk2(s[6 * 33], s[7 * 33]);
        *(u32x4*)(WT + (size_t)(dst_row0 + n) * K + k0 + 8 * c) = o; }
    asm volatile("s_waitcnt lgkmcnt(0)" ::: "memory");
}
struct EpiResF32 {
    static constexpr bool PERM = false, AFTER_DRAIN = false;
    const float* R; float* C; int ldc;
    __device__ __forceinline__ void operator()(const pg8::f32x4 (&acc)[2][2][4][2], const pg8::Unit& u, int wr, int wc, int fr, int fq) const {
        const int row0 = u.pm * 256 + wr * 64 + fr, col0 = u.pn * 256 + wc * 32 + 4 * fq;
#pragma unroll
        for (int ai = 0; ai < 2; ++ai)
#pragma unroll
            for (int m = 0; m < 4; ++m) { const size_t off = (size_t)(row0 + ai * 128 + m * 16) * ldc + col0;
#pragma unroll
                for (int bj = 0; bj < 2; ++bj)
#pragma unroll
                    for (int n = 0; n < 2; ++n) *(pg8::f32x4*)(C + off + bj * 128 + n * 16) = *(const pg8::f32x4*)(R + off + bj * 128 + n * 16) + acc[ai][bj][m][n]; }
    }
};
#define XB_TMO      128
#define XB_XCNT(j)  (256  + 64 * (j))
#define XB_XSUB(j)  (1280 + 64 * (j))
#define XB_XGEN(j)  (2304 + 64 * (j))
#define XB_TOP      3328
#define XB_TOPGEN   3392
#define XCD_BAR_WORDS 3456
#define XB_SPIN_CAP (1u << 18)

__device__ __forceinline__ unsigned xb_ld(unsigned* p)              { return __hip_atomic_load(p, __ATOMIC_RELAXED, __HIP_MEMORY_SCOPE_AGENT); }
__device__ __forceinline__ unsigned xb_add(unsigned* p, unsigned v) { return __hip_atomic_fetch_add(p, v, __ATOMIC_RELAXED, __HIP_MEMORY_SCOPE_AGENT); }
__device__ __forceinline__ unsigned xb_xcc_id() { return (unsigned)__builtin_amdgcn_s_getreg((3 << 11) | 20) & 0xFu; }
#define XB_SPIN(cond, bar) do { unsigned _sp = 0; while (cond) { __builtin_amdgcn_s_sleep(1); \
    if ((++_sp & 255u) == 0u) { if (xb_ld(&(bar)[XB_TMO])) break; if (_sp > XB_SPIN_CAP) { atomicAdd(&(bar)[XB_TMO], 1u); break; } } } } while (0)

struct XcdBarrier {
    unsigned* bar; unsigned x;
    volatile LAS unsigned* st;
};

__device__ __forceinline__ XcdBarrier xcd_barrier_post(unsigned* bar, volatile LAS unsigned* st) {
    XcdBarrier b; b.bar = bar; b.x = xb_xcc_id(); b.st = st;
    if (threadIdx.x == 0) (void)xb_add(&bar[XB_XCNT(b.x)], 1u);
    return b;
}
__device__ __forceinline__ void xcd_barrier_complete(unsigned* bar, unsigned x, unsigned& nloc, unsigned& nx) {
    const unsigned G = gridDim.x * gridDim.y * gridDim.z;
    unsigned sum, cnt, mine, sp = 0u;
    for (;;) {
        sum = 0u; cnt = 0u; mine = 0u;
#pragma unroll
        for (unsigned j = 0; j < 16; ++j) { const unsigned c = xb_ld(&bar[XB_XCNT(j)]); sum += c; cnt += (c > 0u) ? 1u : 0u; mine = (j == x) ? c : mine; }
        if (sum == G) break;
        __builtin_amdgcn_s_sleep(1);
        if ((++sp & 255u) == 0u) { if (xb_ld(&bar[XB_TMO])) break; if (sp > XB_SPIN_CAP) { atomicAdd(&bar[XB_TMO], 1u); break; } }
    }
    nloc = mine > 0u ? mine : 1u; nx = cnt > 0u ? cnt : 1u;
}

__device__ __forceinline__ void xcd_barrier(const XcdBarrier& b) {
    asm volatile("s_waitcnt vmcnt(0)" ::: "memory");
    __syncthreads();
    if (threadIdx.x == 0) {
        unsigned* bar = b.bar;
        __builtin_amdgcn_s_waitcnt(0);
        unsigned nloc = b.st[0], nx = b.st[1];
        if (nloc == 0u) { xcd_barrier_complete(bar, b.x, nloc, nx); b.st[0] = nloc; b.st[1] = nx; }
        const unsigned old = xb_add(&bar[XB_XSUB(b.x)], 1u);
        const unsigned gen = old / nloc;
        if (old + 1u == (gen + 1u) * nloc) {
            __builtin_amdgcn_fence(__ATOMIC_RELEASE, "agent");
            asm volatile("s_waitcnt vmcnt(0)" ::: "memory");
            const unsigned og = xb_add(&bar[XB_TOP], 1u);
            const unsigned tg = og / nx;
            if (og + 1u == (tg + 1u) * nx) xb_add(&bar[XB_TOPGEN], 1u);
            else XB_SPIN(xb_ld(&bar[XB_TOPGEN]) == tg, bar);
            __builtin_amdgcn_fence(__ATOMIC_ACQUIRE, "agent");
            xb_add(&bar[XB_XGEN(b.x)], 1u);
            asm volatile("s_waitcnt vmcnt(0)" ::: "memory");
        } else {
            XB_SPIN(xb_ld(&bar[XB_XGEN(b.x)]) == gen, bar);
            __builtin_amdgcn_fence(__ATOMIC_ACQUIRE, "agent");
            asm volatile("s_waitcnt vmcnt(0)" ::: "memory");
        }
    }
    __syncthreads();
}

constexpr int NTHR = 512, NWAVES = 8;
constexpr int LDS_BYTES = 163840, MISC_OFF = LDS_BYTES - 256;
typedef short bf16x8 __attribute__((ext_vector_type(8)));
typedef float f32x16 __attribute__((ext_vector_type(16)));
#define MFMA16(a, b, c) __builtin_amdgcn_mfma_f32_16x16x32_bf16((a), (b), (c), 0, 0, 0)
#define MFMA32(a, b, c) __builtin_amdgcn_mfma_f32_32x32x16_bf16((a), (b), (c), 0, 0, 0)
#define WG_SYNC() __syncthreads()
#define RAW_BAR() do { asm volatile("s_waitcnt lgkmcnt(0)" ::: "memory"); __builtin_amdgcn_s_barrier(); asm volatile("" ::: "memory"); } while (0)
__device__ __forceinline__ unsigned cvtpk(float lo, float hi) { unsigned r; asm volatile("v_cvt_pk_bf16_f32 %0, %1, %2" : "=v"(r) : "v"(lo), "v"(hi)); return r; }
__device__ __forceinline__ bf16x8 pack8(f32x4 a, f32x4 b) { u32x4 p; p.x = cvtpk(a.x, a.y); p.y = cvtpk(a.z, a.w); p.z = cvtpk(b.x, b.y); p.w = cvtpk(b.z, b.w); return __builtin_bit_cast(bf16x8, p); }
__device__ __forceinline__ int crow32(int i, int h) { return (i & 3) + 8 * (i >> 2) + 4 * h; }
__device__ __forceinline__ void unpack8(u32x4 w, float (&f)[8]) { f[0] = bflo(w.x); f[1] = bfhi(w.x); f[2] = bflo(w.y); f[3] = bfhi(w.y); f[4] = bflo(w.z); f[5] = bfhi(w.z); f[6] = bflo(w.w); f[7] = bfhi(w.w); }

constexpr size_t MiB = 1u << 20;
constexpr size_t SZ_WIN = (size_t)DINP * DM * 2, SZ_WOUT = (size_t)DM * DM * 2, SZ_WUP = (size_t)2 * DFF * DM * 2, SZ_WDN = (size_t)DM * DFF * 2;
constexpr size_t WS_CTL = 0, CTL_BYTES = 1 * MiB, WS_W = 1 * MiB, SZ_WL = SZ_WIN + SZ_WOUT + SZ_WUP + SZ_WDN;
constexpr size_t WS_HB = WS_W + 2 * SZ_WL, WS_PROJ = WS_HB + (size_t)M * DM * 2, WS_MIX = WS_PROJ + (size_t)M * DINP * 2, WS_XA = WS_MIX + (size_t)M * DM * 2, WS_XB = WS_XA + (size_t)M * DM * 4;
constexpr size_t WS_HID = WS_XB + (size_t)M * DM * 4, WS_ACT = WS_HID + (size_t)M * 2 * DFF * 2, WS_SCR = WS_ACT + (size_t)M * DFF * 2;
constexpr size_t SZ_F1536 = (size_t)M * 1536 * 4, SZ_F1024 = (size_t)M * 1024 * 4;
constexpr size_t WS_QF = WS_SCR, WS_KF = WS_QF + SZ_F1536, WS_VF = WS_KF + SZ_F1536, WS_OF = WS_VF + SZ_F1536, WS_LA = WS_OF + SZ_F1536, WS_LI = WS_LA + SZ_F1536,
                 WS_SV = WS_LI + SZ_F1536, WS_SY = WS_SV + SZ_F1024, WS_BG = WS_SY + SZ_F1024, WS_NAIVE_END = WS_BG + 2 * MiB;
constexpr int DN_UNITS = BATCH * DNH * 64, DN_STAGE = 57344, DN_W_OFF = 0, DN_Q_OFF = 16384, DN_KT_OFF = 32768, DN_AT_OFF = 49152;
constexpr size_t WS_STG = WS_NAIVE_END, WS_UG = WS_STG + (size_t)DN_UNITS * DN_STAGE, WS_DEC = WS_UG + (size_t)DN_UNITS * 32768, WS_HL = WS_DEC + 1 * MiB, WS_PC = WS_HL + SZ_F1536,
                 WS_CAR = WS_PC + SZ_F1536, WS_WAT = WS_CAR + 1 * MiB, WS_WXT = WS_WAT + 1 * MiB, WS_WSB = WS_WXT + 1 * MiB, WS_END = WS_WSB + 1 * MiB;
constexpr int CW_BAR = 4096;

__device__ __forceinline__ void rmsnorm_rows(const float* x, const float* w, bf16* ob, float* of, int gw, int ngw, int lane) {
    for (int row = gw; row < M; row += ngw) {
        const f32x4* xr = (const f32x4*)(x + (size_t)row * DM) + lane; const f32x4* wr = (const f32x4*)w + lane;
        f32x4 v[16]; float s = 0.f;
#pragma unroll
        for (int j = 0; j < 16; ++j) { v[j] = xr[64 * j]; s += (v[j].x * v[j].x + v[j].y * v[j].y) + (v[j].z * v[j].z + v[j].w * v[j].w); }
        const float rstd = 1.0f / sqrtf(wave_sum(s) * (1.0f / DM) + EPS);
        if (ob) {
#pragma unroll
            for (int j = 0; j < 16; ++j) { const f32x4 o = v[j] * rstd * wr[64 * j]; u32x2 p; p.x = pk2(o.x, o.y); p.y = pk2(o.z, o.w); *((u32x2*)(ob + (size_t)row * DM) + lane + 64 * j) = p; }
        } else {
#pragma unroll
            for (int j = 0; j < 16; ++j) { const f32x4 o = v[j] * rstd * wr[64 * j]; *((f32x4*)(of + (size_t)row * DM) + lane + 64 * j) = o; }
        }
    }
}
__device__ __forceinline__ void phase_prologue(LAS unsigned char* lds, const float* const* in, unsigned char* ws, int gw, int ngw, int gtid, int ngt, int wave, int lane) {
    LAS float* scr = (LAS float*)(lds + wave * 8448);
    constexpr int I_IN = (DINP / 32) * (DM / 64), I_OUT = (DM / 32) * (DM / 64), I_UP = (2 * DFF / 32) * (DM / 64), I_DN = (DM / 32) * (DFF / 64), I_L = I_IN + I_OUT + I_UP + I_DN;
    for (int it = gw; it < 2 * I_L; it += ngw) {
        const int l = it / I_L; int r = it % I_L;
        bf16* win = (bf16*)(ws + WS_W + l * SZ_WL); bf16* wout = (bf16*)((unsigned char*)win + SZ_WIN); bf16* wup = (bf16*)((unsigned char*)wout + SZ_WOUT); bf16* wdn = (bf16*)((unsigned char*)wup + SZ_WUP);
        if (r < I_IN) { const int nblk = DINP / 32, kb = r / nblk, n0 = (r % nblk) * 32; int src = n0, nv = 32;
            if (n0 < 6144) { src = n0; } else if (n0 < 11264) { src = n0 + 24; } else if (n0 == 11264) { src = 6144; nv = 24; } else { src = 0; nv = 0; }
            transpose_item(in[2] + (size_t)l * DM * DIN, DM, DIN, win, n0, src, nv, scr, kb, lane); continue; }
        r -= I_IN;
        if (r < I_OUT) { const int nblk = DM / 32; transpose_item(in[20] + (size_t)l * DM * DM, DM, DM, wout, (r % nblk) * 32, (r % nblk) * 32, 32, scr, r / nblk, lane); continue; }
        r -= I_OUT;
        if (r < I_UP) { const int nblk = 2 * DFF / 32; transpose_item(in[22] + (size_t)l * DM * 2 * DFF, DM, 2 * DFF, wup, (r % nblk) * 32, (r % nblk) * 32, 32, scr, r / nblk, lane); continue; }
        r -= I_UP;
        { const int nblk = DM / 32; transpose_item(in[25] + (size_t)l * DFF * DM, DFF, DM, wdn, (r % nblk) * 32, (r % nblk) * 32, 32, scr, r / nblk, lane); }
    }
    bf16* wat = (bf16*)(ws + WS_WAT); bf16* wxt = (bf16*)(ws + WS_WXT); bf16* wsb = (bf16*)(ws + WS_WSB);
    for (int i = gtid; i < DEPTH * LRB * HD * HD; i += ngt) { const int ii = i & 127, j = (i >> 7) & 127, lg = i >> 14; const size_t src = ((size_t)lg * HD + ii) * HD + j;
        wat[i] = (bf16)f2bf(in[9][src]); wxt[i] = (bf16)f2bf(in[11][src]); }
    for (int i = gtid; i < DEPTH * SGG * 128 * 128; i += ngt) { const int s = i & 127, t = (i >> 7) & 127; wsb[i] = (s <= t) ? (bf16)f2bf(in[17][i]) : (bf16)0; }
    rmsnorm_rows(in[0], in[1], (bf16*)(ws + WS_HB), nullptr, gw, ngw, lane);
}

__device__ __forceinline__ void phase_ffn_act(const bf16* hid, const float* cw, const float* cb, bf16* act, int gtid, int ngt) {
    for (size_t gid = gtid; gid < (size_t)M * (DFF / 8); gid += ngt) {
        const int cg = (int)(gid % (DFF / 8)), m = (int)(gid / (DFF / 8)), t = m % SEQ, c0 = cg * 8;
        float ga[8], up[8];
#pragma unroll
        for (int i = 0; i < 8; ++i) { ga[i] = cb[c0 + i]; up[i] = cb[DFF + c0 + i]; }
#pragma unroll
        for (int j = 0; j < 3; ++j) { const int tt = t - 2 + j; if (tt >= 0) {
            const u32x4 hg = *(const u32x4*)(hid + (size_t)(m - 2 + j) * (2 * DFF) + c0), hu = *(const u32x4*)(hid + (size_t)(m - 2 + j) * (2 * DFF) + DFF + c0);
            float g8[8], u8[8]; unpack8(hg, g8); unpack8(hu, u8);
#pragma unroll
            for (int i = 0; i < 8; ++i) { ga[i] += cw[j * 2 * DFF + c0 + i] * g8[i]; up[i] += cw[j * 2 * DFF + DFF + c0 + i] * u8[i]; } } }
        u32x4 o; o.x = pk2(siluf_(ga[0]) * up[0], siluf_(ga[1]) * up[1]); o.y = pk2(siluf_(ga[2]) * up[2], siluf_(ga[3]) * up[3]);
        o.z = pk2(siluf_(ga[4]) * up[4], siluf_(ga[5]) * up[5]); o.w = pk2(siluf_(ga[6]) * up[6], siluf_(ga[7]) * up[7]);
        *(u32x4*)(act + (size_t)m * DFF + c0) = o;
    }
}

__device__ __forceinline__ void dn_prep_unit(LAS unsigned char* lds, int tid, int wave, int lane, int unit, const bf16* proj, const float* convw, const float* a_log, const float* dt_bias,
                                             unsigned char* stg_all, float* ug_all, float* dec_all) {
    const int n = unit & 63, bh = unit >> 6, b = bh / DNH, h = bh % DNH, t0 = n * 64; const size_t m0 = (size_t)b * SEQ + t0;
    LAS float* KS = (LAS float*)(lds); LAS float* VS = (LAS float*)(lds + 33792);
    LAS bf16* QB = (LAS bf16*)(lds + 67584); LAS bf16* KB = (LAS bf16*)(lds + 84992);
    LAS float* AM = (LAS float*)(lds + 102400); LAS float* AT = (LAS float*)(lds + 119808);
    LAS float* SMb = (LAS float*)(lds + 137216);
    unsigned char* stg = stg_all + (size_t)unit * DN_STAGE; float* ug = ug_all + (size_t)unit * 8192;
    if (wave == 0) {
        const size_t m = m0 + lane;
        const float braw = bf2f(proj[m * DINP + BA0 + h]), araw = bf2f(proj[m * DINP + BA0 + DNH + h]);
        const float beta = sigmoidf_(braw), g = -expf(a_log[h]) * softplusf_(araw + dt_bias[h]);
        float gc = g;
#pragma unroll
        for (int o = 1; o < 64; o <<= 1) { const float t = __shfl_up(gc, o); if (lane >= o) gc += t; }
        const float gl = __shfl(gc, 63);
        SMb[lane] = beta; SMb[64 + lane] = gc; SMb[128 + lane] = expf(gc); SMb[192 + lane] = expf(gl - gc); SMb[256 + lane] = beta * expf(gc);
        if (lane == 63) dec_all[unit] = expf(gl);
    }
    WG_SYNC();
    {
        const int rb = tid >> 4, cg = tid & 15;
#pragma unroll
        for (int p = 0; p < 3; ++p) {
            const int c0 = p * DNW + h * HD + cg * 8;
            float w[4][8];
#pragma unroll
            for (int j = 0; j < 4; ++j) { const f32x4 a = *(const f32x4*)(convw + j * 3 * DNW + c0), bq = *(const f32x4*)(convw + j * 3 * DNW + c0 + 4);
                w[j][0] = a.x; w[j][1] = a.y; w[j][2] = a.z; w[j][3] = a.w; w[j][4] = bq.x; w[j][5] = bq.y; w[j][6] = bq.z; w[j][7] = bq.w; }
            float x[5][8];
#pragma unroll
            for (int k = 0; k < 5; ++k) { const int rr = 2 * rb - 3 + k;
                if (t0 + rr >= 0) { const u32x4 v = *(const u32x4*)(proj + (size_t)((long)m0 + rr) * DINP + c0); unpack8(v, x[k]); }
                else {
#pragma unroll
                    for (int i = 0; i < 8; ++i) x[k][i] = 0.f; } }
#pragma unroll
            for (int rr = 0; rr < 2; ++rr) {
                const int row = 2 * rb + rr; float y[8]; float ss = 0.f;
#pragma unroll
                for (int i = 0; i < 8; ++i) { float a = 0.f;
#pragma unroll
                    for (int j = 0; j < 4; ++j) a += w[j][i] * x[rr + j][i];
                    y[i] = siluf_(a); ss += y[i] * y[i]; }
                if (p < 2) { ss += __shfl_xor(ss, 1); ss += __shfl_xor(ss, 2); ss += __shfl_xor(ss, 4); ss += __shfl_xor(ss, 8); const float rn = 1.0f / sqrtf(ss + EPS);
#pragma unroll
                    for (int i = 0; i < 8; ++i) y[i] *= rn; }
                if (p == 0) {
                    u32x4 pk; pk.x = cvtpk(y[0], y[1]); pk.y = cvtpk(y[2], y[3]); pk.z = cvtpk(y[4], y[5]); pk.w = cvtpk(y[6], y[7]);
                    *(LAS u32x4*)(QB + row * 136 + cg * 8) = pk;
                    const float sc = SMb[128 + row] * 0.08838834764831845f;
                    const int mt = row >> 4, rp = row & 15, s = cg >> 2, jj = (cg & 3) >> 1, q0 = 2 * (cg & 1);
                    u32x2 a0, a1; a0.x = cvtpk(y[0] * sc, y[1] * sc); a0.y = cvtpk(y[2] * sc, y[3] * sc); a1.x = cvtpk(y[4] * sc, y[5] * sc); a1.y = cvtpk(y[6] * sc, y[7] * sc);
                    bf16* qf = (bf16*)(stg + DN_Q_OFF);
                    *(u32x2*)(qf + ((size_t)((mt * 4 + s) * 64 + q0 * 16 + rp)) * 8 + 4 * jj) = a0;
                    *(u32x2*)(qf + ((size_t)((mt * 4 + s) * 64 + (q0 + 1) * 16 + rp)) * 8 + 4 * jj) = a1;
                } else if (p == 1) {
                    *(LAS f32x4*)(KS + row * 132 + cg * 8) = (f32x4){y[0], y[1], y[2], y[3]}; *(LAS f32x4*)(KS + row * 132 + cg * 8 + 4) = (f32x4){y[4], y[5], y[6], y[7]};
                    u32x4 pk; pk.x = cvtpk(y[0], y[1]); pk.y = cvtpk(y[2], y[3]); pk.z = cvtpk(y[4], y[5]); pk.w = cvtpk(y[6], y[7]);
                    *(LAS u32x4*)(KB + row * 136 + cg * 8) = pk;
                } else {
                    const float bt = SMb[row];
                    *(LAS f32x4*)(VS + row * 132 + cg * 8) = (f32x4){y[0] * bt, y[1] * bt, y[2] * bt, y[3] * bt}; *(LAS f32x4*)(VS + row * 132 + cg * 8 + 4) = (f32x4){y[4] * bt, y[5] * bt, y[6] * bt, y[7] * bt};
                }
            }
        }
    }
    WG_SYNC();
    {
        const int p = wave >> 2, mt = wave & 3, r = lane & 15, q = lane >> 4;
        LAS bf16* Aop = p ? QB : KB;
#pragma unroll
        for (int nt = 0; nt < 4; ++nt) {
            if (nt <= mt) {
                f32x4 acc = (f32x4){0.f, 0.f, 0.f, 0.f};
#pragma unroll
                for (int s = 0; s < 4; ++s) { const bf16x8 a = *(const LAS bf16x8*)(Aop + (16 * mt + r) * 136 + 32 * s + 8 * q), bb = *(const LAS bf16x8*)(KB + (16 * nt + r) * 136 + 32 * s + 8 * q);
                    acc = MFMA16(a, bb, acc); }
                const int jc = 16 * nt + r; const float gj = SMb[64 + jc];
#pragma unroll
                for (int i = 0; i < 4; ++i) { const int ir = 16 * mt + 4 * q + i; const float gi = SMb[64 + ir]; float v;
                    if (p == 0) v = (ir > jc) ? SMb[ir] * acc[i] * expf(gi - gj) : 0.f; else v = (ir >= jc) ? acc[i] * expf(gi - gj) * 0.08838834764831845f : 0.f;
                    if (p == 0) AM[jc * 68 + ir] = v; else AT[ir * 68 + jc] = v; }
            } else {
#pragma unroll
                for (int i = 0; i < 4; ++i) { if (p == 0) AM[(16 * nt + r) * 68 + 16 * mt + 4 * q + i] = 0.f; else AT[(16 * mt + 4 * q + i) * 68 + 16 * nt + r] = 0.f; }
            }
        }
    }
    WG_SYNC();
    { const int ch = tid, mt = ch >> 7, s = (ch >> 6) & 1, ln = ch & 63, rp = ln & 15, q = ln >> 4, row = 16 * mt + rp;
        const f32x4 a0 = *(const LAS f32x4*)(AT + row * 68 + 32 * s + 4 * q), a1 = *(const LAS f32x4*)(AT + row * 68 + 32 * s + 16 + 4 * q);
        u32x4 pk; pk.x = cvtpk(a0.x, a0.y); pk.y = cvtpk(a0.z, a0.w); pk.z = cvtpk(a1.x, a1.y); pk.w = cvtpk(a1.z, a1.w);
        *(u32x4*)(stg + DN_AT_OFF + (size_t)ch * 16) = pk; }
#pragma unroll
    for (int k = 0; k < 2; ++k) { const int ch = tid + 512 * k, mt = ch >> 7, s = (ch >> 6) & 1, ln = ch & 63, rp = ln & 15, q = ln >> 4, d = 16 * mt + rp; float v[8];
#pragma unroll
        for (int j = 0; j < 8; ++j) { const int c = 32 * s + 16 * (j >> 2) + 4 * q + (j & 3); v[j] = KS[c * 132 + d] * SMb[192 + c]; }
        u32x4 pk; pk.x = cvtpk(v[0], v[1]); pk.y = cvtpk(v[2], v[3]); pk.z = cvtpk(v[4], v[5]); pk.w = cvtpk(v[6], v[7]);
        *(u32x4*)(stg + DN_KT_OFF + (size_t)ch * 16) = pk; }
    WG_SYNC();
    if (tid < 256) {
        const int col = tid; const bool isv = col < 128; LAS float* xcol = isv ? (VS + col) : (KS + (col - 128));
#pragma unroll 1
        for (int ib = 0; ib < 8; ++ib) {
            const int i0 = 8 * ib; float acc[8];
#pragma unroll
            for (int rr = 0; rr < 8; ++rr) { const float v = xcol[(i0 + rr) * 132]; acc[rr] = isv ? v : v * SMb[256 + i0 + rr]; }
#pragma unroll 4
            for (int j = 0; j < i0; ++j) { const float xj = xcol[j * 132]; const f32x4 a0 = *(const LAS f32x4*)(AM + j * 68 + i0), a1 = *(const LAS f32x4*)(AM + j * 68 + i0 + 4);
                acc[0] -= a0.x * xj; acc[1] -= a0.y * xj; acc[2] -= a0.z * xj; acc[3] -= a0.w * xj; acc[4] -= a1.x * xj; acc[5] -= a1.y * xj; acc[6] -= a1.z * xj; acc[7] -= a1.w * xj; }
#pragma unroll
            for (int c = 0; c < 7; ++c) { const f32x4 a0 = *(const LAS f32x4*)(AM + (i0 + c) * 68 + i0), a1 = *(const LAS f32x4*)(AM + (i0 + c) * 68 + i0 + 4);
                const float av[8] = {a0.x, a0.y, a0.z, a0.w, a1.x, a1.y, a1.z, a1.w};
#pragma unroll
                for (int rr = c + 1; rr < 8; ++rr) acc[rr] -= av[rr] * acc[c]; }
#pragma unroll
            for (int rr = 0; rr < 8; ++rr) xcol[(i0 + rr) * 132] = acc[rr];
        }
    }
    WG_SYNC();
#pragma unroll
    for (int k = 0; k < 4; ++k) { const int ch = tid + 512 * k, wv = ch >> 8, ct = (ch >> 6) & 3, ln = ch & 63, r = ln & 15, q = ln >> 4, c = 16 * ct + 4 * q, e = 16 * wv + r;
        const f32x4 v = (f32x4){VS[c * 132 + e], VS[(c + 1) * 132 + e], VS[(c + 2) * 132 + e], VS[(c + 3) * 132 + e]};
        *(f32x4*)(ug + (size_t)ch * 4) = v; }
#pragma unroll
    for (int k = 0; k < 2; ++k) { const int ch = tid + 512 * k, mt = ch >> 8, s = (ch >> 6) & 3, ln = ch & 63, rp = ln & 15, q = ln >> 4, row = 16 * mt + rp;
        const f32x4 a0 = *(const LAS f32x4*)(KS + row * 132 + 32 * s + 4 * q), a1 = *(const LAS f32x4*)(KS + row * 132 + 32 * s + 16 + 4 * q);
        u32x4 pk; pk.x = cvtpk(-a0.x, -a0.y); pk.y = cvtpk(-a0.z, -a0.w); pk.z = cvtpk(-a1.x, -a1.y); pk.w = cvtpk(-a1.z, -a1.w);
        *(u32x4*)(stg + DN_W_OFF + (size_t)ch * 16) = pk; }
    WG_SYNC();
}

__device__ __forceinline__ void dn_scan_bh(LAS unsigned char* lds, int tid, int wave, int lane, int bh, const unsigned char* stg_all, const float* ug_all, const float* dec_all,
                                           const bf16* proj, const float* normw, bf16* mix) {
    const int b = bh / DNH, h = bh % DNH, r = lane & 15, q = lane >> 4;
    LAS float* OB = (LAS float*)(lds + 2 * DN_STAGE);
    f32x4 S[8];
#pragma unroll
    for (int i = 0; i < 8; ++i) S[i] = (f32x4){0.f, 0.f, 0.f, 0.f};
    const unsigned char* stg_bh = stg_all + (size_t)bh * 64 * DN_STAGE; const float* ug_bh = ug_all + (size_t)bh * 64 * 8192;
    const int prow = tid >> 3, pcg = tid & 7;
    f32x4 nw[4];
#pragma unroll
    for (int k = 0; k < 4; ++k) nw[k] = *(const f32x4*)(normw + 16 * pcg + 4 * k);
#define DN_DMA(n_, buf_) do { const unsigned char* g_ = stg_bh + (size_t)(n_) * DN_STAGE; _Pragma("unroll") for (int k_ = 0; k_ < 7; ++k_) \
        __builtin_amdgcn_global_load_lds((const unsigned*)(g_ + (size_t)((wave * 7 + k_) * 1024 + lane * 16)), (LAS unsigned*)(lds + (buf_) * DN_STAGE + (wave * 7 + k_) * 1024), 16, 0, 0); } while (0)
    DN_DMA(0, 0);
    f32x4 ucur[4];
#pragma unroll
    for (int ct = 0; ct < 4; ++ct) ucur[ct] = *(const f32x4*)(ug_bh + (size_t)((wave * 4 + ct) * 64 + lane) * 4);
    u32x4 zprev[2] = {(u32x4){0u, 0u, 0u, 0u}, (u32x4){0u, 0u, 0u, 0u}};
    for (int n = 0; n <= 64; ++n) {
        asm volatile("s_waitcnt vmcnt(0)" ::: "memory"); RAW_BAR();
        f32x4 unext[4]; u32x4 zcur[2]; float dec = 0.f;
        if (n < 64) {
            if (n + 1 < 64) { DN_DMA(n + 1, (n + 1) & 1);
#pragma unroll
                for (int ct = 0; ct < 4; ++ct) unext[ct] = *(const f32x4*)(ug_bh + (size_t)(n + 1) * 8192 + (size_t)((wave * 4 + ct) * 64 + lane) * 4); }
            else {
#pragma unroll
                for (int ct = 0; ct < 4; ++ct) unext[ct] = (f32x4){0.f, 0.f, 0.f, 0.f}; }
            dec = dec_all[bh * 64 + n];
            const bf16* zp = proj + ((size_t)b * SEQ + n * 64 + prow) * DINP + Z0 + h * HD + 16 * pcg;
            zcur[0] = *(const u32x4*)zp; zcur[1] = *(const u32x4*)(zp + 8);
        }
        if (n > 0) {
            f32x4 v[4]; float ss = 0.f;
#pragma unroll
            for (int k = 0; k < 4; ++k) { v[k] = *(const LAS f32x4*)(OB + prow * 132 + 16 * pcg + 4 * k); ss += (v[k].x * v[k].x + v[k].y * v[k].y) + (v[k].z * v[k].z + v[k].w * v[k].w); }
            ss += __shfl_xor(ss, 1); ss += __shfl_xor(ss, 2); ss += __shfl_xor(ss, 4);
            const float rstd = 1.0f / sqrtf(ss * (1.0f / HD) + EPS);
            float z[16]; { float t8[8]; unpack8(zprev[0], t8);
#pragma unroll
                for (int i = 0; i < 8; ++i) z[i] = t8[i]; unpack8(zprev[1], t8);
#pragma unroll
                for (int i = 0; i < 8; ++i) z[8 + i] = t8[i]; }
            float o16[16];
#pragma unroll
            for (int k = 0; k < 4; ++k) { o16[4 * k] = v[k].x * rstd * nw[k].x * siluf_(z[4 * k]); o16[4 * k + 1] = v[k].y * rstd * nw[k].y * siluf_(z[4 * k + 1]);
                o16[4 * k + 2] = v[k].z * rstd * nw[k].z * siluf_(z[4 * k + 2]); o16[4 * k + 3] = v[k].w * rstd * nw[k].w * siluf_(z[4 * k + 3]); }
            u32x4 p0, p1; p0.x = cvtpk(o16[0], o16[1]); p0.y = cvtpk(o16[2], o16[3]); p0.z = cvtpk(o16[4], o16[5]); p0.w = cvtpk(o16[6], o16[7]);
            p1.x = cvtpk(o16[8], o16[9]); p1.y = cvtpk(o16[10], o16[11]); p1.z = cvtpk(o16[12], o16[13]); p1.w = cvtpk(o16[14], o16[15]);
            bf16* mp = mix + ((size_t)b * SEQ + (n - 1) * 64 + prow) * DM + h * HD + 16 * pcg;
            *(u32x4*)mp = p0; *(u32x4*)(mp + 8) = p1;
        }
        if (n == 64) break;
        const LAS unsigned char* st = lds + (n & 1) * DN_STAGE;
        bf16x8 Sb[4];
#pragma unroll
        for (int s = 0; s < 4; ++s) Sb[s] = pack8(S[2 * s], S[2 * s + 1]);
        f32x4 vn[4], o[4];
#pragma unroll
        for (int ct = 0; ct < 4; ++ct) { vn[ct] = ucur[ct]; o[ct] = (f32x4){0.f, 0.f, 0.f, 0.f}; }
#pragma unroll
        for (int ct = 0; ct < 4; ++ct)
#pragma unroll
            for (int s = 0; s < 4; ++s) { const bf16x8 a = *(const LAS bf16x8*)(st + DN_W_OFF + ((ct * 4 + s) * 64 + lane) * 16); vn[ct] = MFMA16(a, Sb[s], vn[ct]); }
#pragma unroll
        for (int ct = 0; ct < 4; ++ct)
#pragma unroll
            for (int s = 0; s < 4; ++s) { const bf16x8 a = *(const LAS bf16x8*)(st + DN_Q_OFF + ((ct * 4 + s) * 64 + lane) * 16); o[ct] = MFMA16(a, Sb[s], o[ct]); }
        bf16x8 Vb[2];
#pragma unroll
        for (int s = 0; s < 2; ++s) Vb[s] = pack8(vn[2 * s], vn[2 * s + 1]);
#pragma unroll
        for (int ct = 0; ct < 4; ++ct)
#pragma unroll
            for (int s = 0; s < 2; ++s) { const bf16x8 a = *(const LAS bf16x8*)(st + DN_AT_OFF + ((ct * 2 + s) * 64 + lane) * 16); o[ct] = MFMA16(a, Vb[s], o[ct]); }
#pragma unroll
        for (int dt = 0; dt < 8; ++dt) { S[dt] = S[dt] * dec;
#pragma unroll
            for (int s = 0; s < 2; ++s) { const bf16x8 a = *(const LAS bf16x8*)(st + DN_KT_OFF + ((dt * 2 + s) * 64 + lane) * 16); S[dt] = MFMA16(a, Vb[s], S[dt]); } }
        RAW_BAR();
#pragma unroll
        for (int ct = 0; ct < 4; ++ct)
#pragma unroll
            for (int i = 0; i < 4; ++i) OB[(16 * ct + 4 * q + i) * 132 + 16 * wave + r] = o[ct][i];
#pragma unroll
        for (int ct = 0; ct < 4; ++ct) ucur[ct] = unext[ct];
        zprev[0] = zcur[0]; zprev[1] = zcur[1];
    }
#undef DN_DMA
    asm volatile("s_waitcnt vmcnt(0) lgkmcnt(0)" ::: "memory"); __builtin_amdgcn_s_barrier(); asm volatile("" ::: "memory");
}

__device__ __forceinline__ void lru1_unit(LAS unsigned char* lds, int tid, int wave, int lane, int unit, const bf16* proj, const float* convw, const float* convb, const bf16* wat, const bf16* wxt,
                                          const float* ba, const float* bx, const float* lam, float* HL, float* PC, float* CAR) {
    const int rb = unit & 31, bg = unit >> 5, b = bg / LRB, g = bg % LRB, t0 = rb * 128, cb = g * HD; const size_t m0 = (size_t)b * SEQ + t0;
    LAS float* XC = (LAS float*)lds; LAS float* AA = (LAS float*)(lds + 67584); LAS float* SE = (LAS float*)(lds + 135168);
    {
        const int rq = tid >> 4, cg = tid & 15, c0 = cb + 8 * cg; float w[4][8], bias[8];
#pragma unroll
        for (int j = 0; j < 4; ++j) { const f32x4 a = *(const f32x4*)(convw + j * LRW + c0), bq = *(const f32x4*)(convw + j * LRW + c0 + 4);
            w[j][0] = a.x; w[j][1] = a.y; w[j][2] = a.z; w[j][3] = a.w; w[j][4] = bq.x; w[j][5] = bq.y; w[j][6] = bq.z; w[j][7] = bq.w; }
        { const f32x4 a = *(const f32x4*)(convb + c0), bq = *(const f32x4*)(convb + c0 + 4); bias[0] = a.x; bias[1] = a.y; bias[2] = a.z; bias[3] = a.w; bias[4] = bq.x; bias[5] = bq.y; bias[6] = bq.z; bias[7] = bq.w; }
        float x[7][8];
#pragma unroll
        for (int k = 0; k < 7; ++k) { const int rr = 4 * rq - 3 + k;
            if (t0 + rr >= 0) { const u32x4 v = *(const u32x4*)(proj + (size_t)((long)m0 + rr) * DINP + LX0 + c0); unpack8(v, x[k]); }
            else {
#pragma unroll
                for (int i = 0; i < 8; ++i) x[k][i] = 0.f; } }
#pragma unroll
        for (int rr = 0; rr < 4; ++rr) { float y[8];
#pragma unroll
            for (int i = 0; i < 8; ++i) { float a = bias[i];
#pragma unroll
                for (int j = 0; j < 4; ++j) a += w[j][i] * x[rr + j][i];
                y[i] = a; }
            *(LAS f32x4*)(XC + (4 * rq + rr) * 132 + 8 * cg) = (f32x4){y[0], y[1], y[2], y[3]}; *(LAS f32x4*)(XC + (4 * rq + rr) * 132 + 8 * cg + 4) = (f32x4){y[4], y[5], y[6], y[7]}; }
    }
    WG_SYNC();
    {
        const int mt = wave & 3, nh = wave >> 2, r = lane & 31, hh = lane >> 5;
        f32x16 accA[2], accX[2];
#pragma unroll
        for (int nt = 0; nt < 2; ++nt)
#pragma unroll
            for (int i = 0; i < 16; ++i) { accA[nt][i] = 0.f; accX[nt][i] = 0.f; }
#pragma unroll
        for (int s = 0; s < 8; ++s) {
            const f32x4 a0 = *(const LAS f32x4*)(XC + (32 * mt + r) * 132 + 16 * s + 8 * hh), a1 = *(const LAS f32x4*)(XC + (32 * mt + r) * 132 + 16 * s + 8 * hh + 4);
            const bf16x8 a = pack8(a0, a1);
#pragma unroll
            for (int nt = 0; nt < 2; ++nt) { const int j = 64 * nh + 32 * nt + r; const size_t wo = ((size_t)(g * HD + j)) * HD + 16 * s + 8 * hh;
                const bf16x8 b1 = *(const bf16x8*)(wat + wo), b2 = *(const bf16x8*)(wxt + wo);
                accA[nt] = MFMA32(a, b1, accA[nt]); accX[nt] = MFMA32(a, b2, accX[nt]); }
        }
        WG_SYNC();
#pragma unroll
        for (int nt = 0; nt < 2; ++nt) { const int j = 64 * nh + 32 * nt + r, c = cb + j; const float sp = softplusf_(-lam[c]), bA = ba[c], bX = bx[c];
#pragma unroll
            for (int i = 0; i < 16; ++i) { const int t = 32 * mt + crow32(i, hh); const float xc = XC[t * 132 + j];
                const float rr = sigmoidf_(accA[nt][i] + bA), ig = sigmoidf_(accX[nt][i] + bX), la = -8.0f * rr * sp;
                AA[t * 132 + j] = expf(la); XC[t * 132 + j] = sqrtf(-expm1f(2.0f * la)) * (ig * xc); } }
    }
    WG_SYNC();
    {
        const int j = tid & 127, sg = tid >> 7; float P = 1.f, H = 0.f;
#pragma unroll 4
        for (int tt = 0; tt < 32; ++tt) { const int o = (32 * sg + tt) * 132 + j; const float a = AA[o]; H = a * H + XC[o]; P *= a; XC[o] = H; AA[o] = P; }
        SE[(sg * 128 + j) * 2] = P; SE[(sg * 128 + j) * 2 + 1] = H;
        WG_SYNC();
        float Pin = 1.f, Hin = 0.f;
        for (int s2 = 0; s2 < sg; ++s2) { const float Pe = SE[(s2 * 128 + j) * 2], He = SE[(s2 * 128 + j) * 2 + 1]; Hin = Pe * Hin + He; Pin *= Pe; }
#pragma unroll 4
        for (int tt = 0; tt < 32; ++tt) { const int t = 32 * sg + tt, o = t * 132 + j; const size_t go = (m0 + t) * LRW + cb + j; HL[go] = XC[o] + AA[o] * Hin; PC[go] = AA[o] * Pin; }
        if (sg == 3) { const float Pe = SE[(3 * 128 + j) * 2], He = SE[(3 * 128 + j) * 2 + 1]; CAR[((size_t)unit * 128 + j) * 2] = Pin * Pe; CAR[((size_t)unit * 128 + j) * 2 + 1] = Pe * Hin + He; }
    }
    WG_SYNC();
}
__device__ __forceinline__ void lru3_unit(LAS unsigned char* lds, int tid, int unit, const bf16* proj, const float* HL, const float* PC, const float* CAR, const float* normw, bf16* mix) {
    const int rb = unit & 31, bg = unit >> 5, b = bg / LRB, g = bg % LRB, t0 = rb * 128, cb = g * HD; const size_t m0 = (size_t)b * SEQ + t0;
    LAS float* HIN = (LAS float*)lds;
    if (tid < 128) { float H = 0.f; for (int u2 = 0; u2 < rb; ++u2) { const size_t o = ((size_t)(bg * 32 + u2) * 128 + tid) * 2; H = CAR[o] * H + CAR[o + 1]; } HIN[tid] = H; }
    WG_SYNC();
    const int row = tid >> 2, part = tid & 3, c0 = cb + 32 * part; const size_t m = m0 + row;
    float y[32]; float ss = 0.f;
#pragma unroll
    for (int k = 0; k < 4; ++k) { const u32x4 gv = *(const u32x4*)(proj + m * DINP + LG0 + c0 + 8 * k); float g8[8]; unpack8(gv, g8);
#pragma unroll
        for (int hf = 0; hf < 2; ++hf) { const f32x4 hl = *(const f32x4*)(HL + m * LRW + c0 + 8 * k + 4 * hf), pc = *(const f32x4*)(PC + m * LRW + c0 + 8 * k + 4 * hf);
#pragma unroll
            for (int i = 0; i < 4; ++i) { const int ci = 8 * k + 4 * hf + i; const float hv = hl[i] + pc[i] * HIN[32 * part + ci]; const float yv = hv * geluf_(g8[4 * hf + i]); y[ci] = yv; ss += yv * yv; } } }
    ss += __shfl_xor(ss, 1); ss += __shfl_xor(ss, 2);
    const float rstd = 1.0f / sqrtf(ss * (1.0f / HD) + EPS);
#pragma unroll
    for (int k = 0; k < 4; ++k) { const f32x4 w0 = *(const f32x4*)(normw + c0 + 8 * k), w1 = *(const f32x4*)(normw + c0 + 8 * k + 4);
        u32x4 pk; pk.x = cvtpk(y[8 * k] * rstd * w0.x, y[8 * k + 1] * rstd * w0.y); pk.y = cvtpk(y[8 * k + 2] * rstd * w0.z, y[8 * k + 3] * rstd * w0.w);
        pk.z = cvtpk(y[8 * k + 4] * rstd * w1.x, y[8 * k + 5] * rstd * w1.y); pk.w = cvtpk(y[8 * k + 6] * rstd * w1.z, y[8 * k + 7] * rstd * w1.w);
        *(u32x4*)(mix + m * DM + DNW + c0 + 8 * k) = pk; }
    WG_SYNC();
}

__device__ __forceinline__ void sg_unit(LAS unsigned char* lds, int tid, int wave, int lane, int unit, const bf16* proj, const float* lnw, const float* lnb, const bf16* wsb, const float* bs, const float* normw, bf16* mix) {
    const int g = unit & 7, bn = unit >> 3; const size_t m0 = (size_t)bn * 128;
    LAS bf16* VT = (LAS bf16*)lds; LAS float* YB = (LAS float*)(lds + 34816); LAS float* MU = (LAS float*)(lds + 102400);
    for (int k = 0; k < 16; ++k) { const int tk = 16 * wave + k; const bf16* p = proj + (m0 + tk) * DINP + SV0 + 8 * lane; float s = 0.f, s2 = 0.f;
#pragma unroll
        for (int jj = 0; jj < 2; ++jj) { const u32x4 v = *(const u32x4*)(p + 512 * jj); float f[8]; unpack8(v, f);
#pragma unroll
            for (int i = 0; i < 8; ++i) { const float gv = geluf_(f[i]); s += gv; s2 += gv * gv; } }
        s = wave_sum(s); s2 = wave_sum(s2);
        if (lane == 0) { const float mu = s * (1.0f / SGW); float var = s2 * (1.0f / SGW) - mu * mu; var = var > 0.f ? var : 0.f; MU[tk] = mu; MU[128 + tk] = 1.0f / sqrtf(var + EPS); } }
    WG_SYNC();
    {
        const int s_ = tid >> 2, part = tid & 3; const float mu = MU[s_], rs = MU[128 + s_];
#pragma unroll
        for (int k = 0; k < 4; ++k) { const u32x4 v = *(const u32x4*)(proj + (m0 + s_) * DINP + SV0 + g * HD + 32 * part + 8 * k); float f[8]; unpack8(v, f);
            const f32x4 w0 = *(const f32x4*)(lnw + g * HD + 32 * part + 8 * k), w1 = *(const f32x4*)(lnw + g * HD + 32 * part + 8 * k + 4), b0 = *(const f32x4*)(lnb + g * HD + 32 * part + 8 * k), b1 = *(const f32x4*)(lnb + g * HD + 32 * part + 8 * k + 4);
            const float ww[8] = {w0.x, w0.y, w0.z, w0.w, w1.x, w1.y, w1.z, w1.w}, bb[8] = {b0.x, b0.y, b0.z, b0.w, b1.x, b1.y, b1.z, b1.w};
#pragma unroll
            for (int i = 0; i < 8; ++i) VT[(32 * part + 8 * k + i) * 136 + s_] = (bf16)f2bf((geluf_(f[i]) - mu) * rs * ww[i] + bb[i]); }
    }
    WG_SYNC();
    {
        const int mt = wave & 3, nh = wave >> 2, r = lane & 31, hh = lane >> 5;
        f32x16 acc[2];
#pragma unroll
        for (int nt = 0; nt < 2; ++nt)
#pragma unroll
            for (int i = 0; i < 16; ++i) acc[nt][i] = 0.f;
        for (int s = 0; s < 2 * mt + 2; ++s) { const bf16x8 a = *(const bf16x8*)(wsb + ((size_t)(g * 128 + 32 * mt + r)) * 128 + 16 * s + 8 * hh);
#pragma unroll
            for (int nt = 0; nt < 2; ++nt) { const bf16x8 bb = *(const LAS bf16x8*)(VT + (64 * nh + 32 * nt + r) * 136 + 16 * s + 8 * hh); acc[nt] = MFMA32(a, bb, acc[nt]); } }
#pragma unroll
        for (int nt = 0; nt < 2; ++nt) { const int c = 64 * nh + 32 * nt + r;
#pragma unroll
            for (int i = 0; i < 16; ++i) { const int t = 32 * mt + crow32(i, hh); const float z = acc[nt][i] + bs[g * 128 + t];
                YB[t * 132 + c] = geluf_(bf2f(proj[(m0 + t) * DINP + SU0 + g * HD + c])) * z; } }
    }
    WG_SYNC();
    {
        const int t = tid >> 2, part = tid & 3; f32x4 v[8]; float ss = 0.f;
#pragma unroll
        for (int k = 0; k < 8; ++k) { v[k] = *(const LAS f32x4*)(YB + t * 132 + 32 * part + 4 * k); ss += (v[k].x * v[k].x + v[k].y * v[k].y) + (v[k].z * v[k].z + v[k].w * v[k].w); }
        ss += __shfl_xor(ss, 1); ss += __shfl_xor(ss, 2);
        const float rstd = 1.0f / sqrtf(ss * (1.0f / HD) + EPS);
#pragma unroll
        for (int k = 0; k < 4; ++k) { const f32x4 w0 = *(const f32x4*)(normw + g * HD + 32 * part + 8 * k), w1 = *(const f32x4*)(normw + g * HD + 32 * part + 8 * k + 4);
            u32x4 pk; pk.x = cvtpk(v[2 * k].x * rstd * w0.x, v[2 * k].y * rstd * w0.y); pk.y = cvtpk(v[2 * k].z * rstd * w0.z, v[2 * k].w * rstd * w0.w);
            pk.z = cvtpk(v[2 * k + 1].x * rstd * w1.x, v[2 * k + 1].y * rstd * w1.y); pk.w = cvtpk(v[2 * k + 1].z * rstd * w1.z, v[2 * k + 1].w * rstd * w1.w);
            *(u32x4*)(mix + (m0 + t) * DM + DNW + LRW + g * HD + 32 * part + 8 * k) = pk; }
    }
    WG_SYNC();
}
#ifndef USE_DN
#define USE_DN 1
#endif
#ifndef USE_LRU
#define USE_LRU 1
#endif
#ifndef USE_SG
#define USE_SG 1
#endif
#define LAUNDER() int tid = tid0, bx = bx0, G = G0; asm volatile("" : "+v"(tid), "+s"(bx), "+s"(G)); const int lane = tid & 63, wave = __builtin_amdgcn_readfirstlane(tid >> 6), gw = bx * NWAVES + wave, ngw = G * NWAVES, gtid = bx * NTHR + tid, ngt = G * NTHR; (void)lane; (void)wave; (void)gw; (void)ngw; (void)gtid; (void)ngt
constexpr int N_PHASES = 1 + 9 * DEPTH;
struct Args { const float* in[27]; float* out; unsigned char* ws; int ph_lo, ph_hi, li, pad; };
__global__ void __launch_bounds__(NTHR, 2) mega(Args a) {
    extern __shared__ __attribute__((aligned(16))) unsigned char lds_raw[];
    LAS unsigned char* lds = (LAS unsigned char*)lds_raw;
    const int tid0 = threadIdx.x, G0 = gridDim.x, bx0 = blockIdx.x;
    volatile LAS unsigned* MISC = (volatile LAS unsigned*)(lds + MISC_OFF);
    if (tid0 < 64) MISC[tid0] = 0u;
    __syncthreads();
    unsigned char* ws = a.ws;
    XcdBarrier bar = xcd_barrier_post((unsigned*)(ws + WS_CTL) + CW_BAR + a.li * XCD_BAR_WORDS, MISC + 8);
    const int lo = a.ph_lo, hi = a.ph_hi;
#define IN(k) (lo <= (k) && (k) < hi)
#define SEAM(k) do { if (IN(k) && IN((k) + 1)) xcd_barrier(bar); } while (0)
    bf16* hb = (bf16*)(ws + WS_HB); bf16* proj = (bf16*)(ws + WS_PROJ); bf16* mix = (bf16*)(ws + WS_MIX); float* xa = (float*)(ws + WS_XA); float* xb = (float*)(ws + WS_XB);
    bf16* hid = (bf16*)(ws + WS_HID); bf16* act = (bf16*)(ws + WS_ACT);
    unsigned char* stg = ws + WS_STG; float* ug = (float*)(ws + WS_UG); float* decg = (float*)(ws + WS_DEC); float* HL = (float*)(ws + WS_HL); float* PC = (float*)(ws + WS_PC); float* CAR = (float*)(ws + WS_CAR);

    if (IN(0)) { LAUNDER(); phase_prologue(lds, a.in, ws, gw, ngw, gtid, ngt, wave, lane); }
    SEAM(0);
    for (int l = 0; l < DEPTH; ++l) {
        const int pb = 1 + 9 * l;
        const float* xin = (l == 0) ? a.in[0] : (const float*)xb;
        const bf16* win = (const bf16*)(ws + WS_W + l * SZ_WL); const bf16* wout = (const bf16*)((const unsigned char*)win + SZ_WIN);
        const bf16* wup = (const bf16*)((const unsigned char*)wout + SZ_WOUT); const bf16* wdn = (const bf16*)((const unsigned char*)wup + SZ_WUP);
        if (IN(pb + 0)) { LAUNDER(); pg8::Gemm g{hb, win, M, DINP, DM}; pg8::StaticOrder S; S.init(M, DINP, G, bx); pg8::EpiBf16<0> E{proj, DINP, nullptr, 0, 0, 1.f};
            pg8::gemm_phase<pg8::EpiBf16<0>, pg8::StaticOrder, true, true>(lds, g, S, E); }
        SEAM(pb + 0);
        if (IN(pb + 1)) { LAUNDER();
#if USE_DN
            for (int u = bx; u < DN_UNITS; u += G) dn_prep_unit(lds, tid, wave, lane, u, proj, a.in[3] + (size_t)l * 4 * 3 * DNW, a.in[4] + l * DNH, a.in[5] + l * DNH, stg, ug, decg);
#endif
#if USE_LRU
            for (int u = bx; u < BATCH * LRB * 32; u += G) lru1_unit(lds, tid, wave, lane, u, proj, a.in[7] + (size_t)l * 4 * LRW, a.in[8] + l * LRW, (const bf16*)(ws + WS_WAT) + (size_t)l * LRB * HD * HD,
                                                                   (const bf16*)(ws + WS_WXT) + (size_t)l * LRB * HD * HD, a.in[10] + l * LRW, a.in[12] + l * LRW, a.in[13] + l * LRW, HL, PC, CAR);
#endif
        }
        SEAM(pb + 1);
        if (IN(pb + 2)) { LAUNDER();
            if (bx < BATCH * DNH && G > BATCH * DNH) {
#if USE_DN
                dn_scan_bh(lds, tid, wave, lane, bx, stg, ug, decg, proj, a.in[6] + l * HD, mix);
#endif
            } else {
                const int wb = bx - BATCH * DNH, nwb = G - BATCH * DNH;
#if USE_LRU
                for (int u = wb; u < BATCH * LRB * 32; u += nwb) lru3_unit(lds, tid, u, proj, HL, PC, CAR, a.in[14] + l * LRW, mix);
#endif
#if USE_SG
                for (int u = wb; u < BATCH * 32 * SGG; u += nwb) sg_unit(lds, tid, wave, lane, u, proj, a.in[15] + l * SGW, a.in[16] + l * SGW, (const bf16*)(ws + WS_WSB) + (size_t)l * SGG * 128 * 128,
                                                                         a.in[18] + l * SGG * 128, a.in[19] + l * SGW, mix);
#endif
            }
        }
        SEAM(pb + 2);
        if (IN(pb + 3)) { LAUNDER(); pg8::Gemm g{mix, wout, M, DM, DM}; pg8::StaticOrder S; S.init(M, DM, G, bx); EpiResF32 E{xin, xa, DM};
            pg8::gemm_phase<EpiResF32, pg8::StaticOrder, true, true>(lds, g, S, E); }
        SEAM(pb + 3);
        if (IN(pb + 4)) { LAUNDER(); rmsnorm_rows(xa, a.in[21] + l * DM, hb, nullptr, gw, ngw, lane); }
        SEAM(pb + 4);
        if (IN(pb + 5)) { LAUNDER(); pg8::Gemm g{hb, wup, M, 2 * DFF, DM}; pg8::StaticOrder S; S.init(M, 2 * DFF, G, bx); pg8::EpiBf16<0> E{hid, 2 * DFF, nullptr, 0, 0, 1.f};
            pg8::gemm_phase<pg8::EpiBf16<0>, pg8::StaticOrder, true, true>(lds, g, S, E); }
        SEAM(pb + 5);
        if (IN(pb + 6)) { LAUNDER(); phase_ffn_act(hid, a.in[23] + (size_t)l * 3 * 2 * DFF, a.in[24] + (size_t)l * 2 * DFF, act, gtid, ngt); }
        SEAM(pb + 6);
        if (IN(pb + 7)) { LAUNDER(); pg8::Gemm g{act, wdn, M, DM, DFF}; pg8::StaticOrder S; S.init(M, DM, G, bx); EpiResF32 E{xa, xb, DM};
            pg8::gemm_phase<EpiResF32, pg8::StaticOrder, true, true>(lds, g, S, E); }
        SEAM(pb + 7);
        if (IN(pb + 8)) { LAUNDER(); if (l + 1 < DEPTH) rmsnorm_rows(xb, a.in[1] + (l + 1) * DM, hb, nullptr, gw, ngw, lane); else rmsnorm_rows(xb, a.in[26], nullptr, a.out, gw, ngw, lane); }
        SEAM(pb + 8);
    }
#undef IN
#undef SEAM
}

extern "C" void kernel_launch(void* const* d_in, const int* in_sizes, int n_in, void* d_out, int out_size, void* d_ws, size_t ws_size, hipStream_t stream) {
    if (n_in != 27 || out_size != M * DM || ws_size < WS_END) { fprintf(stderr, "kernel_launch: unexpected shapes (n_in %d out %d ws %zu need %zu)\n", n_in, out_size, ws_size, (size_t)WS_END); return; }
    static int grid = 0;
    if (grid == 0) {
        int dev = 0, cus = 0, per_cu = 0;
        if (hipGetDevice(&dev) != hipSuccess || hipDeviceGetAttribute(&cus, hipDeviceAttributeMultiprocessorCount, dev) != hipSuccess) { fprintf(stderr, "kernel_launch: device query failed\n"); grid = -1; return; }
        if (hipFuncSetAttribute((const void*)mega, hipFuncAttributeMaxDynamicSharedMemorySize, LDS_BYTES) != hipSuccess) { fprintf(stderr, "kernel_launch: hipFuncSetAttribute(%d B LDS) failed\n", LDS_BYTES); grid = -1; return; }
        if (hipOccupancyMaxActiveBlocksPerMultiprocessor(&per_cu, (const void*)mega, NTHR, LDS_BYTES) != hipSuccess || per_cu < 1) { fprintf(stderr, "kernel_launch: occupancy query says %d blocks/CU\n", per_cu); }
        (void)hipGetLastError();
        grid = cus;
    }
    if (grid < 0) return;
    const float* const* in = (const float* const*)d_in; unsigned char* ws = (unsigned char*)d_ws;
    (void)hipMemsetAsync(ws + WS_CTL, 0, CTL_BYTES, stream);
    Args a{}; for (int i = 0; i < 27; ++i) a.in[i] = in[i]; a.out = (float*)d_out; a.ws = ws; a.pad = 0;
    int li = 0;
    auto launch = [&](int lo, int hi) { a.ph_lo = lo; a.ph_hi = hi; a.li = li++; hipLaunchKernelGGL(mega, dim3(grid), dim3(NTHR), LDS_BYTES, stream, a); };
#if USE_DN && USE_LRU && USE_SG
    launch(0, N_PHASES);
#else
    bf16* proj = (bf16*)(ws + WS_PROJ); bf16* mix = (bf16*)(ws + WS_MIX);
    float *qf = (float*)(ws + WS_QF), *kf = (float*)(ws + WS_KF), *vf = (float*)(ws + WS_VF), *of = (float*)(ws + WS_OF), *la = (float*)(ws + WS_LA), *lif = (float*)(ws + WS_LI), *sv = (float*)(ws + WS_SV), *sy = (float*)(ws + WS_SY);
    float* beta = (float*)(ws + WS_BG); float* gg = beta + M * DNH;
    int cur = 0;
    for (int l = 0; l < DEPTH; ++l) {
        const int pb = 1 + 9 * l;
        launch(cur, pb + 1); cur = pb + 1;
#if !USE_DN
        hipLaunchKernelGGL(k_dn_prep, dim3(M * DNH), dim3(128), 0, stream, (const bf16*)proj, in[3] + (size_t)l * 4 * 3 * DNW, in[4] + l * DNH, in[5] + l * DNH, qf, kf, vf, beta, gg);
        hipLaunchKernelGGL(k_dn_scan, dim3(BATCH * DNH), dim3(128), 0, stream, (const float*)qf, (const float*)kf, (const float*)vf, (const float*)beta, (const float*)gg, of);
        hipLaunchKernelGGL(k_groupnorm, dim3(M * DNH / 4), dim3(256), 0, stream, (const float*)of, DNW, in[6] + l * HD, (const bf16*)proj, mix, 0, 0);
#endif
#if !USE_LRU
        hipLaunchKernelGGL(k_lru_gates, dim3(M * LRB), dim3(128), 0, stream, (const bf16*)proj, in[7] + (size_t)l * 4 * LRW, in[8] + l * LRW, in[9] + (size_t)l * LRB * HD * HD, in[10] + l * LRW, in[11] + (size_t)l * LRB * HD * HD, in[12] + l * LRW, in[13] + l * LRW, la, lif);
        hipLaunchKernelGGL(k_lru_scan, dim3(BATCH * LRW / 64), dim3(64), 0, stream, (const float*)la, lif, (const bf16*)proj);
        hipLaunchKernelGGL(k_groupnorm, dim3(M * LRB / 4), dim3(256), 0, stream, (const float*)lif, LRW, in[14] + l * LRW, (const bf16*)proj, mix, DNW, 1);
#endif
#if !USE_SG
        hipLaunchKernelGGL(k_sg_ln, dim3(M), dim3(256), 0, stream, (const bf16*)proj, in[15] + l * SGW, in[16] + l * SGW, sv);
        hipLaunchKernelGGL(k_sg_mix, dim3(BATCH * (SEQ / 128) * SGG), dim3(128), 0, stream, (const float*)sv, in[17] + (size_t)l * SGG * 128 * 128, in[18] + l * SGG * 128, (const bf16*)proj, sy);
        hipLaunchKernelGGL(k_groupnorm, dim3(M * SGG / 4), dim3(256), 0, stream, (const float*)sy, SGW, in[19] + l * SGW, (const bf16*)proj, mix, DNW + LRW, 1);
#endif
    }
    launch(cur, N_PHASES);
#endif
}
```

```cpp
#include <hip/hip_runtime.h>
#include <cstdio>
#include <cstdint>
#define USE_DN 1
#define USE_LRU 1
#define USE_SG 1
#define DUP_MASK 0
#define DUP_SUB 0
namespace pg8 {
#define PG8_LAS __attribute__((address_space(3)))
typedef unsigned short bf16_t;
typedef short bf16x8 __attribute__((ext_vector_type(8)));
typedef float f32x4 __attribute__((ext_vector_type(4)));
typedef unsigned u32x4 __attribute__((ext_vector_type(4)));
constexpr int BM = 256, BK = 64, HALF = 128, HTB = HALF * BK * 2  , STAGE_BYTES = 8 * HTB, NXCD = 8, WGM = 8;

__host__ __device__ __forceinline__ int lds_byte(int r, int c) { const int st = (r >> 4) * 2 + (c >> 5), rr = r & 15, cc = c & 31, ob = rr * 64 + cc * 2; return st * 1024 + (ob ^ (((ob >> 9) & 1) << 5)); }
__host__ __device__ __forceinline__ void stage_rc(int b, int& R, int& C) { const int st = b / 1024, sb = b % 1024, swz = sb ^ (((sb >> 9) & 1) << 5); R = (st >> 1) * 16 + swz / 64; C = (st & 1) * 32 + (swz % 64) / 2; }
__host__ __device__ __forceinline__ int perm32(int rho) { const int n = rho >> 4, i = rho & 15; return 8 * (i >> 2) + 4 * n + (i & 3); }

struct Unit { int pm, pn; };
struct Gemm { const bf16_t* A; const bf16_t* Bt; int M, N, K; };

struct StaticOrder {
    int nM, nN, nwg, G, c;
    __host__ __device__ void init(int M, int N, int G_, int c_) { nM = M / BM; nN = N / BM; nwg = nM * nN; G = G_; c = c_; }
    __host__ __device__ bool next(int i, Unit& u) const {
        const long L = (long)i * G + c; if (L >= nwg) return false;
        int wgid = (int)L; { const int q = nwg / NXCD, r = nwg % NXCD, xcd = wgid % NXCD, off = wgid / NXCD; wgid = (xcd < r ? xcd * (q + 1) : r * (q + 1) + (xcd - r) * q) + off; }
        const int nig = WGM * nN, gid = wgid / nig, fm = gid * WGM, gsz = (nM - fm) < WGM ? (nM - fm) : WGM;
        u.pm = fm + ((wgid % nig) % gsz); u.pn = (wgid % nig) / gsz; return true;
    }
    __device__ __forceinline__ void a_ready(const Unit&) const {}
    __device__ __forceinline__ void done(const Unit&) const {}
};

__device__ __forceinline__ unsigned cvt_pk_bf16(float lo, float hi) { unsigned r; asm volatile("v_cvt_pk_bf16_f32 %0, %1, %2" : "=v"(r) : "v"(lo), "v"(hi)); return r; }
typedef float f32x2 __attribute__((ext_vector_type(2)));
__device__ __forceinline__ f32x2 gelu_pk(f32x2 v) {
    const f32x2 av = __builtin_elementwise_abs(v), d = av * 0.2316418882f + 1.0f;
    f32x2 t; t.x = __builtin_amdgcn_rcpf(d.x); t.y = __builtin_amdgcn_rcpf(d.y);
    f32x2 q = t * 0.5307027145f + (-0.7265760135f); q = q * t + 0.7107068705f; q = q * t + (-0.142248368f); q = q * t + 0.127414796f; q = q * t;
    const f32x2 s = (v * v) * (-0.72134752044f);
    f32x2 e; e.x = __builtin_amdgcn_exp2f(s.x); e.y = __builtin_amdgcn_exp2f(s.y);
    const f32x2 m = v * (q * e), r = v - m;
    f32x2 o; o.x = v.x < 0.f ? m.x : r.x; o.y = v.y < 0.f ? m.y : r.y; return o;
}

template <int ACT  > struct EpiBf16 {
    static constexpr bool PERM = true, AFTER_DRAIN = false; static_assert(ACT == 0 || ACT == 1, "EpiBf16: ACT is 0 (none) or 1 (gelu_pk)");
    bf16_t* O; int ldc; const float* bias; int split_cols; size_t split_stride; float scale0;
    __device__ __forceinline__ void operator()(const f32x4 (&acc)[2][2][4][2], const Unit& u, int wr, int wc, int fr, int fq) const {
        const int row0 = u.pm * BM + wr * 64 + fr; int colt = u.pn * BM; bf16_t* base = O;
        float sc = 1.f; if (split_cols) { const int t = colt / split_cols; base += (size_t)t * split_stride; colt -= t * split_cols; if (t == 0) sc = scale0; }
        const int col0 = colt + wc * 32 + 8 * fq, bcol0 = u.pn * BM + wc * 32 + 8 * fq;
        f32x4 bv[2][2];
#pragma unroll
        for (int bj = 0; bj < 2; ++bj)
#pragma unroll
            for (int n = 0; n < 2; ++n) bv[bj][n] = bias ? *(const f32x4*)(bias + bcol0 + bj * HALF + 4 * n) : (f32x4){0.f, 0.f, 0.f, 0.f};
#pragma unroll
        for (int ai = 0; ai < 2; ++ai)
#pragma unroll
            for (int m = 0; m < 4; ++m) { bf16_t* rowp = base + (size_t)(row0 + ai * HALF + m * 16) * ldc + col0;
#pragma unroll
                for (int bj = 0; bj < 2; ++bj) { f32x4 v0 = acc[ai][bj][m][0] + bv[bj][0], v1 = acc[ai][bj][m][1] + bv[bj][1];
                    if (ACT == 1) { f32x2 a = gelu_pk((f32x2){v0[0], v0[1]}), b = gelu_pk((f32x2){v0[2], v0[3]}), c = gelu_pk((f32x2){v1[0], v1[1]}), d = gelu_pk((f32x2){v1[2], v1[3]});
                        v0 = (f32x4){a.x, a.y, b.x, b.y}; v1 = (f32x4){c.x, c.y, d.x, d.y}; }
                    v0 = v0 * sc; v1 = v1 * sc; u32x4 w; w.x = cvt_pk_bf16(v0[0], v0[1]); w.y = cvt_pk_bf16(v0[2], v0[3]); w.z = cvt_pk_bf16(v1[0], v1[1]); w.w = cvt_pk_bf16(v1[2], v1[3]);
                    *(u32x4*)(rowp + bj * HALF) = w; } }
    }
};

template <class Epi, class Sched, bool ALIGN_EPI = false, bool SP2 = false>
__device__ __forceinline__ void gemm_phase(PG8_LAS unsigned char* lds, const Gemm g, const Sched& S, const Epi& E) {
    int tid_l = threadIdx.x; asm volatile("" : "+v"(tid_l));
    const int tid = tid_l, wid = __builtin_amdgcn_readfirstlane(tid >> 6), lane = tid & 63, wr = wid >> 2, wc = wid & 3, fr = lane & 15, fq = lane >> 4;
    const int K = g.K, nt = K / BK;
    unsigned voffA[2], voffB[2];
#pragma unroll
    for (int i = 0; i < 2; ++i) { int R, C; stage_rc(tid * 16 + i * 8192, R, C); const int Rb = Epi::PERM ? ((R & ~31) + perm32(R & 31)) : R;
        voffA[i] = (unsigned)(R * K + C) * 2u; voffB[i] = (unsigned)(Rb * K + C) * 2u; }
    const size_t kstep = (size_t)(BK * 2);
    const size_t hstep = (size_t)HALF * K * 2;
    const size_t tstep = 2 * hstep;
    const unsigned ldsw = (unsigned)wid * 1024u;
    const int aoff = lds_byte(wr * 64 + fr, fq * 8), boff = lds_byte(wc * 32 + fr, fq * 8);
#define PG8_SA(b, h) (((b) * 2 + (h)) * HTB)
#define PG8_SB(b, h) ((4 + (b) * 2 + (h)) * HTB)
#define PG8_STAGE(bufoff, gbase, voff) do { _Pragma("unroll") for (int _i = 0; _i < 2; ++_i) \
        __builtin_amdgcn_global_load_lds((const unsigned*)((const char*)(gbase) + (voff)[_i]), (PG8_LAS unsigned*)(lds + (bufoff) + ldsw + _i * 8192), 16, 0, 0); } while (0)
#define PG8_LDA(dst, b, h) do { _Pragma("unroll") for (int m = 0; m < 4; ++m) _Pragma("unroll") for (int k = 0; k < 2; ++k) dst[m][k] = *(const PG8_LAS bf16x8*)(lds + PG8_SA(b, h) + aoff + m * 2048 + k * 1024); } while (0)
#define PG8_LDB(dst, b, h) do { _Pragma("unroll") for (int n = 0; n < 2; ++n) _Pragma("unroll") for (int k = 0; k < 2; ++k) dst[n][k] = *(const PG8_LAS bf16x8*)(lds + PG8_SB(b, h) + boff + n * 2048 + k * 1024); } while (0)
#define PG8_MMA(ai, bj, At, Bt) do { __builtin_amdgcn_s_setprio(1); _Pragma("unroll") for (int m = 0; m < 4; ++m) _Pragma("unroll") for (int n = 0; n < 2; ++n) _Pragma("unroll") for (int k = 0; k < 2; ++k) \
        acc[ai][bj][m][n] = __builtin_amdgcn_mfma_f32_16x16x32_bf16(Bt[n][k], At[m][k], acc[ai][bj][m][n], 0, 0, 0); __builtin_amdgcn_s_setprio(0); } while (0)
#define PG8_WAIT_V(n) asm volatile("s_waitcnt vmcnt(" #n ")" ::: "memory")
#define PG8_WAIT_L(n) asm volatile("s_waitcnt lgkmcnt(" #n ")" ::: "memory")
#define PG8_BAR __builtin_amdgcn_s_barrier()
#define PG8_SCHED __builtin_amdgcn_sched_barrier(0)
    Unit cur, nxt; int ui = 0;
    if (!S.next(0, cur)) return;
    f32x4 acc[2][2][4][2];
#pragma unroll
    for (int a = 0; a < 2; ++a)
#pragma unroll
        for (int b = 0; b < 2; ++b)
#pragma unroll
            for (int m = 0; m < 4; ++m)
#pragma unroll
                for (int n = 0; n < 2; ++n) acc[a][b][m][n] = (f32x4){0.f, 0.f, 0.f, 0.f};
    bf16x8 At[4][2], B0[2][2], B1[2][2];
    const char* cA = (const char*)g.A + (size_t)cur.pm * tstep; const char* cB = (const char*)g.Bt + (size_t)cur.pn * tstep;
    S.a_ready(cur);
    if constexpr (SP2) {
        PG8_STAGE(PG8_SB(0, 0), cB, voffB); PG8_STAGE(PG8_SB(0, 1), cB + hstep, voffB); PG8_STAGE(PG8_SA(0, 0), cA, voffA); PG8_STAGE(PG8_SA(0, 1), cA + hstep, voffA);
        if (wr == 1) PG8_BAR;
        PG8_WAIT_V(2); PG8_BAR;
        PG8_STAGE(PG8_SB(1, 0), cB + kstep, voffB); PG8_STAGE(PG8_SA(1, 0), cA + kstep, voffA); PG8_STAGE(PG8_SB(1, 1), cB + hstep + kstep, voffB);
        PG8_WAIT_V(6); PG8_BAR;
    } else {
        PG8_STAGE(PG8_SB(0, 0), cB, voffB); PG8_STAGE(PG8_SA(0, 0), cA, voffA); PG8_STAGE(PG8_SB(0, 1), cB + hstep, voffB); PG8_STAGE(PG8_SA(0, 1), cA + hstep, voffA);
        if (wr == 1) PG8_BAR;
        PG8_WAIT_V(4); PG8_BAR;
        PG8_STAGE(PG8_SB(1, 0), cB + kstep, voffB); PG8_STAGE(PG8_SA(1, 0), cA + kstep, voffA); PG8_STAGE(PG8_SB(1, 1), cB + hstep + kstep, voffB);
        PG8_WAIT_V(6); PG8_BAR;
    }
    for (;;) {
        const bool has_next = S.next(ui + 1, nxt);
        const char* nA = has_next ? (const char*)g.A + (size_t)nxt.pm * tstep : cA; const char* nB = has_next ? (const char*)g.Bt + (size_t)nxt.pn * tstep : cB;
        for (int t = 0; t < nt; t += 2) {
            const bool last = (t == nt - 2);
            const char* a1 = cA + (size_t)(t + 1) * kstep;
            const char* a2 = last ? nA : cA + (size_t)(t + 2) * kstep; const char* b2 = last ? nB : cB + (size_t)(t + 2) * kstep;
            const char* a3 = a2 + kstep; const char* b3 = b2 + kstep;
            if (last && has_next) S.a_ready(nxt);
            if constexpr (SP2) {
            PG8_LDB(B0, 0, 0); PG8_LDB(B1, 0, 1); PG8_SCHED; PG8_LDA(At, 0, 0); PG8_STAGE(PG8_SA(1, 1), a1 + hstep, voffA);
            PG8_WAIT_V(8); PG8_WAIT_L(0); PG8_BAR; PG8_MMA(0, 0, At, B0); PG8_MMA(0, 1, At, B1); PG8_BAR; PG8_SCHED;
            PG8_LDA(At, 0, 1); PG8_STAGE(PG8_SB(0, 0), b2, voffB); PG8_STAGE(PG8_SB(0, 1), b2 + hstep, voffB); PG8_STAGE(PG8_SA(0, 0), a2, voffA);
            PG8_WAIT_V(8); PG8_WAIT_L(0); PG8_BAR; PG8_MMA(1, 0, At, B0); PG8_MMA(1, 1, At, B1); PG8_BAR; PG8_SCHED;
            PG8_LDB(B0, 1, 0); PG8_LDB(B1, 1, 1); PG8_SCHED; PG8_LDA(At, 1, 0); PG8_STAGE(PG8_SA(0, 1), a2 + hstep, voffA);
            PG8_WAIT_V(8); PG8_WAIT_L(0); PG8_BAR; PG8_MMA(0, 0, At, B0); PG8_MMA(0, 1, At, B1); PG8_BAR; PG8_SCHED;
            PG8_LDA(At, 1, 1); PG8_STAGE(PG8_SB(1, 0), b3, voffB); PG8_STAGE(PG8_SB(1, 1), b3 + hstep, voffB); PG8_STAGE(PG8_SA(1, 0), a3, voffA);
            PG8_WAIT_V(8); PG8_WAIT_L(0); PG8_BAR; PG8_MMA(1, 0, At, B0); PG8_MMA(1, 1, At, B1); PG8_BAR; PG8_SCHED;
            } else {
            PG8_LDB(B0, 0, 0); PG8_SCHED; PG8_LDA(At, 0, 0); PG8_STAGE(PG8_SA(1, 1), a1 + hstep, voffA);
            PG8_WAIT_L(8); PG8_BAR; PG8_WAIT_L(0); PG8_MMA(0, 0, At, B0); PG8_BAR; PG8_SCHED;
            PG8_LDB(B1, 0, 1); PG8_STAGE(PG8_SB(0, 0), b2, voffB);
            PG8_BAR; PG8_WAIT_L(0); PG8_MMA(0, 1, At, B1); PG8_BAR;
            PG8_LDA(At, 0, 1); PG8_STAGE(PG8_SA(0, 0), a2, voffA);
            PG8_BAR; PG8_WAIT_L(0); PG8_MMA(1, 0, At, B0); PG8_BAR; PG8_SCHED;
            PG8_STAGE(PG8_SB(0, 1), b2 + hstep, voffB);
            PG8_WAIT_V(6); PG8_BAR; PG8_MMA(1, 1, At, B1); PG8_BAR;
            PG8_LDB(B0, 1, 0); PG8_SCHED; PG8_LDA(At, 1, 0); PG8_STAGE(PG8_SA(0, 1), a2 + hstep, voffA);
            PG8_WAIT_L(8); PG8_BAR; PG8_WAIT_L(0); PG8_MMA(0, 0, At, B0); PG8_BAR; PG8_SCHED;
            PG8_LDB(B1, 1, 1); PG8_STAGE(PG8_SB(1, 0), b3, voffB);
            PG8_BAR; PG8_WAIT_L(0); PG8_MMA(0, 1, At, B1); PG8_BAR;
            PG8_LDA(At, 1, 1); PG8_STAGE(PG8_SA(1, 0), a3, voffA);
            PG8_BAR; PG8_WAIT_L(0); PG8_MMA(1, 0, At, B0); PG8_BAR; PG8_SCHED;
            PG8_STAGE(PG8_SB(1, 1), b3 + hstep, voffB);
            PG8_WAIT_V(6); PG8_BAR; PG8_MMA(1, 1, At, B1); PG8_BAR;
            }
        }
        if constexpr (ALIGN_EPI) { if (wr == 0) PG8_BAR; }
        if constexpr (!Epi::AFTER_DRAIN) { E(acc, cur, wr, wc, fr, fq); S.done(cur); }
        if (!has_next) break;
#pragma unroll
        for (int a = 0; a < 2; ++a)
#pragma unroll
            for (int b = 0; b < 2; ++b)
#pragma unroll
                for (int m = 0; m < 4; ++m)
#pragma unroll
                    for (int n = 0; n < 2; ++n) acc[a][b][m][n] = (f32x4){0.f, 0.f, 0.f, 0.f};
        cur = nxt; cA = nA; cB = nB; ++ui;
        if constexpr (ALIGN_EPI) { if (wr == 1) PG8_BAR; }
    }
    PG8_WAIT_V(0);
    if constexpr (!ALIGN_EPI) { if (wr == 0) PG8_BAR; }
    PG8_BAR;
    if constexpr (Epi::AFTER_DRAIN) { E.fused(acc, cur, wr, wc, fr, fq, lds, wid, lane); S.done(cur); }
#undef PG8_SA
#undef PG8_SB
#undef PG8_STAGE
#undef PG8_LDA
#undef PG8_LDB
#undef PG8_MMA
#undef PG8_WAIT_V
#undef PG8_WAIT_L
#undef PG8_BAR
#undef PG8_SCHED
}
}
constexpr int BATCH = 2, SEQ = 4096, M = BATCH * SEQ, DM = 4096, DEPTH = 2, HD = 128;
constexpr int DNW = 1536, LRW = 1536, SGW = 1024, DNH = 12, LRB = 12, SGG = 8, DFF = 11008, DIN = 11288, DINP = 11520;
constexpr int Q0 = 0, K0 = 1536, V0 = 3072, Z0 = 4608, LX0 = 6144, LG0 = 7680, SU0 = 9216, SV0 = 10240, BA0 = 11264;
constexpr float EPS = 1e-6f;
typedef unsigned short bf16;
typedef float f32x4 __attribute__((ext_vector_type(4)));
typedef unsigned u32x4 __attribute__((ext_vector_type(4)));
typedef unsigned u32x2 __attribute__((ext_vector_type(2)));
#define LAS __attribute__((address_space(3)))
__device__ __forceinline__ unsigned f2bf(float f) { unsigned u = __builtin_bit_cast(unsigned, f); return (u + 0x7fffu + ((u >> 16) & 1u)) >> 16; }
__device__ __forceinline__ unsigned pk2(float lo, float hi) { return f2bf(lo) | (f2bf(hi) << 16); }
__device__ __forceinline__ float bf2f(unsigned short b) { return __builtin_bit_cast(float, ((unsigned)b) << 16); }
__device__ __forceinline__ float bflo(unsigned w) { return __builtin_bit_cast(float, w << 16); }
__device__ __forceinline__ float bfhi(unsigned w) { return __builtin_bit_cast(float, w & 0xffff0000u); }
__device__ __forceinline__ float rcpf_(float x) { return __builtin_amdgcn_rcpf(x); }
__device__ __forceinline__ float sigmoidf_(float x) { return rcpf_(1.0f + __expf(-x)); }
__device__ __forceinline__ float siluf_(float x) { return x * sigmoidf_(x); }
__device__ __forceinline__ float geluf_(float x) { const float u2 = 1.5957691216057308f * (x + 0.044715f * x * x * x); return x * rcpf_(1.0f + __expf(-u2)); }
__device__ __forceinline__ float softplusf_(float x) { return x > 20.f ? x : log1pf(expf(x)); }
__device__ __forceinline__ float wave_sum(float v) {
#pragma unroll
    for (int o = 1; o < 64; o <<= 1) v += __shfl_xor(v, o);
    return v;
}

__device__ __forceinline__ void transpose_item(const float* W, int K, int Nsrc, bf16* WT, int dst_row0, int src_col0, int nvalid, LAS float* scr, int kb, int lane) {
    const int k0 = 64 * kb;
#pragma unroll 8
    for (int i = 0; i < 32; ++i) { const int kk = 2 * i + (lane >> 5), n = lane & 31; scr[kk * 33 + n] = (n < nvalid) ? W[(size_t)(k0 + kk) * Nsrc + src_col0 + n] : 0.f; }
    asm volatile("s_waitcnt lgkmcnt(0)" ::: "memory");
    const int c = lane & 7;
#pragma unroll
    for (int j = 0; j < 4; ++j) { const int n = (lane >> 3) + 8 * j; const LAS float* s = scr + (8 * c) * 33 + n;
        u32x4 o; o.x = pk2(s[0 * 33], s[1 * 33]); o.y = pk2(s[2 * 33], s[3 * 33]); o.z = pk2(s[4 * 33], s[5 * 33]); o.w = pk2(s[6 * 33], s[7 * 33]);
        *(u32x4*)(WT + (size_t)(dst_row0 + n) * K + k0 + 8 * c) = o; }
    asm volatile("s_waitcnt lgkmcnt(0)" ::: "memory");
}
struct EpiResF32 {
    static constexpr bool PERM = false, AFTER_DRAIN = false;
    const float* R; float* C; int ldc;
    __device__ __forceinline__ void operator()(const pg8::f32x4 (&acc)[2][2][4][2], const pg8::Unit& u, int wr, int wc, int fr, int fq) const {
        const int row0 = u.pm * 256 + wr * 64 + fr, col0 = u.pn * 256 + wc * 32 + 4 * fq;
#pragma unroll
        for (int ai = 0; ai < 2; ++ai)
#pragma unroll
            for (int m = 0; m < 4; ++m) { const size_t off = (size_t)(row0 + ai * 128 + m * 16) * ldc + col0;
#pragma unroll
                for (int bj = 0; bj < 2; ++bj)
#pragma unroll
                    for (int n = 0; n < 2; ++n) *(pg8::f32x4*)(C + off + bj * 128 + n * 16) = *(const pg8::f32x4*)(R + off + bj * 128 + n * 16) + acc[ai][bj][m][n]; }
    }
};
#define XB_TMO      128
#define XB_XCNT(j)  (256  + 64 * (j))
#define XB_XSUB(j)  (1280 + 64 * (j))
#define XB_XGEN(j)  (2304 + 64 * (j))
#define XB_TOP      3328
#define XB_TOPGEN   3392
#define XCD_BAR_WORDS 3456
#define XB_SPIN_CAP (1u << 18)

__device__ __forceinline__ unsigned xb_ld(unsigned* p)              { return __hip_atomic_load(p, __ATOMIC_RELAXED, __HIP_MEMORY_SCOPE_AGENT); }
__device__ __forceinline__ unsigned xb_add(unsigned* p, unsigned v) { return __hip_atomic_fetch_add(p, v, __ATOMIC_RELAXED, __HIP_MEMORY_SCOPE_AGENT); }
__device__ __forceinline__ unsigned xb_xcc_id() { return (unsigned)__builtin_amdgcn_s_getreg((3 << 11) | 20) & 0xFu; }
#define XB_SPIN(cond, bar) do { unsigned _sp = 0; while (cond) { __builtin_amdgcn_s_sleep(1); \
    if ((++_sp & 255u) == 0u) { if (xb_ld(&(bar)[XB_TMO])) break; if (_sp > XB_SPIN_CAP) { atomicAdd(&(bar)[XB_TMO], 1u); break; } } } } while (0)

struct XcdBarrier {
    unsigned* bar; unsigned x;
    volatile LAS unsigned* st;
};

__device__ __forceinline__ XcdBarrier xcd_barrier_post(unsigned* bar, volatile LAS unsigned* st) {
    XcdBarrier b; b.bar = bar; b.x = xb_xcc_id(); b.st = st;
    if (threadIdx.x == 0) (void)xb_add(&bar[XB_XCNT(b.x)], 1u);
    return b;
}
__device__ __forceinline__ void xcd_barrier_complete(unsigned* bar, unsigned x, unsigned& nloc, unsigned& nx) {
    const unsigned G = gridDim.x * gridDim.y * gridDim.z;
    unsigned sum, cnt, mine, sp = 0u;
    for (;;) {
        sum = 0u; cnt = 0u; mine = 0u;
#pragma unroll
        for (unsigned j = 0; j < 16; ++j) { const unsigned c = xb_ld(&bar[XB_XCNT(j)]); sum += c; cnt += (c > 0u) ? 1u : 0u; mine = (j == x) ? c : mine; }
        if (sum == G) break;
        __builtin_amdgcn_s_sleep(1);
        if ((++sp & 255u) == 0u) { if (xb_ld(&bar[XB_TMO])) break; if (sp > XB_SPIN_CAP) { atomicAdd(&bar[XB_TMO], 1u); break; } }
    }
    nloc = mine > 0u ? mine : 1u; nx = cnt > 0u ? cnt : 1u;
}

__device__ __forceinline__ void xcd_barrier(const XcdBarrier& b) {
    asm volatile("s_waitcnt vmcnt(0)" ::: "memory");
    __syncthreads();
    if (threadIdx.x == 0) {
        unsigned* bar = b.bar;
        __builtin_amdgcn_s_waitcnt(0);
        unsigned nloc = b.st[0], nx = b.st[1];
        if (nloc == 0u) { xcd_barrier_complete(bar, b.x, nloc, nx); b.st[0] = nloc; b.st[1] = nx; }
        const unsigned old = xb_add(&bar[XB_XSUB(b.x)], 1u);
        const unsigned gen = old / nloc;
        if (old + 1u == (gen + 1u) * nloc) {
            __builtin_amdgcn_fence(__ATOMIC_RELEASE, "agent");
            asm volatile("s_waitcnt vmcnt(0)" ::: "memory");
            const unsigned og = xb_add(&bar[XB_TOP], 1u);
            const unsigned tg = og / nx;
            if (og + 1u == (tg + 1u) * nx) xb_add(&bar[XB_TOPGEN], 1u);
            else XB_SPIN(xb_ld(&bar[XB_TOPGEN]) == tg, bar);
            __builtin_amdgcn_fence(__ATOMIC_ACQUIRE, "agent");
            xb_add(&bar[XB_XGEN(b.x)], 1u);
            asm volatile("s_waitcnt vmcnt(0)" ::: "memory");
        } else {
            XB_SPIN(xb_ld(&bar[XB_XGEN(b.x)]) == gen, bar);
            __builtin_amdgcn_fence(__ATOMIC_ACQUIRE, "agent");
            asm volatile("s_waitcnt vmcnt(0)" ::: "memory");
        }
    }
    __syncthreads();
}

constexpr int NTHR = 512, NWAVES = 8;
constexpr int LDS_BYTES = 163840, MISC_OFF = LDS_BYTES - 256;
typedef short bf16x8 __attribute__((ext_vector_type(8)));
typedef float f32x16 __attribute__((ext_vector_type(16)));
#define MFMA16(a, b, c) __builtin_amdgcn_mfma_f32_16x16x32_bf16((a), (b), (c), 0, 0, 0)
#define MFMA32(a, b, c) __builtin_amdgcn_mfma_f32_32x32x16_bf16((a), (b), (c), 0, 0, 0)
#define WG_SYNC() __syncthreads()
#define RAW_BAR() do { asm volatile("s_waitcnt lgkmcnt(0)" ::: "memory"); __builtin_amdgcn_s_barrier(); asm volatile("" ::: "memory"); } while (0)
__device__ __forceinline__ unsigned cvtpk(float lo, float hi) { unsigned r; asm volatile("v_cvt_pk_bf16_f32 %0, %1, %2" : "=v"(r) : "v"(lo), "v"(hi)); return r; }
__device__ __forceinline__ bf16x8 pack8(f32x4 a, f32x4 b) { u32x4 p; p.x = cvtpk(a.x, a.y); p.y = cvtpk(a.z, a.w); p.z = cvtpk(b.x, b.y); p.w = cvtpk(b.z, b.w); return __builtin_bit_cast(bf16x8, p); }
__device__ __forceinline__ int crow32(int i, int h) { return (i & 3) + 8 * (i >> 2) + 4 * h; }
__device__ __forceinline__ void unpack8(u32x4 w, float (&f)[8]) { f[0] = bflo(w.x); f[1] = bfhi(w.x); f[2] = bflo(w.y); f[3] = bfhi(w.y); f[4] = bflo(w.z); f[5] = bfhi(w.z); f[6] = bflo(w.w); f[7] = bfhi(w.w); }

constexpr size_t MiB = 1u << 20;
constexpr size_t SZ_WIN = (size_t)DINP * DM * 2, SZ_WOUT = (size_t)DM * DM * 2, SZ_WUP = (size_t)2 * DFF * DM * 2, SZ_WDN = (size_t)DM * DFF * 2;
constexpr size_t WS_CTL = 0, CTL_BYTES = 1 * MiB, WS_W = 1 * MiB, SZ_WL = SZ_WIN + SZ_WOUT + SZ_WUP + SZ_WDN;
constexpr size_t WS_HB = WS_W + 2 * SZ_WL, WS_PROJ = WS_HB + (size_t)M * DM * 2, WS_MIX = WS_PROJ + (size_t)M * DINP * 2, WS_XA = WS_MIX + (size_t)M * DM * 2, WS_XB = WS_XA + (size_t)M * DM * 4;
constexpr size_t WS_HID = WS_XB + (size_t)M * DM * 4, WS_ACT = WS_HID + (size_t)M * 2 * DFF * 2, WS_SCR = WS_ACT + (size_t)M * DFF * 2;
constexpr size_t SZ_F1536 = (size_t)M * 1536 * 4, SZ_F1024 = (size_t)M * 1024 * 4;
constexpr size_t WS_QF = WS_SCR, WS_KF = WS_QF + SZ_F1536, WS_VF = WS_KF + SZ_F1536, WS_OF = WS_VF + SZ_F1536, WS_LA = WS_OF + SZ_F1536, WS_LI = WS_LA + SZ_F1536,
                 WS_SV = WS_LI + SZ_F1536, WS_SY = WS_SV + SZ_F1024, WS_BG = WS_SY + SZ_F1024, WS_NAIVE_END = WS_BG + 2 * MiB;
constexpr int DN_UNITS = BATCH * DNH * 64, DN_STAGE = 57344, DN_W_OFF = 0, DN_Q_OFF = 16384, DN_KT_OFF = 32768, DN_AT_OFF = 49152;
constexpr size_t WS_STG = WS_NAIVE_END, WS_UG = WS_STG + (size_t)DN_UNITS * DN_STAGE, WS_DEC = WS_UG + (size_t)DN_UNITS * 32768, WS_HL = WS_DEC + 1 * MiB, WS_PC = WS_HL + SZ_F1536,
                 WS_CAR = WS_PC + SZ_F1536, WS_WAT = WS_CAR + 1 * MiB, WS_WXT = WS_WAT + 1 * MiB, WS_WSB = WS_WXT + 1 * MiB, WS_SGST = WS_WSB + 1 * MiB, WS_END = WS_SGST + 1 * MiB;
constexpr int CW_BAR = 4096;

__device__ __forceinline__ void rmsnorm_rows(const float* x, const float* w, bf16* ob, float* of, int gw, int ngw, int lane) {
    for (int row = gw; row < M; row += ngw) {
        const f32x4* xr = (const f32x4*)(x + (size_t)row * DM) + lane; const f32x4* wr = (const f32x4*)w + lane;
        f32x4 v[16]; float s = 0.f;
#pragma unroll
        for (int j = 0; j < 16; ++j) { v[j] = xr[64 * j]; s += (v[j].x * v[j].x + v[j].y * v[j].y) + (v[j].z * v[j].z + v[j].w * v[j].w); }
        const float rstd = 1.0f / sqrtf(wave_sum(s) * (1.0f / DM) + EPS);
        if (ob) {
#pragma unroll
            for (int j = 0; j < 16; ++j) { const f32x4 o = v[j] * rstd * wr[64 * j]; u32x2 p; p.x = pk2(o.x, o.y); p.y = pk2(o.z, o.w); *((u32x2*)(ob + (size_t)row * DM) + lane + 64 * j) = p; }
        } else {
#pragma unroll
            for (int j = 0; j < 16; ++j) { const f32x4 o = v[j] * rstd * wr[64 * j]; *((f32x4*)(of + (size_t)row * DM) + lane + 64 * j) = o; }
        }
    }
}
template <class INP> __device__ __forceinline__ void phase_prologue(LAS unsigned char* lds, INP in, unsigned char* ws, int gw, int ngw, int gtid, int ngt, int wave, int lane) {
    LAS float* scr = (LAS float*)(lds + wave * 8448);
    constexpr int I_IN = (DINP / 32) * (DM / 64), I_OUT = (DM / 32) * (DM / 64), I_UP = (2 * DFF / 32) * (DM / 64), I_DN = (DM / 32) * (DFF / 64), I_L = I_IN + I_OUT + I_UP + I_DN;
    for (int it = gw; it < 2 * I_L; it += ngw) {
        const int l = it / I_L; int r = it % I_L;
        bf16* win = (bf16*)(ws + WS_W + l * SZ_WL); bf16* wout = (bf16*)((unsigned char*)win + SZ_WIN); bf16* wup = (bf16*)((unsigned char*)wout + SZ_WOUT); bf16* wdn = (bf16*)((unsigned char*)wup + SZ_WUP);
        if (r < I_IN) { const int nblk = DINP / 32, kb = r / nblk, n0 = (r % nblk) * 32; int src = n0, nv = 32;
            if (n0 < 6144) { src = n0; } else if (n0 < 11264) { src = n0 + 24; } else if (n0 == 11264) { src = 6144; nv = 24; } else { src = 0; nv = 0; }
            transpose_item(in[2] + (size_t)l * DM * DIN, DM, DIN, win, n0, src, nv, scr, kb, lane); continue; }
        r -= I_IN;
        if (r < I_OUT) { const int nblk = DM / 32; transpose_item(in[20] + (size_t)l * DM * DM, DM, DM, wout, (r % nblk) * 32, (r % nblk) * 32, 32, scr, r / nblk, lane); continue; }
        r -= I_OUT;
        if (r < I_UP) { const int nblk = 2 * DFF / 32; transpose_item(in[22] + (size_t)l * DM * 2 * DFF, DM, 2 * DFF, wup, (r % nblk) * 32, (r % nblk) * 32, 32, scr, r / nblk, lane); continue; }
        r -= I_UP;
        { const int nblk = DM / 32; transpose_item(in[25] + (size_t)l * DFF * DM, DFF, DM, wdn, (r % nblk) * 32, (r % nblk) * 32, 32, scr, r / nblk, lane); }
    }
    bf16* wat = (bf16*)(ws + WS_WAT); bf16* wxt = (bf16*)(ws + WS_WXT); bf16* wsb = (bf16*)(ws + WS_WSB);
    for (int i = gtid; i < DEPTH * LRB * HD * HD; i += ngt) { const int ii = i & 127, j = (i >> 7) & 127, lg = i >> 14; const size_t src = ((size_t)lg * HD + ii) * HD + j;
        wat[i] = (bf16)f2bf(in[9][src]); wxt[i] = (bf16)f2bf(in[11][src]); }
    for (int i = gtid; i < DEPTH * SGG * 128 * 128; i += ngt) { const int s = i & 127, t = (i >> 7) & 127; wsb[i] = (s <= t) ? (bf16)f2bf(in[17][i]) : (bf16)0; }
    rmsnorm_rows(in[0], in[1], (bf16*)(ws + WS_HB), nullptr, gw, ngw, lane);
}

__device__ __forceinline__ void phase_ffn_act(const bf16* hid, const float* cw, const float* cb, bf16* act, int gw, int ngw, int lane) {
    constexpr int NOG = (DFF / 8 + 63) / 64, NSTRIP = M / 16;
    for (int item = gw; item < NOG * NSTRIP; item += ngw) {
        const int strip = item / NOG, og = item % NOG, oct = og * 64 + lane;
        if (oct < DFF / 8) {
            const int c0 = oct * 8, m0 = strip * 16, t0 = m0 % SEQ;
            float wg[3][8], wu[3][8], bg[8], bu[8];
#pragma unroll
            for (int j = 0; j < 3; ++j) { const f32x4 a0 = *(const f32x4*)(cw + (size_t)j * 2 * DFF + c0), a1 = *(const f32x4*)(cw + (size_t)j * 2 * DFF + c0 + 4), b0 = *(const f32x4*)(cw + (size_t)j * 2 * DFF + DFF + c0), b1 = *(const f32x4*)(cw + (size_t)j * 2 * DFF + DFF + c0 + 4);
                wg[j][0] = a0.x; wg[j][1] = a0.y; wg[j][2] = a0.z; wg[j][3] = a0.w; wg[j][4] = a1.x; wg[j][5] = a1.y; wg[j][6] = a1.z; wg[j][7] = a1.w;
                wu[j][0] = b0.x; wu[j][1] = b0.y; wu[j][2] = b0.z; wu[j][3] = b0.w; wu[j][4] = b1.x; wu[j][5] = b1.y; wu[j][6] = b1.z; wu[j][7] = b1.w; }
            { const f32x4 a0 = *(const f32x4*)(cb + c0), a1 = *(const f32x4*)(cb + c0 + 4), b0 = *(const f32x4*)(cb + DFF + c0), b1 = *(const f32x4*)(cb + DFF + c0 + 4);
              bg[0] = a0.x; bg[1] = a0.y; bg[2] = a0.z; bg[3] = a0.w; bg[4] = a1.x; bg[5] = a1.y; bg[6] = a1.z; bg[7] = a1.w; bu[0] = b0.x; bu[1] = b0.y; bu[2] = b0.z; bu[3] = b0.w; bu[4] = b1.x; bu[5] = b1.y; bu[6] = b1.z; bu[7] = b1.w; }
            float g0[8], g1[8], u0[8], u1[8];
            if (t0 > 0) { const bf16* pr = hid + (size_t)(m0 - 2) * (2 * DFF) + c0;
                unpack8(*(const u32x4*)pr, g0); unpack8(*(const u32x4*)(pr + DFF), u0); unpack8(*(const u32x4*)(pr + 2 * DFF), g1); unpack8(*(const u32x4*)(pr + 3 * DFF), u1); }
            else {
#pragma unroll
                for (int i = 0; i < 8; ++i) { g0[i] = 0.f; g1[i] = 0.f; u0[i] = 0.f; u1[i] = 0.f; } }
#pragma unroll 4
            for (int r = 0; r < 16; ++r) {
                const bf16* pr = hid + (size_t)(m0 + r) * (2 * DFF) + c0; float g2[8], u2[8]; unpack8(*(const u32x4*)pr, g2); unpack8(*(const u32x4*)(pr + DFF), u2);
                float o[8];
#pragma unroll
                for (int i = 0; i < 8; ++i) { const float yg = bg[i] + wg[0][i] * g0[i] + wg[1][i] * g1[i] + wg[2][i] * g2[i], yu = bu[i] + wu[0][i] * u0[i] + wu[1][i] * u1[i] + wu[2][i] * u2[i];
                    o[i] = siluf_(yg) * yu; g0[i] = g1[i]; g1[i] = g2[i]; u0[i] = u1[i]; u1[i] = u2[i]; }
                u32x4 pk; pk.x = cvtpk(o[0], o[1]); pk.y = cvtpk(o[2], o[3]); pk.z = cvtpk(o[4], o[5]); pk.w = cvtpk(o[6], o[7]);
                *(u32x4*)(act + (size_t)(m0 + r) * DFF + c0) = pk;
            }
        }
    }
}
__device__ __forceinline__ void phase_sg_stats(const bf16* proj, float* sgst, int gw, int ngw, int lane) {
    for (int m = gw; m < M; m += ngw) { const bf16* p = proj + (size_t)m * DINP + SV0 + 8 * lane; float s = 0.f, s2 = 0.f;
#pragma unroll
        for (int jj = 0; jj < 2; ++jj) { const u32x4 v = *(const u32x4*)(p + 512 * jj); float f[8]; unpack8(v, f);
#pragma unroll
            for (int i = 0; i < 8; ++i) { const float gv = geluf_(f[i]); s += gv; s2 += gv * gv; } }
        s = wave_sum(s); s2 = wave_sum(s2);
        if (lane == 0) { const float mu = s * (1.0f / SGW); float var = s2 * (1.0f / SGW) - mu * mu; var = var > 0.f ? var : 0.f; sgst[2 * m] = mu; sgst[2 * m + 1] = 1.0f / sqrtf(var + EPS); } }
}

__device__ __forceinline__ void dn_prep_unit(LAS unsigned char* lds, int tid, int wave, int lane, int unit, const bf16* proj, const float* convw, const float* a_log, const float* dt_bias,
                                             unsigned char* stg_all, float* ug_all, float* dec_all) {
    const int n = unit & 63, bh = unit >> 6, b = bh / DNH, h = bh % DNH, t0 = n * 64; const size_t m0 = (size_t)b * SEQ + t0;
    LAS float* KS = (LAS float*)(lds); LAS float* VS = (LAS float*)(lds + 33792);
    LAS bf16* QB = (LAS bf16*)(lds + 67584); LAS bf16* KB = (LAS bf16*)(lds + 84992);
    LAS float* AM = (LAS float*)(lds + 102400); LAS float* AT = (LAS float*)(lds + 119808);
    LAS float* SMb = (LAS float*)(lds + 137216);
    unsigned char* stg = stg_all + (size_t)unit * DN_STAGE; float* ug = ug_all + (size_t)unit * 8192;
    if (wave == 0) {
        const size_t m = m0 + lane;
        const float braw = bf2f(proj[m * DINP + BA0 + h]), araw = bf2f(proj[m * DINP + BA0 + DNH + h]);
        const float beta = sigmoidf_(braw), g = -expf(a_log[h]) * softplusf_(araw + dt_bias[h]);
        float gc = g;
#pragma unroll
        for (int o = 1; o < 64; o <<= 1) { const float t = __shfl_up(gc, o); if (lane >= o) gc += t; }
        const float gl = __shfl(gc, 63);
        SMb[lane] = beta; SMb[64 + lane] = gc; SMb[128 + lane] = expf(gc); SMb[192 + lane] = expf(gl - gc); SMb[256 + lane] = beta * expf(gc);
        if (lane == 63) dec_all[unit] = expf(gl);
    }
    WG_SYNC();
    {
        const int rb = tid >> 4, cg = tid & 15;
#pragma unroll
        for (int p = 0; p < 3; ++p) {
            const int c0 = p * DNW + h * HD + cg * 8;
            float w[4][8];
#pragma unroll
            for (int j = 0; j < 4; ++j) { const f32x4 a = *(const f32x4*)(convw + j * 3 * DNW + c0), bq = *(const f32x4*)(convw + j * 3 * DNW + c0 + 4);
                w[j][0] = a.x; w[j][1] = a.y; w[j][2] = a.z; w[j][3] = a.w; w[j][4] = bq.x; w[j][5] = bq.y; w[j][6] = bq.z; w[j][7] = bq.w; }
            float x[5][8];
#pragma unroll
            for (int k = 0; k < 5; ++k) { const int rr = 2 * rb - 3 + k;
                if (t0 + rr >= 0) { const u32x4 v = *(const u32x4*)(proj + (size_t)((long)m0 + rr) * DINP + c0); unpack8(v, x[k]); }
                else {
#pragma unroll
                    for (int i = 0; i < 8; ++i) x[k][i] = 0.f; } }
#pragma unroll
            for (int rr = 0; rr < 2; ++rr) {
                const int row = 2 * rb + rr; float y[8]; float ss = 0.f;
#pragma unroll
                for (int i = 0; i < 8; ++i) { float a = 0.f;
#pragma unroll
                    for (int j = 0; j < 4; ++j) a += w[j][i] * x[rr + j][i];
                    y[i] = siluf_(a); ss += y[i] * y[i]; }
                if (p < 2) { ss += __shfl_xor(ss, 1); ss += __shfl_xor(ss, 2); ss += __shfl_xor(ss, 4); ss += __shfl_xor(ss, 8); const float rn = 1.0f / sqrtf(ss + EPS);
#pragma unroll
                    for (int i = 0; i < 8; ++i) y[i] *= rn; }
                if (p == 0) {
                    u32x4 pk; pk.x = cvtpk(y[0], y[1]); pk.y = cvtpk(y[2], y[3]); pk.z = cvtpk(y[4], y[5]); pk.w = cvtpk(y[6], y[7]);
                    *(LAS u32x4*)(QB + row * 136 + cg * 8) = pk;
                    const float sc = SMb[128 + row] * 0.08838834764831845f;
                    const int mt = row >> 4, rp = row & 15, s = cg >> 2, jj = (cg & 3) >> 1, q0 = 2 * (cg & 1);
                    u32x2 a0, a1; a0.x = cvtpk(y[0] * sc, y[1] * sc); a0.y = cvtpk(y[2] * sc, y[3] * sc); a1.x = cvtpk(y[4] * sc, y[5] * sc); a1.y = cvtpk(y[6] * sc, y[7] * sc);
                    bf16* qf = (bf16*)(stg + DN_Q_OFF);
                    *(u32x2*)(qf + ((size_t)((mt * 4 + s) * 64 + q0 * 16 + rp)) * 8 + 4 * jj) = a0;
                    *(u32x2*)(qf + ((size_t)((mt * 4 + s) * 64 + (q0 + 1) * 16 + rp)) * 8 + 4 * jj) = a1;
                } else if (p == 1) {
                    *(LAS f32x4*)(KS + row * 132 + cg * 8) = (f32x4){y[0], y[1], y[2], y[3]}; *(LAS f32x4*)(KS + row * 132 + cg * 8 + 4) = (f32x4){y[4], y[5], y[6], y[7]};
                    u32x4 pk; pk.x = cvtpk(y[0], y[1]); pk.y = cvtpk(y[2], y[3]); pk.z = cvtpk(y[4], y[5]); pk.w = cvtpk(y[6], y[7]);
                    *(LAS u32x4*)(KB + row * 136 + cg * 8) = pk;
                } else {
                    const float bt = SMb[row];
                    *(LAS f32x4*)(VS + row * 132 + cg * 8) = (f32x4){y[0] * bt, y[1] * bt, y[2] * bt, y[3] * bt}; *(LAS f32x4*)(VS + row * 132 + cg * 8 + 4) = (f32x4){y[4] * bt, y[5] * bt, y[6] * bt, y[7] * bt};
                }
            }
        }
    }
    WG_SYNC();
    {
        const int p = wave >> 2, mt = wave & 3, r = lane & 15, q = lane >> 4;
        LAS bf16* Aop = p ? QB : KB;
#pragma unroll
        for (int nt = 0; nt < 4; ++nt) {
            if (nt <= mt) {
                f32x4 acc = (f32x4){0.f, 0.f, 0.f, 0.f};
#pragma unroll
                for (int s = 0; s < 4; ++s) { const bf16x8 a = *(const LAS bf16x8*)(Aop + (16 * mt + r) * 136 + 32 * s + 8 * q), bb = *(const LAS bf16x8*)(KB + (16 * nt + r) * 136 + 32 * s + 8 * q);
                    acc = MFMA16(a, bb, acc); }
                const int jc = 16 * nt + r; const float gj = SMb[64 + jc];
#pragma unroll
                for (int i = 0; i < 4; ++i) { const int ir = 16 * mt + 4 * q + i; const float gi = SMb[64 + ir]; float v;
                    if (p == 0) v = (ir > jc) ? SMb[ir] * acc[i] * expf(gi - gj) : 0.f; else v = (ir >= jc) ? acc[i] * expf(gi - gj) * 0.08838834764831845f : 0.f;
                    if (p == 0) AM[jc * 68 + ir] = v; else AT[ir * 68 + jc] = v; }
            } else {
#pragma unroll
                for (int i = 0; i < 4; ++i) { if (p == 0) AM[(16 * nt + r) * 68 + 16 * mt + 4 * q + i] = 0.f; else AT[(16 * mt + 4 * q + i) * 68 + 16 * nt + r] = 0.f; }
            }
        }
    }
    WG_SYNC();
    { const int ch = tid, mt = ch >> 7, s = (ch >> 6) & 1, ln = ch & 63, rp = ln & 15, q = ln >> 4, row = 16 * mt + rp;
        const f32x4 a0 = *(const LAS f32x4*)(AT + row * 68 + 32 * s + 4 * q), a1 = *(const LAS f32x4*)(AT + row * 68 + 32 * s + 16 + 4 * q);
        u32x4 pk; pk.x = cvtpk(a0.x, a0.y); pk.y = cvtpk(a0.z, a0.w); pk.z = cvtpk(a1.x, a1.y); pk.w = cvtpk(a1.z, a1.w);
        *(u32x4*)(stg + DN_AT_OFF + (size_t)ch * 16) = pk; }
#pragma unroll
    for (int k = 0; k < 2; ++k) { const int ch = tid + 512 * k, mt = ch >> 7, s = (ch >> 6) & 1, ln = ch & 63, rp = ln & 15, q = ln >> 4, d = 16 * mt + rp; float v[8];
#pragma unroll
        for (int j = 0; j < 8; ++j) { const int c = 32 * s + 16 * (j >> 2) + 4 * q + (j & 3); v[j] = KS[c * 132 + d] * SMb[192 + c]; }
        u32x4 pk; pk.x = cvtpk(v[0], v[1]); pk.y = cvtpk(v[2], v[3]); pk.z = cvtpk(v[4], v[5]); pk.w = cvtpk(v[6], v[7]);
        *(u32x4*)(stg + DN_KT_OFF + (size_t)ch * 16) = pk; }
    WG_SYNC();
    if (tid < 256) {
        const int col = tid; const bool isv = col < 128; LAS float* xcol = isv ? (VS + col) : (KS + (col - 128));
#pragma unroll 1
        for (int ib = 0; ib < 8; ++ib) {
            const int i0 = 8 * ib; float acc[8];
#pragma unroll
            for (int rr = 0; rr < 8; ++rr) { const float v = xcol[(i0 + rr) * 132]; acc[rr] = isv ? v : v * SMb[256 + i0 + rr]; }
#pragma unroll 4
            for (int j = 0; j < i0; ++j) { const float xj = xcol[j * 132]; const f32x4 a0 = *(const LAS f32x4*)(AM + j * 68 + i0), a1 = *(const LAS f32x4*)(AM + j * 68 + i0 + 4);
                acc[0] -= a0.x * xj; acc[1] -= a0.y * xj; acc[2] -= a0.z * xj; acc[3] -= a0.w * xj; acc[4] -= a1.x * xj; acc[5] -= a1.y * xj; acc[6] -= a1.z * xj; acc[7] -= a1.w * xj; }
#pragma unroll
            for (int c = 0; c < 7; ++c) { const f32x4 a0 = *(const LAS f32x4*)(AM + (i0 + c) * 68 + i0), a1 = *(const LAS f32x4*)(AM + (i0 + c) * 68 + i0 + 4);
                const float av[8] = {a0.x, a0.y, a0.z, a0.w, a1.x, a1.y, a1.z, a1.w};
#pragma unroll
                for (int rr = c + 1; rr < 8; ++rr) acc[rr] -= av[rr] * acc[c]; }
#pragma unroll
            for (int rr = 0; rr < 8; ++rr) xcol[(i0 + rr) * 132] = acc[rr];
        }
    }
    WG_SYNC();
#pragma unroll
    for (int k = 0; k < 4; ++k) { const int ch = tid + 512 * k, wv = ch >> 8, ct = (ch >> 6) & 3, ln = ch & 63, r = ln & 15, q = ln >> 4, c = 16 * ct + 4 * q, e = 16 * wv + r;
        const f32x4 v = (f32x4){VS[c * 132 + e], VS[(c + 1) * 132 + e], VS[(c + 2) * 132 + e], VS[(c + 3) * 132 + e]};
        *(f32x4*)(ug + (size_t)ch * 4) = v; }
#pragma unroll
    for (int k = 0; k < 2; ++k) { const int ch = tid + 512 * k, mt = ch >> 8, s = (ch >> 6) & 3, ln = ch & 63, rp = ln & 15, q = ln >> 4, row = 16 * mt + rp;
        const f32x4 a0 = *(const LAS f32x4*)(KS + row * 132 + 32 * s + 4 * q), a1 = *(const LAS f32x4*)(KS + row * 132 + 32 * s + 16 + 4 * q);
        u32x4 pk; pk.x = cvtpk(-a0.x, -a0.y); pk.y = cvtpk(-a0.z, -a0.w); pk.z = cvtpk(-a1.x, -a1.y); pk.w = cvtpk(-a1.z, -a1.w);
        *(u32x4*)(stg + DN_W_OFF + (size_t)ch * 16) = pk; }
    WG_SYNC();
}

__device__ __forceinline__ void dn_scan_bh(LAS unsigned char* lds, int tid, int wave, int lane, int bh, const unsigned char* stg_all, const float* ug_all, const float* dec_all,
                                           const bf16* proj, const float* normw, bf16* mix) {
    const int b = bh / DNH, h = bh % DNH, r = lane & 15, q = lane >> 4;
    LAS float* OB = (LAS float*)(lds + 2 * DN_STAGE);
    f32x4 S[8];
#pragma unroll
    for (int i = 0; i < 8; ++i) S[i] = (f32x4){0.f, 0.f, 0.f, 0.f};
    const unsigned char* stg_bh = stg_all + (size_t)bh * 64 * DN_STAGE; const float* ug_bh = ug_all + (size_t)bh * 64 * 8192; const float* dec_bh = dec_all + bh * 64;
    const int prow = tid >> 3, pcg = tid & 7;
    const bf16* zbase = proj + ((size_t)b * SEQ + prow) * DINP + Z0 + h * HD + 16 * pcg; bf16* mbase = mix + ((size_t)b * SEQ + prow) * DM + h * HD + 16 * pcg;
    LAS float* NWL = (LAS float*)(lds + 2 * DN_STAGE + 33792);
    if (tid < HD) NWL[tid] = normw[tid];
#define DN_DMA(n_, buf_) do { const unsigned char* g_ = stg_bh + (size_t)(n_) * DN_STAGE; _Pragma("unroll") for (int k_ = 0; k_ < 7; ++k_) \
        __builtin_amdgcn_global_load_lds((const unsigned*)(g_ + (size_t)((wave * 7 + k_) * 1024 + lane * 16)), (LAS unsigned*)(lds + (buf_) * DN_STAGE + (wave * 7 + k_) * 1024), 16, 0, 0); } while (0)
#define DN_POST(n_, ZP) do { f32x4 v_[4]; float ss_ = 0.f; \
        _Pragma("unroll") for (int k = 0; k < 4; ++k) { v_[k] = *(const LAS f32x4*)(OB + prow * 132 + 16 * pcg + 4 * k); ss_ += (v_[k].x * v_[k].x + v_[k].y * v_[k].y) + (v_[k].z * v_[k].z + v_[k].w * v_[k].w); } \
        ss_ += __shfl_xor(ss_, 1); ss_ += __shfl_xor(ss_, 2); ss_ += __shfl_xor(ss_, 4); \
        const float rstd_ = 1.0f / sqrtf(ss_ * (1.0f / HD) + EPS); float z_[16]; { float t8[8]; unpack8(ZP[0], t8); \
        _Pragma("unroll") for (int i = 0; i < 8; ++i) z_[i] = t8[i]; unpack8(ZP[1], t8); _Pragma("unroll") for (int i = 0; i < 8; ++i) z_[8 + i] = t8[i]; } \
        float o_[16]; _Pragma("unroll") for (int k = 0; k < 4; ++k) { const f32x4 nwk = *(const LAS f32x4*)(NWL + 16 * pcg + 4 * k); o_[4 * k] = v_[k].x * rstd_ * nwk.x * siluf_(z_[4 * k]); o_[4 * k + 1] = v_[k].y * rstd_ * nwk.y * siluf_(z_[4 * k + 1]); \
            o_[4 * k + 2] = v_[k].z * rstd_ * nwk.z * siluf_(z_[4 * k + 2]); o_[4 * k + 3] = v_[k].w * rstd_ * nwk.w * siluf_(z_[4 * k + 3]); } \
        u32x4 p0_, p1_; p0_.x = cvtpk(o_[0], o_[1]); p0_.y = cvtpk(o_[2], o_[3]); p0_.z = cvtpk(o_[4], o_[5]); p0_.w = cvtpk(o_[6], o_[7]); \
        p1_.x = cvtpk(o_[8], o_[9]); p1_.y = cvtpk(o_[10], o_[11]); p1_.z = cvtpk(o_[12], o_[13]); p1_.w = cvtpk(o_[14], o_[15]); \
        bf16* mp_ = mbase + (size_t)(n_) * 64 * DM; *(u32x4*)mp_ = p0_; *(u32x4*)(mp_ + 8) = p1_; } while (0)
#define DN_LD4(F, off_, f0_) do { _Pragma("unroll") for (int i_ = 0; i_ < 4; ++i_) F[i_] = *(const LAS bf16x8*)(st + (off_) + (((f0_) + i_) * 64 + lane) * 16); } while (0)
#define DN_MM4(acc_, F, B) do { _Pragma("unroll") for (int s_ = 0; s_ < 4; ++s_) acc_ = MFMA16(F[s_], B[s_], acc_); } while (0)
#define DN_MM2x2(a0_, a1_, F, B) do { a0_ = MFMA16(F[0], B[0], a0_); a1_ = MFMA16(F[2], B[0], a1_); a0_ = MFMA16(F[1], B[1], a0_); a1_ = MFMA16(F[3], B[1], a1_); } while (0)
#define DN_STEP(n_, UC, UN, ZP, ZC, DC, DN_) do { \
        asm volatile("s_waitcnt vmcnt(0)" ::: "memory"); RAW_BAR(); \
        asm volatile("" : "+v"(UC[0]), "+v"(UC[1]), "+v"(UC[2]), "+v"(UC[3]), "+v"(ZP[0]), "+v"(ZP[1]), "+v"(DC)); \
        if ((n_) + 1 < 64) { DN_DMA((n_) + 1, ((n_) + 1) & 1); \
            _Pragma("unroll") for (int ct = 0; ct < 4; ++ct) UN[ct] = *(const f32x4*)(ug_bh + (size_t)((n_) + 1) * 8192 + (size_t)((wave * 4 + ct) * 64 + lane) * 4); \
            DN_ = dec_bh[(n_) + 1]; } \
        { const bf16* zp_ = zbase + (size_t)(n_) * 64 * DINP; ZC[0] = *(const u32x4*)zp_; ZC[1] = *(const u32x4*)(zp_ + 8); } \
        if ((n_) > 0) DN_POST((n_) - 1, ZP); \
        const LAS unsigned char* st = lds + ((n_) & 1) * DN_STAGE; \
        bf16x8 Sb[4]; _Pragma("unroll") for (int s = 0; s < 4; ++s) Sb[s] = pack8(S[2 * s], S[2 * s + 1]); \
        f32x4 vn[4], o[4]; _Pragma("unroll") for (int ct = 0; ct < 4; ++ct) { vn[ct] = UC[ct]; o[ct] = (f32x4){0.f, 0.f, 0.f, 0.f}; } \
        bf16x8 F0[4], F1[4]; \
        DN_LD4(F0, DN_W_OFF, 0); DN_LD4(F1, DN_W_OFF, 4); \
        DN_MM4(vn[0], F0, Sb); DN_LD4(F0, DN_W_OFF, 8); DN_MM4(vn[1], F1, Sb); DN_LD4(F1, DN_W_OFF, 12); \
        DN_MM4(vn[2], F0, Sb); DN_LD4(F0, DN_Q_OFF, 0); DN_MM4(vn[3], F1, Sb); DN_LD4(F1, DN_Q_OFF, 4); \
        bf16x8 Vb[2]; \
        DN_MM4(o[0], F0, Sb); DN_LD4(F0, DN_Q_OFF, 8); DN_MM4(o[1], F1, Sb); DN_LD4(F1, DN_Q_OFF, 12); \
        _Pragma("unroll") for (int s = 0; s < 2; ++s) Vb[s] = pack8(vn[2 * s], vn[2 * s + 1]); \
        DN_MM4(o[2], F0, Sb); DN_LD4(F0, DN_AT_OFF, 0); DN_MM4(o[3], F1, Sb); DN_LD4(F1, DN_AT_OFF, 4); \
        _Pragma("unroll") for (int dt = 0; dt < 8; ++dt) S[dt] = S[dt] * DC; \
        DN_MM2x2(o[0], o[1], F0, Vb); DN_LD4(F0, DN_KT_OFF, 0); DN_MM2x2(o[2], o[3], F1, Vb); DN_LD4(F1, DN_KT_OFF, 4); \
        DN_MM2x2(S[0], S[1], F0, Vb); DN_LD4(F0, DN_KT_OFF, 8); DN_MM2x2(S[2], S[3], F1, Vb); DN_LD4(F1, DN_KT_OFF, 12); \
        DN_MM2x2(S[4], S[5], F0, Vb); DN_MM2x2(S[6], S[7], F1, Vb); \
        RAW_BAR(); \
        _Pragma("unroll") for (int ct = 0; ct < 4; ++ct) _Pragma("unroll") for (int i = 0; i < 4; ++i) OB[(16 * ct + 4 * q + i) * 132 + 16 * wave + r] = o[ct][i]; \
    } while (0)
    DN_DMA(0, 0);
    f32x4 uA[4], uB[4]; u32x4 zA[2] = {(u32x4){0u, 0u, 0u, 0u}, (u32x4){0u, 0u, 0u, 0u}}, zB[2] = {(u32x4){0u, 0u, 0u, 0u}, (u32x4){0u, 0u, 0u, 0u}}; float dA = dec_bh[0], dB = 0.f;
#pragma unroll
    for (int ct = 0; ct < 4; ++ct) { uA[ct] = *(const f32x4*)(ug_bh + (size_t)((wave * 4 + ct) * 64 + lane) * 4); uB[ct] = (f32x4){0.f, 0.f, 0.f, 0.f}; }
#pragma unroll 1
    for (int n = 0; n < 64; n += 2) {
        DN_STEP(n, uA, uB, zA, zB, dA, dB);
        DN_STEP(n + 1, uB, uA, zB, zA, dB, dA);
    }
    asm volatile("s_waitcnt vmcnt(0)" ::: "memory"); RAW_BAR();
    DN_POST(63, zA);
#undef DN_DMA
#undef DN_POST
#undef DN_STEP
#undef DN_LD4
#undef DN_MM4
#undef DN_MM2x2
    asm volatile("s_waitcnt vmcnt(0) lgkmcnt(0)" ::: "memory"); __builtin_amdgcn_s_barrier(); asm volatile("" ::: "memory");
}

__device__ __forceinline__ void lru1_unit(LAS unsigned char* lds, int tid, int wave, int lane, int unit, const bf16* proj, const float* convw, const float* convb, const bf16* wat, const bf16* wxt,
                                          const float* ba, const float* bx, const float* lam, float* HL, float* PC, float* CAR) {
    const int rb = unit & 31, bg = unit >> 5, b = bg / LRB, g = bg % LRB, t0 = rb * 128, cb = g * HD; const size_t m0 = (size_t)b * SEQ + t0;
    LAS float* XC = (LAS float*)lds; LAS float* AA = (LAS float*)(lds + 67584); LAS float* SE = (LAS float*)(lds + 135168);
    {
        const int rq = tid >> 4, cg = tid & 15, c0 = cb + 8 * cg; float w[4][8], bias[8];
#pragma unroll
        for (int j = 0; j < 4; ++j) { const f32x4 a = *(const f32x4*)(convw + j * LRW + c0), bq = *(const f32x4*)(convw + j * LRW + c0 + 4);
            w[j][0] = a.x; w[j][1] = a.y; w[j][2] = a.z; w[j][3] = a.w; w[j][4] = bq.x; w[j][5] = bq.y; w[j][6] = bq.z; w[j][7] = bq.w; }
        { const f32x4 a = *(const f32x4*)(convb + c0), bq = *(const f32x4*)(convb + c0 + 4); bias[0] = a.x; bias[1] = a.y; bias[2] = a.z; bias[3] = a.w; bias[4] = bq.x; bias[5] = bq.y; bias[6] = bq.z; bias[7] = bq.w; }
        float x[7][8];
#pragma unroll
        for (int k = 0; k < 7; ++k) { const int rr = 4 * rq - 3 + k;
            if (t0 + rr >= 0) { const u32x4 v = *(const u32x4*)(proj + (size_t)((long)m0 + rr) * DINP + LX0 + c0); unpack8(v, x[k]); }
            else {
#pragma unroll
                for (int i = 0; i < 8; ++i) x[k][i] = 0.f; } }
#pragma unroll
        for (int rr = 0; rr < 4; ++rr) { float y[8];
#pragma unroll
            for (int i = 0; i < 8; ++i) { float a = bias[i];
#pragma unroll
                for (int j = 0; j < 4; ++j) a += w[j][i] * x[rr + j][i];
                y[i] = a; }
            *(LAS f32x4*)(XC + (4 * rq + rr) * 132 + 8 * cg) = (f32x4){y[0], y[1], y[2], y[3]}; *(LAS f32x4*)(XC + (4 * rq + rr) * 132 + 8 * cg + 4) = (f32x4){y[4], y[5], y[6], y[7]}; }
    }
    WG_SYNC();
    {
        const int mt = wave & 3, nh = wave >> 2, r = lane & 31, hh = lane >> 5;
        f32x16 accA[2], accX[2];
#pragma unroll
        for (int nt = 0; nt < 2; ++nt)
#pragma unroll
            for (int i = 0; i < 16; ++i) { accA[nt][i] = 0.f; accX[nt][i] = 0.f; }
#pragma unroll
        for (int s = 0; s < 8; ++s) {
            const f32x4 a0 = *(const LAS f32x4*)(XC + (32 * mt + r) * 132 + 16 * s + 8 * hh), a1 = *(const LAS f32x4*)(XC + (32 * mt + r) * 132 + 16 * s + 8 * hh + 4);
            const bf16x8 a = pack8(a0, a1);
#pragma unroll
            for (int nt = 0; nt < 2; ++nt) { const int j = 64 * nh + 32 * nt + r; const size_t wo = ((size_t)(g * HD + j)) * HD + 16 * s + 8 * hh;
                const bf16x8 b1 = *(const bf16x8*)(wat + wo), b2 = *(const bf16x8*)(wxt + wo);
                accA[nt] = MFMA32(a, b1, accA[nt]); accX[nt] = MFMA32(a, b2, accX[nt]); }
        }
        WG_SYNC();
#pragma unroll
        for (int nt = 0; nt < 2; ++nt) { const int j = 64 * nh + 32 * nt + r, c = cb + j; const float sp = softplusf_(-lam[c]), bA = ba[c], bX = bx[c];
#pragma unroll
            for (int i = 0; i < 16; ++i) { const int t = 32 * mt + crow32(i, hh); const float xc = XC[t * 132 + j];
                const float rr = sigmoidf_(accA[nt][i] + bA), ig = sigmoidf_(accX[nt][i] + bX), la = -8.0f * rr * sp;
                AA[t * 132 + j] = expf(la); XC[t * 132 + j] = sqrtf(-expm1f(2.0f * la)) * (ig * xc); } }
    }
    WG_SYNC();
    {
        const int j = tid & 127, sg = tid >> 7; float P = 1.f, H = 0.f;
#pragma unroll 4
        for (int tt = 0; tt < 32; ++tt) { const int o = (32 * sg + tt) * 132 + j; const float a = AA[o]; H = a * H + XC[o]; P *= a; XC[o] = H; AA[o] = P; }
        SE[(sg * 128 + j) * 2] = P; SE[(sg * 128 + j) * 2 + 1] = H;
        WG_SYNC();
        float Pin = 1.f, Hin = 0.f;
        for (int s2 = 0; s2 < sg; ++s2) { const float Pe = SE[(s2 * 128 + j) * 2], He = SE[(s2 * 128 + j) * 2 + 1]; Hin = Pe * Hin + He; Pin *= Pe; }
#pragma unroll 4
        for (int tt = 0; tt < 32; ++tt) { const int t = 32 * sg + tt, o = t * 132 + j; const size_t go = (m0 + t) * LRW + cb + j; HL[go] = XC[o] + AA[o] * Hin; PC[go] = AA[o] * Pin; }
        if (sg == 3) { const float Pe = SE[(3 * 128 + j) * 2], He = SE[(3 * 128 + j) * 2 + 1]; CAR[((size_t)unit * 128 + j) * 2] = Pin * Pe; CAR[((size_t)unit * 128 + j) * 2 + 1] = Pe * Hin + He; }
    }
    WG_SYNC();
}
__device__ __forceinline__ void lru3_unit(LAS unsigned char* lds, int tid, int unit, const bf16* proj, const float* HL, const float* PC, const float* CAR, const float* normw, bf16* mix) {
    const int rb = unit & 31, bg = unit >> 5, b = bg / LRB, g = bg % LRB, t0 = rb * 128, cb = g * HD; const size_t m0 = (size_t)b * SEQ + t0;
    LAS float* HIN = (LAS float*)lds;
    if (tid < 128) { typedef float f32x2_t __attribute__((ext_vector_type(2))); f32x2_t ph[32];
#pragma unroll
        for (int u2 = 0; u2 < 32; ++u2) ph[u2] = (u2 < rb) ? *(const f32x2_t*)(CAR + ((size_t)(bg * 32 + u2) * 128 + tid) * 2) : (f32x2_t){1.f, 0.f};
        float H = 0.f;
#pragma unroll
        for (int u2 = 0; u2 < 32; ++u2) H = (u2 < rb) ? ph[u2].x * H + ph[u2].y : H;
        HIN[tid] = H; }
    WG_SYNC();
    const int row = tid >> 2, part = tid & 3, c0 = cb + 32 * part; const size_t m = m0 + row;
    float y[32]; float ss = 0.f;
#pragma unroll
    for (int k = 0; k < 4; ++k) { const u32x4 gv = *(const u32x4*)(proj + m * DINP + LG0 + c0 + 8 * k); float g8[8]; unpack8(gv, g8);
#pragma unroll
        for (int hf = 0; hf < 2; ++hf) { const f32x4 hl = *(const f32x4*)(HL + m * LRW + c0 + 8 * k + 4 * hf), pc = *(const f32x4*)(PC + m * LRW + c0 + 8 * k + 4 * hf);
#pragma unroll
            for (int i = 0; i < 4; ++i) { const int ci = 8 * k + 4 * hf + i; const float hv = hl[i] + pc[i] * HIN[32 * part + ci]; const float yv = hv * geluf_(g8[4 * hf + i]); y[ci] = yv; ss += yv * yv; } } }
    ss += __shfl_xor(ss, 1); ss += __shfl_xor(ss, 2);
    const float rstd = 1.0f / sqrtf(ss * (1.0f / HD) + EPS);
#pragma unroll
    for (int k = 0; k < 4; ++k) { const f32x4 w0 = *(const f32x4*)(normw + c0 + 8 * k), w1 = *(const f32x4*)(normw + c0 + 8 * k + 4);
        u32x4 pk; pk.x = cvtpk(y[8 * k] * rstd * w0.x, y[8 * k + 1] * rstd * w0.y); pk.y = cvtpk(y[8 * k + 2] * rstd * w0.z, y[8 * k + 3] * rstd * w0.w);
        pk.z = cvtpk(y[8 * k + 4] * rstd * w1.x, y[8 * k + 5] * rstd * w1.y); pk.w = cvtpk(y[8 * k + 6] * rstd * w1.z, y[8 * k + 7] * rstd * w1.w);
        *(u32x4*)(mix + m * DM + DNW + c0 + 8 * k) = pk; }
    WG_SYNC();
}

__device__ __forceinline__ void sg_unit(LAS unsigned char* lds, int tid, int wave, int lane, int unit, const bf16* proj, const float* sgst, const float* lnw, const float* lnb, const bf16* wsb, const float* bs, const float* normw, bf16* mix) {
    const int g = unit & 7, bn = unit >> 3; const size_t m0 = (size_t)bn * 128;
    LAS bf16* VT = (LAS bf16*)lds; LAS float* YB = (LAS float*)(lds + 34816);
    {
        const int s_ = tid >> 2, part = tid & 3; const float mu = sgst[2 * (m0 + s_)], rs = sgst[2 * (m0 + s_) + 1];
#pragma unroll
        for (int k = 0; k < 4; ++k) { const u32x4 v = *(const u32x4*)(proj + (m0 + s_) * DINP + SV0 + g * HD + 32 * part + 8 * k); float f[8]; unpack8(v, f);
            const f32x4 w0 = *(const f32x4*)(lnw + g * HD + 32 * part + 8 * k), w1 = *(const f32x4*)(lnw + g * HD + 32 * part + 8 * k + 4), b0 = *(const f32x4*)(lnb + g * HD + 32 * part + 8 * k), b1 = *(const f32x4*)(lnb + g * HD + 32 * part + 8 * k + 4);
            const float ww[8] = {w0.x, w0.y, w0.z, w0.w, w1.x, w1.y, w1.z, w1.w}, bb[8] = {b0.x, b0.y, b0.z, b0.w, b1.x, b1.y, b1.z, b1.w};
#pragma unroll
            for (int i = 0; i < 8; ++i) VT[(32 * part + 8 * k + i) * 136 + s_] = (bf16)f2bf((geluf_(f[i]) - mu) * rs * ww[i] + bb[i]); }
    }
    WG_SYNC();
    {
        const int mt = wave & 3, nh = wave >> 2, r = lane & 31, hh = lane >> 5;
        f32x16 acc[2];
#pragma unroll
        for (int nt = 0; nt < 2; ++nt)
#pragma unroll
            for (int i = 0; i < 16; ++i) acc[nt][i] = 0.f;
        for (int s = 0; s < 2 * mt + 2; ++s) { const bf16x8 a = *(const bf16x8*)(wsb + ((size_t)(g * 128 + 32 * mt + r)) * 128 + 16 * s + 8 * hh);
#pragma unroll
            for (int nt = 0; nt < 2; ++nt) { const bf16x8 bb = *(const LAS bf16x8*)(VT + (64 * nh + 32 * nt + r) * 136 + 16 * s + 8 * hh); acc[nt] = MFMA32(a, bb, acc[nt]); } }
#pragma unroll
        for (int nt = 0; nt < 2; ++nt) { const int c = 64 * nh + 32 * nt + r;
#pragma unroll
            for (int i = 0; i < 16; ++i) { const int t = 32 * mt + crow32(i, hh); const float z = acc[nt][i] + bs[g * 128 + t];
                YB[t * 132 + c] = geluf_(bf2f(proj[(m0 + t) * DINP + SU0 + g * HD + c])) * z; } }
    }
    WG_SYNC();
    {
        const int t = tid >> 2, part = tid & 3; f32x4 v[8]; float ss = 0.f;
#pragma unroll
        for (int k = 0; k < 8; ++k) { v[k] = *(const LAS f32x4*)(YB + t * 132 + 32 * part + 4 * k); ss += (v[k].x * v[k].x + v[k].y * v[k].y) + (v[k].z * v[k].z + v[k].w * v[k].w); }
        ss += __shfl_xor(ss, 1); ss += __shfl_xor(ss, 2);
        const float rstd = 1.0f / sqrtf(ss * (1.0f / HD) + EPS);
#pragma unroll
        for (int k = 0; k < 4; ++k) { const f32x4 w0 = *(const f32x4*)(normw + g * HD + 32 * part + 8 * k), w1 = *(const f32x4*)(normw + g * HD + 32 * part + 8 * k + 4);
            u32x4 pk; pk.x = cvtpk(v[2 * k].x * rstd * w0.x, v[2 * k].y * rstd * w0.y); pk.y = cvtpk(v[2 * k].z * rstd * w0.z, v[2 * k].w * rstd * w0.w);
            pk.z = cvtpk(v[2 * k + 1].x * rstd * w1.x, v[2 * k + 1].y * rstd * w1.y); pk.w = cvtpk(v[2 * k + 1].z * rstd * w1.z, v[2 * k + 1].w * rstd * w1.w);
            *(u32x4*)(mix + (m0 + t) * DM + DNW + LRW + g * HD + 32 * part + 8 * k) = pk; }
    }
    WG_SYNC();
}
#ifndef USE_DN
#define USE_DN 1
#endif
#ifndef USE_LRU
#define USE_LRU 1
#endif
#ifndef USE_SG
#define USE_SG 1
#endif
#define LAUNDER() int tid = tid0, bx = bx0, G = G0; unsigned char* ws = ws0; KIN in_ = (KIN)__builtin_amdgcn_kernarg_segment_ptr(); asm volatile("" : "+v"(tid), "+s"(bx), "+s"(G), "+s"(ws), "+s"(in_)); const int lane = tid & 63, wave = __builtin_amdgcn_readfirstlane(tid >> 6), gw = bx * NWAVES + wave, ngw = G * NWAVES, gtid = bx * NTHR + tid, ngt = G * NTHR; (void)lane; (void)wave; (void)gw; (void)ngw; (void)gtid; (void)ngt
#ifndef DUP_MASK
#define DUP_MASK 0
#endif
#ifndef DUP_SUB
#define DUP_SUB 0
#endif
#define SREP(b) (((DUP_SUB) & (b)) && l == 0 ? 2 : 1)
#define NREP(j) ((((DUP_MASK) >> (j)) & 1) && l == 0 ? 2 : 1)
constexpr int N_PHASES = 1 + 9 * DEPTH;
typedef const float* const __attribute__((address_space(4)))* KIN;
struct Args { const float* in[27]; float* out; unsigned char* ws; int ph_lo, ph_hi, li, pad; };
__global__ void __launch_bounds__(NTHR, 2) mega(Args a) {
    extern __shared__ __attribute__((aligned(16))) unsigned char lds_raw[];
    LAS unsigned char* lds = (LAS unsigned char*)lds_raw;
    const int tid0 = threadIdx.x, G0 = gridDim.x, bx0 = blockIdx.x;
    volatile LAS unsigned* MISC = (volatile LAS unsigned*)(lds + MISC_OFF);
    if (tid0 < 64) MISC[tid0] = 0u;
    __syncthreads();
    unsigned char* const ws0 = a.ws;
    XcdBarrier bar = xcd_barrier_post((unsigned*)(ws0 + WS_CTL) + CW_BAR + a.li * XCD_BAR_WORDS, MISC + 8);
    const int lo = a.ph_lo, hi = a.ph_hi;
#define IN(k) (lo <= (k) && (k) < hi)
#define SEAM(k) do { if (IN(k) && IN((k) + 1)) xcd_barrier(bar); } while (0)
#define hb ((bf16*)(ws + WS_HB))
#define proj ((bf16*)(ws + WS_PROJ))
#define mix ((bf16*)(ws + WS_MIX))
#define xa ((float*)(ws + WS_XA))
#define xb ((float*)(ws + WS_XB))
#define hid ((bf16*)(ws + WS_HID))
#define act ((bf16*)(ws + WS_ACT))
#define stg (ws + WS_STG)
#define ug ((float*)(ws + WS_UG))
#define decg ((float*)(ws + WS_DEC))
#define HL ((float*)(ws + WS_HL))
#define PC ((float*)(ws + WS_PC))
#define CAR ((float*)(ws + WS_CAR))

    if (IN(0)) for (int rep = 0; rep < (((DUP_MASK) & 1) ? 2 : 1); ++rep) { LAUNDER(); phase_prologue(lds, in_, ws, gw, ngw, gtid, ngt, wave, lane); }
    SEAM(0);
    for (int l = 0; l < DEPTH; ++l) {
        const int pb = 1 + 9 * l;
        const bf16* win = (const bf16*)(ws0 + WS_W + l * SZ_WL); const bf16* wout = (const bf16*)((const unsigned char*)win + SZ_WIN);
        const bf16* wup = (const bf16*)((const unsigned char*)wout + SZ_WOUT); const bf16* wdn = (const bf16*)((const unsigned char*)wup + SZ_WUP);
        if (IN(pb + 0)) for (int rep = 0; rep < NREP(1); ++rep) { LAUNDER(); pg8::Gemm g{hb, win, M, DINP, DM}; pg8::StaticOrder S; S.init(M, DINP, G, bx); pg8::EpiBf16<0> E{proj, DINP, nullptr, 0, 0, 1.f};
            pg8::gemm_phase<pg8::EpiBf16<0>, pg8::StaticOrder, true, true>(lds, g, S, E); }
        SEAM(pb + 0);
        if (IN(pb + 1)) for (int rep = 0; rep < NREP(2); ++rep) { LAUNDER();
#if USE_DN
            for (int r2 = 0; r2 < SREP(1); ++r2) for (int u = bx; u < DN_UNITS; u += G) dn_prep_unit(lds, tid, wave, lane, u, proj, in_[3] + (size_t)l * 4 * 3 * DNW, in_[4] + l * DNH, in_[5] + l * DNH, stg, ug, decg);
#endif
#if USE_SG
            phase_sg_stats(proj, (float*)(ws + WS_SGST), gw, ngw, lane);
#endif
#if USE_LRU
            for (int r2 = 0; r2 < SREP(2); ++r2) for (int u = bx; u < BATCH * LRB * 32; u += G) lru1_unit(lds, tid, wave, lane, u, proj, in_[7] + (size_t)l * 4 * LRW, in_[8] + l * LRW, (const bf16*)(ws + WS_WAT) + (size_t)l * LRB * HD * HD,
                                                                   (const bf16*)(ws + WS_WXT) + (size_t)l * LRB * HD * HD, in_[10] + l * LRW, in_[12] + l * LRW, in_[13] + l * LRW, HL, PC, CAR);
#endif
        }
        SEAM(pb + 1);
        if (IN(pb + 2)) for (int rep = 0; rep < NREP(3); ++rep) { LAUNDER();
            if (bx < BATCH * DNH && G > BATCH * DNH) {
#if USE_DN
                for (int r2 = 0; r2 < SREP(4); ++r2) dn_scan_bh(lds, tid, wave, lane, bx, stg, ug, decg, proj, in_[6] + l * HD, mix);
#endif
            } else {
                const int wb = bx - BATCH * DNH, nwb = G - BATCH * DNH;
#if USE_LRU
                for (int r2 = 0; r2 < SREP(8); ++r2) for (int u = wb; u < BATCH * LRB * 32; u += nwb) lru3_unit(lds, tid, u, proj, HL, PC, CAR, in_[14] + l * LRW, mix);
#endif
#if USE_SG
                for (int r2 = 0; r2 < SREP(16); ++r2) for (int u = wb; u < BATCH * 32 * SGG; u += nwb) sg_unit(lds, tid, wave, lane, u, proj, (const float*)(ws + WS_SGST), in_[15] + l * SGW, in_[16] + l * SGW, (const bf16*)(ws + WS_WSB) + (size_t)l * SGG * 128 * 128,
                                                                         in_[18] + l * SGG * 128, in_[19] + l * SGW, mix);
#endif
            }
        }
        SEAM(pb + 2);
        if (IN(pb + 3)) for (int rep = 0; rep < NREP(4); ++rep) { LAUNDER(); pg8::Gemm g{mix, wout, M, DM, DM}; pg8::StaticOrder S; S.init(M, DM, G, bx); EpiResF32 E{(l == 0) ? in_[0] : (const float*)xb, xa, DM};
            pg8::gemm_phase<EpiResF32, pg8::StaticOrder, true, true>(lds, g, S, E); }
        SEAM(pb + 3);
        if (IN(pb + 4)) for (int rep = 0; rep < NREP(5); ++rep) { LAUNDER(); rmsnorm_rows(xa, in_[21] + l * DM, hb, nullptr, gw, ngw, lane); }
        SEAM(pb + 4);
        if (IN(pb + 5)) for (int rep = 0; rep < NREP(6); ++rep) { LAUNDER(); pg8::Gemm g{hb, wup, M, 2 * DFF, DM}; pg8::StaticOrder S; S.init(M, 2 * DFF, G, bx); pg8::EpiBf16<0> E{hid, 2 * DFF, nullptr, 0, 0, 1.f};
            pg8::gemm_phase<pg8::EpiBf16<0>, pg8::StaticOrder, true, true>(lds, g, S, E); }
        SEAM(pb + 5);
        if (IN(pb + 6)) for (int rep = 0; rep < NREP(7); ++rep) { LAUNDER(); phase_ffn_act(hid, in_[23] + (size_t)l * 3 * 2 * DFF, in_[24] + (size_t)l * 2 * DFF, act, gw, ngw, lane); }
        SEAM(pb + 6);
        if (IN(pb + 7)) for (int rep = 0; rep < NREP(8); ++rep) { LAUNDER(); pg8::Gemm g{act, wdn, M, DM, DFF}; pg8::StaticOrder S; S.init(M, DM, G, bx); EpiResF32 E{xa, xb, DM};
            pg8::gemm_phase<EpiResF32, pg8::StaticOrder, true, true>(lds, g, S, E); }
        SEAM(pb + 7);
        if (IN(pb + 8)) for (int rep = 0; rep < NREP(9); ++rep) { LAUNDER(); if (l + 1 < DEPTH) rmsnorm_rows(xb, in_[1] + (l + 1) * DM, hb, nullptr, gw, ngw, lane); else rmsnorm_rows(xb, in_[26], nullptr, (float*)in_[27], gw, ngw, lane); }
        SEAM(pb + 8);
    }
#undef IN
#undef SEAM
#undef hb
#undef proj
#undef mix
#undef xa
#undef xb
#undef hid
#undef act
#undef stg
#undef ug
#undef decg
#undef HL
#undef PC
#undef CAR
}

extern "C" void kernel_launch(void* const* d_in, const int* in_sizes, int n_in, void* d_out, int out_size, void* d_ws, size_t ws_size, hipStream_t stream) {
    if (n_in != 27 || out_size != M * DM || ws_size < WS_END) { fprintf(stderr, "kernel_launch: unexpected shapes (n_in %d out %d ws %zu need %zu)\n", n_in, out_size, ws_size, (size_t)WS_END); return; }
    static int grid = 0;
    if (grid == 0) {
        int dev = 0, cus = 0, per_cu = 0;
        if (hipGetDevice(&dev) != hipSuccess || hipDeviceGetAttribute(&cus, hipDeviceAttributeMultiprocessorCount, dev) != hipSuccess) { fprintf(stderr, "kernel_launch: device query failed\n"); grid = -1; return; }
        if (hipFuncSetAttribute((const void*)mega, hipFuncAttributeMaxDynamicSharedMemorySize, LDS_BYTES) != hipSuccess) { fprintf(stderr, "kernel_launch: hipFuncSetAttribute(%d B LDS) failed\n", LDS_BYTES); grid = -1; return; }
        if (hipOccupancyMaxActiveBlocksPerMultiprocessor(&per_cu, (const void*)mega, NTHR, LDS_BYTES) != hipSuccess || per_cu < 1) { fprintf(stderr, "kernel_launch: occupancy query says %d blocks/CU\n", per_cu); }
        (void)hipGetLastError();
        grid = cus;
    }
    if (grid < 0) return;
    const float* const* in = (const float* const*)d_in; unsigned char* ws = (unsigned char*)d_ws;
    (void)hipMemsetAsync(ws + WS_CTL, 0, CTL_BYTES, stream);
    Args a{}; for (int i = 0; i < 27; ++i) a.in[i] = in[i]; a.out = (float*)d_out; a.ws = ws; a.pad = 0;
    int li = 0;
    auto launch = [&](int lo, int hi) { a.ph_lo = lo; a.ph_hi = hi; a.li = li++; hipLaunchKernelGGL(mega, dim3(grid), dim3(NTHR), LDS_BYTES, stream, a); };
#if USE_DN && USE_LRU && USE_SG
    launch(0, N_PHASES);
#else
    bf16* proj = (bf16*)(ws + WS_PROJ); bf16* mix = (bf16*)(ws + WS_MIX);
    float *qf = (float*)(ws + WS_QF), *kf = (float*)(ws + WS_KF), *vf = (float*)(ws + WS_VF), *of = (float*)(ws + WS_OF), *la = (float*)(ws + WS_LA), *lif = (float*)(ws + WS_LI), *sv = (float*)(ws + WS_SV), *sy = (float*)(ws + WS_SY);
    float* beta = (float*)(ws + WS_BG); float* gg = beta + M * DNH;
    int cur = 0;
    for (int l = 0; l < DEPTH; ++l) {
        const int pb = 1 + 9 * l;
        launch(cur, pb + 1); cur = pb + 1;
#if !USE_DN
        hipLaunchKernelGGL(k_dn_prep, dim3(M * DNH), dim3(128), 0, stream, (const bf16*)proj, in[3] + (size_t)l * 4 * 3 * DNW, in[4] + l * DNH, in[5] + l * DNH, qf, kf, vf, beta, gg);
        hipLaunchKernelGGL(k_dn_scan, dim3(BATCH * DNH), dim3(128), 0, stream, (const float*)qf, (const float*)kf, (const float*)vf, (const float*)beta, (const float*)gg, of);
        hipLaunchKernelGGL(k_groupnorm, dim3(M * DNH / 4), dim3(256), 0, stream, (const float*)of, DNW, in[6] + l * HD, (const bf16*)proj, mix, 0, 0);
#endif
#if !USE_LRU
        hipLaunchKernelGGL(k_lru_gates, dim3(M * LRB), dim3(128), 0, stream, (const bf16*)proj, in[7] + (size_t)l * 4 * LRW, in[8] + l * LRW, in[9] + (size_t)l * LRB * HD * HD, in[10] + l * LRW, in[11] + (size_t)l * LRB * HD * HD, in[12] + l * LRW, in[13] + l * LRW, la, lif);
        hipLaunchKernelGGL(k_lru_scan, dim3(BATCH * LRW / 64), dim3(64), 0, stream, (const float*)la, lif, (const bf16*)proj);
        hipLaunchKernelGGL(k_groupnorm, dim3(M * LRB / 4), dim3(256), 0, stream, (const float*)lif, LRW, in[14] + l * LRW, (const bf16*)proj, mix, DNW, 1);
#endif
#if !USE_SG
        hipLaunchKernelGGL(k_sg_ln, dim3(M), dim3(256), 0, stream, (const bf16*)proj, in[15] + l * SGW, in[16] + l * SGW, sv);
        hipLaunchKernelGGL(k_sg_mix, dim3(BATCH * (SEQ / 128) * SGG), dim3(128), 0, stream, (const float*)sv, in[17] + (size_t)l * SGG * 128 * 128, in[18] + l * SGG * 128, (const bf16*)proj, sy);
        hipLaunchKernelGGL(k_groupnorm, dim3(M * SGG / 4), dim3(256), 0, stream, (const float*)sy, SGW, in[19] + l * SGW, (const bf16*)proj, mix, DNW + LRW, 1);
#endif
    }
    launch(cur, N_PHASES);
#endif
}
```

```cpp
#include <hip/hip_runtime.h>
#include <cstdio>
#include <cstdint>
#define USE_DN 1
#define USE_LRU 1
#define USE_SG 1
#define DUP_MASK 0
#define DUP_SUB 0

namespace pg8 {
#define PG8_LAS __attribute__((address_space(3)))
typedef unsigned short bf16_t;
typedef short bf16x8 __attribute__((ext_vector_type(8)));
typedef float f32x4 __attribute__((ext_vector_type(4)));
typedef unsigned u32x4 __attribute__((ext_vector_type(4)));
constexpr int BM = 256, BK = 64, HALF = 128, HTB = HALF * BK * 2  , STAGE_BYTES = 8 * HTB, NXCD = 8, WGM = 8;

__host__ __device__ __forceinline__ int lds_byte(int r, int c) { const int st = (r >> 4) * 2 + (c >> 5), rr = r & 15, cc = c & 31, ob = rr * 64 + cc * 2; return st * 1024 + (ob ^ (((ob >> 9) & 1) << 5)); }
__host__ __device__ __forceinline__ void stage_rc(int b, int& R, int& C) { const int st = b / 1024, sb = b % 1024, swz = sb ^ (((sb >> 9) & 1) << 5); R = (st >> 1) * 16 + swz / 64; C = (st & 1) * 32 + (swz % 64) / 2; }
__host__ __device__ __forceinline__ int perm32(int rho) { const int n = rho >> 4, i = rho & 15; return 8 * (i >> 2) + 4 * n + (i & 3); }

struct Unit { int pm, pn; };
struct Gemm { const bf16_t* A; const bf16_t* Bt; int M, N, K; };

struct StaticOrder {
    int nM, nN, nwg, G, c;
    __host__ __device__ void init(int M, int N, int G_, int c_) { nM = M / BM; nN = N / BM; nwg = nM * nN; G = G_; c = c_; }
    __host__ __device__ bool next(int i, Unit& u) const {
        const long L = (long)i * G + c; if (L >= nwg) return false;
        int wgid = (int)L; { const int q = nwg / NXCD, r = nwg % NXCD, xcd = wgid % NXCD, off = wgid / NXCD; wgid = (xcd < r ? xcd * (q + 1) : r * (q + 1) + (xcd - r) * q) + off; }
        const int nig = WGM * nN, gid = wgid / nig, fm = gid * WGM, gsz = (nM - fm) < WGM ? (nM - fm) : WGM;
        u.pm = fm + ((wgid % nig) % gsz); u.pn = (wgid % nig) / gsz; return true;
    }
    __device__ __forceinline__ void a_ready(const Unit&) const {}
    __device__ __forceinline__ void done(const Unit&) const {}
};

__device__ __forceinline__ unsigned cvt_pk_bf16(float lo, float hi) { unsigned r; asm volatile("v_cvt_pk_bf16_f32 %0, %1, %2" : "=v"(r) : "v"(lo), "v"(hi)); return r; }
typedef float f32x2 __attribute__((ext_vector_type(2)));
__device__ __forceinline__ f32x2 gelu_pk(f32x2 v) {
    const f32x2 av = __builtin_elementwise_abs(v), d = av * 0.2316418882f + 1.0f;
    f32x2 t; t.x = __builtin_amdgcn_rcpf(d.x); t.y = __builtin_amdgcn_rcpf(d.y);
    f32x2 q = t * 0.5307027145f + (-0.7265760135f); q = q * t + 0.7107068705f; q = q * t + (-0.142248368f); q = q * t + 0.127414796f; q = q * t;
    const f32x2 s = (v * v) * (-0.72134752044f);
    f32x2 e; e.x = __builtin_amdgcn_exp2f(s.x); e.y = __builtin_amdgcn_exp2f(s.y);
    const f32x2 m = v * (q * e), r = v - m;
    f32x2 o; o.x = v.x < 0.f ? m.x : r.x; o.y = v.y < 0.f ? m.y : r.y; return o;
}

template <int ACT  > struct EpiBf16 {
    static constexpr bool PERM = true, AFTER_DRAIN = false; static_assert(ACT == 0 || ACT == 1, "EpiBf16: ACT is 0 (none) or 1 (gelu_pk)");
    bf16_t* O; int ldc; const float* bias; int split_cols; size_t split_stride; float scale0;
    __device__ __forceinline__ void operator()(const f32x4 (&acc)[2][2][4][2], const Unit& u, int wr, int wc, int fr, int fq) const {
        const int row0 = u.pm * BM + wr * 64 + fr; int colt = u.pn * BM; bf16_t* base = O;
        float sc = 1.f; if (split_cols) { const int t = colt / split_cols; base += (size_t)t * split_stride; colt -= t * split_cols; if (t == 0) sc = scale0; }
        const int col0 = colt + wc * 32 + 8 * fq, bcol0 = u.pn * BM + wc * 32 + 8 * fq;
        f32x4 bv[2][2];
#pragma unroll
        for (int bj = 0; bj < 2; ++bj)
#pragma unroll
            for (int n = 0; n < 2; ++n) bv[bj][n] = bias ? *(const f32x4*)(bias + bcol0 + bj * HALF + 4 * n) : (f32x4){0.f, 0.f, 0.f, 0.f};
#pragma unroll
        for (int ai = 0; ai < 2; ++ai)
#pragma unroll
            for (int m = 0; m < 4; ++m) { bf16_t* rowp = base + (size_t)(row0 + ai * HALF + m * 16) * ldc + col0;
#pragma unroll
                for (int bj = 0; bj < 2; ++bj) { f32x4 v0 = acc[ai][bj][m][0] + bv[bj][0], v1 = acc[ai][bj][m][1] + bv[bj][1];
                    if (ACT == 1) { f32x2 a = gelu_pk((f32x2){v0[0], v0[1]}), b = gelu_pk((f32x2){v0[2], v0[3]}), c = gelu_pk((f32x2){v1[0], v1[1]}), d = gelu_pk((f32x2){v1[2], v1[3]});
                        v0 = (f32x4){a.x, a.y, b.x, b.y}; v1 = (f32x4){c.x, c.y, d.x, d.y}; }
                    v0 = v0 * sc; v1 = v1 * sc; u32x4 w; w.x = cvt_pk_bf16(v0[0], v0[1]); w.y = cvt_pk_bf16(v0[2], v0[3]); w.z = cvt_pk_bf16(v1[0], v1[1]); w.w = cvt_pk_bf16(v1[2], v1[3]);
                    *(u32x4*)(rowp + bj * HALF) = w; } }
    }
};

template <class Epi, class Sched, bool ALIGN_EPI = false, bool SP2 = false>
__device__ __forceinline__ void gemm_phase(PG8_LAS unsigned char* lds, const Gemm g, const Sched& S, const Epi& E) {
    int tid_l = threadIdx.x; asm volatile("" : "+v"(tid_l));
    const int tid = tid_l, wid = __builtin_amdgcn_readfirstlane(tid >> 6), lane = tid & 63, wr = wid >> 2, wc = wid & 3, fr = lane & 15, fq = lane >> 4;
    const int K = g.K, nt = K / BK;
    unsigned voffA[2], voffB[2];
#pragma unroll
    for (int i = 0; i < 2; ++i) { int R, C; stage_rc(tid * 16 + i * 8192, R, C); const int Rb = Epi::PERM ? ((R & ~31) + perm32(R & 31)) : R;
        voffA[i] = (unsigned)(R * K + C) * 2u; voffB[i] = (unsigned)(Rb * K + C) * 2u; }
    const size_t kstep = (size_t)(BK * 2);
    const size_t hstep = (size_t)HALF * K * 2;
    const size_t tstep = 2 * hstep;
    const unsigned ldsw = (unsigned)wid * 1024u;
    const int aoff = lds_byte(wr * 64 + fr, fq * 8), boff = lds_byte(wc * 32 + fr, fq * 8);
#define PG8_SA(b, h) (((b) * 2 + (h)) * HTB)
#define PG8_SB(b, h) ((4 + (b) * 2 + (h)) * HTB)
#define PG8_STAGE(bufoff, gbase, voff) do { _Pragma("unroll") for (int _i = 0; _i < 2; ++_i) \
        __builtin_amdgcn_global_load_lds((const unsigned*)((const char*)(gbase) + (voff)[_i]), (PG8_LAS unsigned*)(lds + (bufoff) + ldsw + _i * 8192), 16, 0, 0); } while (0)
#define PG8_LDA(dst, b, h) do { _Pragma("unroll") for (int m = 0; m < 4; ++m) _Pragma("unroll") for (int k = 0; k < 2; ++k) dst[m][k] = *(const PG8_LAS bf16x8*)(lds + PG8_SA(b, h) + aoff + m * 2048 + k * 1024); } while (0)
#define PG8_LDB(dst, b, h) do { _Pragma("unroll") for (int n = 0; n < 2; ++n) _Pragma("unroll") for (int k = 0; k < 2; ++k) dst[n][k] = *(const PG8_LAS bf16x8*)(lds + PG8_SB(b, h) + boff + n * 2048 + k * 1024); } while (0)
#define PG8_MMA(ai, bj, At, Bt) do { __builtin_amdgcn_s_setprio(1); _Pragma("unroll") for (int m = 0; m < 4; ++m) _Pragma("unroll") for (int n = 0; n < 2; ++n) _Pragma("unroll") for (int k = 0; k < 2; ++k) \
        acc[ai][bj][m][n] = __builtin_amdgcn_mfma_f32_16x16x32_bf16(Bt[n][k], At[m][k], acc[ai][bj][m][n], 0, 0, 0); __builtin_amdgcn_s_setprio(0); } while (0)
#define PG8_WAIT_V(n) asm volatile("s_waitcnt vmcnt(" #n ")" ::: "memory")
#define PG8_WAIT_L(n) asm volatile("s_waitcnt lgkmcnt(" #n ")" ::: "memory")
#define PG8_BAR __builtin_amdgcn_s_barrier()
#define PG8_SCHED __builtin_amdgcn_sched_barrier(0)
    Unit cur, nxt; int ui = 0;
    if (!S.next(0, cur)) return;
    f32x4 acc[2][2][4][2];
#pragma unroll
    for (int a = 0; a < 2; ++a)
#pragma unroll
        for (int b = 0; b < 2; ++b)
#pragma unroll
            for (int m = 0; m < 4; ++m)
#pragma unroll
                for (int n = 0; n < 2; ++n) acc[a][b][m][n] = (f32x4){0.f, 0.f, 0.f, 0.f};
    bf16x8 At[4][2], B0[2][2], B1[2][2];
    const char* cA = (const char*)g.A + (size_t)cur.pm * tstep; const char* cB = (const char*)g.Bt + (size_t)cur.pn * tstep;
    S.a_ready(cur);
    if constexpr (SP2) {
        PG8_STAGE(PG8_SB(0, 0), cB, voffB); PG8_STAGE(PG8_SB(0, 1), cB + hstep, voffB); PG8_STAGE(PG8_SA(0, 0), cA, voffA); PG8_STAGE(PG8_SA(0, 1), cA + hstep, voffA);
        if (wr == 1) PG8_BAR;
        PG8_WAIT_V(2); PG8_BAR;
        PG8_STAGE(PG8_SB(1, 0), cB + kstep, voffB); PG8_STAGE(PG8_SA(1, 0), cA + kstep, voffA); PG8_STAGE(PG8_SB(1, 1), cB + hstep + kstep, voffB);
        PG8_WAIT_V(6); PG8_BAR;
    } else {
        PG8_STAGE(PG8_SB(0, 0), cB, voffB); PG8_STAGE(PG8_SA(0, 0), cA, voffA); PG8_STAGE(PG8_SB(0, 1), cB + hstep, voffB); PG8_STAGE(PG8_SA(0, 1), cA + hstep, voffA);
        if (wr == 1) PG8_BAR;
        PG8_WAIT_V(4); PG8_BAR;
        PG8_STAGE(PG8_SB(1, 0), cB + kstep, voffB); PG8_STAGE(PG8_SA(1, 0), cA + kstep, voffA); PG8_STAGE(PG8_SB(1, 1), cB + hstep + kstep, voffB);
        PG8_WAIT_V(6); PG8_BAR;
    }
    for (;;) {
        const bool has_next = S.next(ui + 1, nxt);
        const char* nA = has_next ? (const char*)g.A + (size_t)nxt.pm * tstep : cA; const char* nB = has_next ? (const char*)g.Bt + (size_t)nxt.pn * tstep : cB;
        for (int t = 0; t < nt; t += 2) {
            const bool last = (t == nt - 2);
            const char* a1 = cA + (size_t)(t + 1) * kstep;
            const char* a2 = last ? nA : cA + (size_t)(t + 2) * kstep; const char* b2 = last ? nB : cB + (size_t)(t + 2) * kstep;
            const char* a3 = a2 + kstep; const char* b3 = b2 + kstep;
            if (last && has_next) S.a_ready(nxt);
            if constexpr (SP2) {
            PG8_LDB(B0, 0, 0); PG8_LDB(B1, 0, 1); PG8_SCHED; PG8_LDA(At, 0, 0); PG8_STAGE(PG8_SA(1, 1), a1 + hstep, voffA);
            PG8_WAIT_V(8); PG8_WAIT_L(0); PG8_BAR; PG8_MMA(0, 0, At, B0); PG8_MMA(0, 1, At, B1); PG8_BAR; PG8_SCHED;
            PG8_LDA(At, 0, 1); PG8_STAGE(PG8_SB(0, 0), b2, voffB); PG8_STAGE(PG8_SB(0, 1), b2 + hstep, voffB); PG8_STAGE(PG8_SA(0, 0), a2, voffA);
            PG8_WAIT_V(8); PG8_WAIT_L(0); PG8_BAR; PG8_MMA(1, 0, At, B0); PG8_MMA(1, 1, At, B1); PG8_BAR; PG8_SCHED;
            PG8_LDB(B0, 1, 0); PG8_LDB(B1, 1, 1); PG8_SCHED; PG8_LDA(At, 1, 0); PG8_STAGE(PG8_SA(0, 1), a2 + hstep, voffA);
            PG8_WAIT_V(8); PG8_WAIT_L(0); PG8_BAR; PG8_MMA(0, 0, At, B0); PG8_MMA(0, 1, At, B1); PG8_BAR; PG8_SCHED;
            PG8_LDA(At, 1, 1); PG8_STAGE(PG8_SB(1, 0), b3, voffB); PG8_STAGE(PG8_SB(1, 1), b3 + hstep, voffB); PG8_STAGE(PG8_SA(1, 0), a3, voffA);
            PG8_WAIT_V(8); PG8_WAIT_L(0); PG8_BAR; PG8_MMA(1, 0, At, B0); PG8_MMA(1, 1, At, B1); PG8_BAR; PG8_SCHED;
            } else {
            PG8_LDB(B0, 0, 0); PG8_SCHED; PG8_LDA(At, 0, 0); PG8_STAGE(PG8_SA(1, 1), a1 + hstep, voffA);
            PG8_WAIT_L(8); PG8_BAR; PG8_WAIT_L(0); PG8_MMA(0, 0, At, B0); PG8_BAR; PG8_SCHED;
            PG8_LDB(B1, 0, 1); PG8_STAGE(PG8_SB(0, 0), b2, voffB);
            PG8_BAR; PG8_WAIT_L(0); PG8_MMA(0, 1, At, B1); PG8_BAR;
            PG8_LDA(At, 0, 1); PG8_STAGE(PG8_SA(0, 0), a2, voffA);
            PG8_BAR; PG8_WAIT_L(0); PG8_MMA(1, 0, At, B0); PG8_BAR; PG8_SCHED;
            PG8_STAGE(PG8_SB(0, 1), b2 + hstep, voffB);
            PG8_WAIT_V(6); PG8_BAR; PG8_MMA(1, 1, At, B1); PG8_BAR;
            PG8_LDB(B0, 1, 0); PG8_SCHED; PG8_LDA(At, 1, 0); PG8_STAGE(PG8_SA(0, 1), a2 + hstep, voffA);
            PG8_WAIT_L(8); PG8_BAR; PG8_WAIT_L(0); PG8_MMA(0, 0, At, B0); PG8_BAR; PG8_SCHED;
            PG8_LDB(B1, 1, 1); PG8_STAGE(PG8_SB(1, 0), b3, voffB);
            PG8_BAR; PG8_WAIT_L(0); PG8_MMA(0, 1, At, B1); PG8_BAR;
            PG8_LDA(At, 1, 1); PG8_STAGE(PG8_SA(1, 0), a3, voffA);
            PG8_BAR; PG8_WAIT_L(0); PG8_MMA(1, 0, At, B0); PG8_BAR; PG8_SCHED;
            PG8_STAGE(PG8_SB(1, 1), b3 + hstep, voffB);
            PG8_WAIT_V(6); PG8_BAR; PG8_MMA(1, 1, At, B1); PG8_BAR;
            }
        }
        if constexpr (ALIGN_EPI) { if (wr == 0) PG8_BAR; }
        if constexpr (!Epi::AFTER_DRAIN) { E(acc, cur, wr, wc, fr, fq); S.done(cur); }
        if (!has_next) break;
#pragma unroll
        for (int a = 0; a < 2; ++a)
#pragma unroll
            for (int b = 0; b < 2; ++b)
#pragma unroll
                for (int m = 0; m < 4; ++m)
#pragma unroll
                    for (int n = 0; n < 2; ++n) acc[a][b][m][n] = (f32x4){0.f, 0.f, 0.f, 0.f};
        cur = nxt; cA = nA; cB = nB; ++ui;
        if constexpr (ALIGN_EPI) { if (wr == 1) PG8_BAR; }
    }
    PG8_WAIT_V(0);
    if constexpr (!ALIGN_EPI) { if (wr == 0) PG8_BAR; }
    PG8_BAR;
    if constexpr (Epi::AFTER_DRAIN) { E.fused(acc, cur, wr, wc, fr, fq, lds, wid, lane); S.done(cur); }
#undef PG8_SA
#undef PG8_SB
#undef PG8_STAGE
#undef PG8_LDA
#undef PG8_LDB
#undef PG8_MMA
#undef PG8_WAIT_V
#undef PG8_WAIT_L
#undef PG8_BAR
#undef PG8_SCHED
}
}
constexpr int BATCH = 2, SEQ = 4096, M = BATCH * SEQ, DM = 4096, DEPTH = 2, HD = 128;
constexpr int DNW = 1536, LRW = 1536, SGW = 1024, DNH = 12, LRB = 12, SGG = 8, DFF = 11008, DIN = 11288, DINP = 11520;
constexpr int Q0 = 0, K0 = 1536, V0 = 3072, Z0 = 4608, LX0 = 6144, LG0 = 7680, SU0 = 9216, SV0 = 10240, BA0 = 11264;
constexpr float EPS = 1e-6f;
typedef unsigned short bf16;
typedef unsigned long long ssq_t;
__device__ __forceinline__ float ssq_rstd(ssq_t v) { return __builtin_amdgcn_rsqf((float)v * (1.0f / 65536.0f) * (1.0f / 4096.0f) + 1e-6f); }
__device__ __forceinline__ ssq_t ssq_fix(float s) { return (ssq_t)(s * 65536.0f + 0.5f); }
typedef float f32x4 __attribute__((ext_vector_type(4)));
typedef unsigned u32x4 __attribute__((ext_vector_type(4)));
typedef unsigned u32x2 __attribute__((ext_vector_type(2)));
#define LAS __attribute__((address_space(3)))
__device__ __forceinline__ unsigned f2bf(float f) { unsigned u = __builtin_bit_cast(unsigned, f); return (u + 0x7fffu + ((u >> 16) & 1u)) >> 16; }
__device__ __forceinline__ unsigned pk2(float lo, float hi) { return f2bf(lo) | (f2bf(hi) << 16); }
__device__ __forceinline__ float bf2f(unsigned short b) { return __builtin_bit_cast(float, ((unsigned)b) << 16); }
__device__ __forceinline__ float bflo(unsigned w) { return __builtin_bit_cast(float, w << 16); }
__device__ __forceinline__ float bfhi(unsigned w) { return __builtin_bit_cast(float, w & 0xffff0000u); }
__device__ __forceinline__ float rcpf_(float x) { return __builtin_amdgcn_rcpf(x); }
__device__ __forceinline__ float sigmoidf_(float x) { return rcpf_(1.0f + __expf(-x)); }
__device__ __forceinline__ float siluf_(float x) { return x * sigmoidf_(x); }
__device__ __forceinline__ float geluf_(float x) { const float u2 = 1.5957691216057308f * (x + 0.044715f * x * x * x); return x * rcpf_(1.0f + __expf(-u2)); }
__device__ __forceinline__ float softplusf_(float x) { return x > 20.f ? x : log1pf(expf(x)); }
__device__ __forceinline__ float wave_sum(float v) {
#pragma unroll
    for (int o = 1; o < 64; o <<= 1) v += __shfl_xor(v, o);
    return v;
}

__device__ __forceinline__ void transpose_item(const float* W, int K, int Nsrc, bf16* WT, int dst_row0, int src_col0, int nvalid  , const float* kscale, LAS float* scr, int kb, int lane) {
    const int k0 = 64 * kb, kr = lane >> 4, c4 = lane & 15; f32x4 v[16];
#pragma unroll
    for (int i = 0; i < 16; ++i) v[i] = (4 * c4 < nvalid) ? __builtin_nontemporal_load((const f32x4*)(W + (size_t)(k0 + 4 * i + kr) * Nsrc + src_col0 + 4 * c4)) : (f32x4){0.f, 0.f, 0.f, 0.f};
    if (kscale) {
#pragma unroll
        for (int i = 0; i < 16; ++i) v[i] = v[i] * kscale[k0 + 4 * i + kr]; }
#pragma unroll
    for (int i = 0; i < 16; ++i) { LAS float* d = scr + (4 * i + kr) * 65 + 4 * c4; d[0] = v[i].x; d[1] = v[i].y; d[2] = v[i].z; d[3] = v[i].w; }
    asm volatile("s_waitcnt lgkmcnt(0)" ::: "memory");
    const int nl = lane & 7, kc = lane >> 3;
#pragma unroll
    for (int j = 0; j < 8; ++j) { const LAS float* s = scr + (8 * kc) * 65 + 8 * j + nl;
        u32x4 o; o.x = pk2(s[0 * 65], s[1 * 65]); o.y = pk2(s[2 * 65], s[3 * 65]); o.z = pk2(s[4 * 65], s[5 * 65]); o.w = pk2(s[6 * 65], s[7 * 65]);
        *(u32x4*)(WT + (size_t)(dst_row0 + 8 * j + nl) * K + k0 + 8 * kc) = o; }
    asm volatile("s_waitcnt lgkmcnt(0)" ::: "memory");
}

struct EpiBf16Rs {
    static constexpr bool PERM = true, AFTER_DRAIN = false;
    bf16* O; int ldc; const ssq_t* ss;
    __device__ __forceinline__ void operator()(const pg8::f32x4 (&acc)[2][2][4][2], const pg8::Unit& u, int wr, int wc, int fr, int fq) const {
        const int row0 = u.pm * 256 + wr * 64 + fr, col0 = u.pn * 256 + wc * 32 + 8 * fq;
#pragma unroll
        for (int ai = 0; ai < 2; ++ai)
#pragma unroll
            for (int m = 0; m < 4; ++m) { const int row = row0 + ai * 128 + m * 16; const float rs = ssq_rstd(ss[row]); bf16* rowp = O + (size_t)row * ldc + col0;
#pragma unroll
                for (int bj = 0; bj < 2; ++bj) { const pg8::f32x4 v0 = acc[ai][bj][m][0] * rs, v1 = acc[ai][bj][m][1] * rs;
                    pg8::u32x4 w; w.x = pg8::cvt_pk_bf16(v0[0], v0[1]); w.y = pg8::cvt_pk_bf16(v0[2], v0[3]); w.z = pg8::cvt_pk_bf16(v1[0], v1[1]); w.w = pg8::cvt_pk_bf16(v1[2], v1[3]);
                    *(pg8::u32x4*)(rowp + bj * 128) = w; } }
    }
};

struct EpiResB16 {
    static constexpr bool PERM = true, AFTER_DRAIN = false;
    bf16* X; ssq_t* ss; int ldc;
    __device__ __forceinline__ void operator()(const pg8::f32x4 (&acc)[2][2][4][2], const pg8::Unit& u, int wr, int wc, int fr, int fq) const {
        const int row0 = u.pm * 256 + wr * 64 + fr, col0 = u.pn * 256 + wc * 32 + 8 * fq;
        u32x4 rv[8][2];
#pragma unroll
        for (int it = 0; it < 8; ++it) { const size_t off = (size_t)(row0 + (it >> 2) * 128 + (it & 3) * 16) * ldc + col0; rv[it][0] = *(const u32x4*)(X + off); rv[it][1] = *(const u32x4*)(X + off + 128); }
        __builtin_amdgcn_s_waitcnt(0x4F70);
#pragma unroll
        for (int it = 0; it < 8; ++it) { const int ai = it >> 2, m = it & 3, row = row0 + ai * 128 + m * 16; const size_t off = (size_t)row * ldc + col0; float s = 0.f;
#pragma unroll
            for (int bj = 0; bj < 2; ++bj) { float r8[8]; const u32x4 w = rv[it][bj]; r8[0] = bflo(w.x); r8[1] = bfhi(w.x); r8[2] = bflo(w.y); r8[3] = bfhi(w.y); r8[4] = bflo(w.z); r8[5] = bfhi(w.z); r8[6] = bflo(w.w); r8[7] = bfhi(w.w);
                const pg8::f32x4 v0 = acc[ai][bj][m][0] + (pg8::f32x4){r8[0], r8[1], r8[2], r8[3]}, v1 = acc[ai][bj][m][1] + (pg8::f32x4){r8[4], r8[5], r8[6], r8[7]};
                s += ((v0[0] * v0[0] + v0[1] * v0[1]) + (v0[2] * v0[2] + v0[3] * v0[3])) + ((v1[0] * v1[0] + v1[1] * v1[1]) + (v1[2] * v1[2] + v1[3] * v1[3]));
                u32x4 o; o.x = pg8::cvt_pk_bf16(v0[0], v0[1]); o.y = pg8::cvt_pk_bf16(v0[2], v0[3]); o.z = pg8::cvt_pk_bf16(v1[0], v1[1]); o.w = pg8::cvt_pk_bf16(v1[2], v1[3]);
                *(u32x4*)(X + off + bj * 128) = o; }
            s += __shfl_xor(s, 16); s += __shfl_xor(s, 32);
            if (fq == 0) __hip_atomic_fetch_add((__attribute__((address_space(1))) ssq_t*)(ss + row), ssq_fix(s), __ATOMIC_RELAXED, __HIP_MEMORY_SCOPE_AGENT); }
    }
};
#define XB_TMO      128
#define XB_XCNT(j)  (256  + 64 * (j))
#define XB_XSUB(j)  (1280 + 64 * (j))
#define XB_XGEN(j)  (2304 + 64 * (j))
#define XB_TOP      3328
#define XB_TOPGEN   3392
#define XCD_BAR_WORDS 3456
#define XB_SPIN_CAP (1u << 18)

__device__ __forceinline__ unsigned xb_ld(unsigned* p)              { return __hip_atomic_load(p, __ATOMIC_RELAXED, __HIP_MEMORY_SCOPE_AGENT); }
__device__ __forceinline__ unsigned xb_add(unsigned* p, unsigned v) { return __hip_atomic_fetch_add(p, v, __ATOMIC_RELAXED, __HIP_MEMORY_SCOPE_AGENT); }
__device__ __forceinline__ unsigned xb_xcc_id() { return (unsigned)__builtin_amdgcn_s_getreg((3 << 11) | 20) & 0xFu; }
#define XB_SPIN(cond, bar) do { unsigned _sp = 0; while (cond) { __builtin_amdgcn_s_sleep(1); \
    if ((++_sp & 255u) == 0u) { if (xb_ld(&(bar)[XB_TMO])) break; if (_sp > XB_SPIN_CAP) { atomicAdd(&(bar)[XB_TMO], 1u); break; } } } } while (0)

struct XcdBarrier {
    unsigned* bar; unsigned x;
    volatile LAS unsigned* st;
};

__device__ __forceinline__ XcdBarrier xcd_barrier_post(unsigned* bar, volatile LAS unsigned* st) {
    XcdBarrier b; b.bar = bar; b.x = xb_xcc_id(); b.st = st;
    if (threadIdx.x == 0) (void)xb_add(&bar[XB_XCNT(b.x)], 1u);
    return b;
}
__device__ __forceinline__ void xcd_barrier_complete(unsigned* bar, unsigned x, unsigned& nloc, unsigned& nx) {
    const unsigned G = gridDim.x * gridDim.y * gridDim.z;
    unsigned sum, cnt, mine, sp = 0u;
    for (;;) {
        sum = 0u; cnt = 0u; mine = 0u;
#pragma unroll
        for (unsigned j = 0; j < 16; ++j) { const unsigned c = xb_ld(&bar[XB_XCNT(j)]); sum += c; cnt += (c > 0u) ? 1u : 0u; mine = (j == x) ? c : mine; }
        if (sum == G) break;
        __builtin_amdgcn_s_sleep(1);
        if ((++sp & 255u) == 0u) { if (xb_ld(&bar[XB_TMO])) break; if (sp > XB_SPIN_CAP) { atomicAdd(&bar[XB_TMO], 1u); break; } }
    }
    nloc = mine > 0u ? mine : 1u; nx = cnt > 0u ? cnt : 1u;
}

__device__ __forceinline__ void xcd_barrier(const XcdBarrier& b) {
    asm volatile("s_waitcnt vmcnt(0)" ::: "memory");
    __syncthreads();
    if (threadIdx.x == 0) {
        unsigned* bar = b.bar;
        __builtin_amdgcn_s_waitcnt(0);
        unsigned nloc = b.st[0], nx = b.st[1];
        if (nloc == 0u) { xcd_barrier_complete(bar, b.x, nloc, nx); b.st[0] = nloc; b.st[1] = nx; }
        const unsigned old = xb_add(&bar[XB_XSUB(b.x)], 1u);
        const unsigned gen = old / nloc;
        if (old + 1u == (gen + 1u) * nloc) {
            __builtin_amdgcn_fence(__ATOMIC_RELEASE, "agent");
            asm volatile("s_waitcnt vmcnt(0)" ::: "memory");
            const unsigned og = xb_add(&bar[XB_TOP], 1u);
            const unsigned tg = og / nx;
            if (og + 1u == (tg + 1u) * nx) xb_add(&bar[XB_TOPGEN], 1u);
            else XB_SPIN(xb_ld(&bar[XB_TOPGEN]) == tg, bar);
            __builtin_amdgcn_fence(__ATOMIC_ACQUIRE, "agent");
            xb_add(&bar[XB_XGEN(b.x)], 1u);
            asm volatile("s_waitcnt vmcnt(0)" ::: "memory");
        } else {
            XB_SPIN(xb_ld(&bar[XB_XGEN(b.x)]) == gen, bar);
            __builtin_amdgcn_fence(__ATOMIC_ACQUIRE, "agent");
            asm volatile("s_waitcnt vmcnt(0)" ::: "memory");
        }
    }
    __syncthreads();
}

constexpr int NTHR = 512, NWAVES = 8;
constexpr int LDS_BYTES = 163840, MISC_OFF = LDS_BYTES - 256;
typedef short bf16x8 __attribute__((ext_vector_type(8)));
typedef float f32x16 __attribute__((ext_vector_type(16)));
#define MFMA16(a, b, c) __builtin_amdgcn_mfma_f32_16x16x32_bf16((a), (b), (c), 0, 0, 0)
#define MFMA32(a, b, c) __builtin_amdgcn_mfma_f32_32x32x16_bf16((a), (b), (c), 0, 0, 0)
#define WG_SYNC() do { asm volatile("s_waitcnt lgkmcnt(0)" ::: "memory"); __builtin_amdgcn_s_barrier(); asm volatile("" ::: "memory"); } while (0)
#define RAW_BAR() do { asm volatile("s_waitcnt lgkmcnt(0)" ::: "memory"); __builtin_amdgcn_s_barrier(); asm volatile("" ::: "memory"); } while (0)
typedef float f32x2_t __attribute__((ext_vector_type(2))); typedef __bf16 bf16x2_t __attribute__((ext_vector_type(2)));
__device__ __forceinline__ unsigned cvtpk(float lo, float hi) { const f32x2_t v = {lo, hi}; const bf16x2_t b = __builtin_convertvector(v, bf16x2_t); return __builtin_bit_cast(unsigned, b); }
__device__ __forceinline__ bf16x8 pack8(f32x4 a, f32x4 b) { u32x4 p; p.x = cvtpk(a.x, a.y); p.y = cvtpk(a.z, a.w); p.z = cvtpk(b.x, b.y); p.w = cvtpk(b.z, b.w); return __builtin_bit_cast(bf16x8, p); }
__device__ __forceinline__ int crow32(int i, int h) { return (i & 3) + 8 * (i >> 2) + 4 * h; }
__device__ __forceinline__ void unpack8(u32x4 w, float (&f)[8]) { f[0] = bflo(w.x); f[1] = bfhi(w.x); f[2] = bflo(w.y); f[3] = bfhi(w.y); f[4] = bflo(w.z); f[5] = bfhi(w.z); f[6] = bflo(w.w); f[7] = bfhi(w.w); }

constexpr size_t MiB = 1u << 20;
constexpr size_t SZ_WIN = (size_t)DINP * DM * 2, SZ_WOUT = (size_t)DM * DM * 2, SZ_WUP = (size_t)2 * DFF * DM * 2, SZ_WDN = (size_t)DM * DFF * 2;
constexpr size_t WS_CTL = 0, CTL_BYTES = 1 * MiB, WS_W = 1 * MiB, SZ_WL = SZ_WIN + SZ_WOUT + SZ_WUP + SZ_WDN;
constexpr size_t WS_HB = WS_W + 2 * SZ_WL, WS_PROJ = WS_HB + (size_t)M * DM * 2, WS_MIX = WS_PROJ + (size_t)M * DINP * 2, WS_XA = WS_MIX + (size_t)M * DM * 2, WS_XB = WS_XA + (size_t)M * DM * 4;
constexpr size_t WS_HID_OLD = WS_XB + (size_t)M * DM * 4, WS_ACT_OLD = WS_HID_OLD + (size_t)M * 2 * DFF * 2, WS_SCR = WS_ACT_OLD + (size_t)M * DFF * 2;
constexpr size_t WS_HID = WS_PROJ, WS_ACT = WS_HID + (size_t)M * 2 * DFF * 2;
static_assert(WS_ACT + (size_t)M * DFF * 2 <= WS_SCR, "hid | act overlay");
constexpr size_t SZ_F1536 = (size_t)M * 1536 * 4, SZ_F1024 = (size_t)M * 1024 * 4;
constexpr size_t WS_QF = WS_SCR, WS_KF = WS_QF + SZ_F1536, WS_VF = WS_KF + SZ_F1536, WS_OF = WS_VF + SZ_F1536, WS_LA = WS_OF + SZ_F1536, WS_LI = WS_LA + SZ_F1536,
                 WS_SV = WS_LI + SZ_F1536, WS_SY = WS_SV + SZ_F1024, WS_BG = WS_SY + SZ_F1024, WS_NAIVE_END = WS_BG + 2 * MiB;
constexpr int DN_UNITS = BATCH * DNH * 64, DN_STAGE = 73728, DN_W_OFF = 0, DN_KT_OFF = 16384, DN_UB_OFF = 32768, DN_Q_OFF = 49152, DN_AT_OFF = 65536, DN_SEQ_BYTES = 49152;

constexpr size_t WS_STG = WS_NAIVE_END, WS_UG = WS_STG + (size_t)DN_UNITS * DN_STAGE, WS_DEC = WS_UG + (size_t)DN_UNITS * 32768, WS_HL = WS_DEC + 1 * MiB, WS_PC = WS_HL + SZ_F1536,
                 WS_CAR = WS_PC + SZ_F1536, WS_WAT = WS_CAR + 1 * MiB, WS_WXT = WS_WAT + 1 * MiB, WS_WSB = WS_WXT + 1 * MiB, WS_SGST = WS_WSB + 1 * MiB, WS_TS = WS_SGST + 1 * MiB, WS_SALL = WS_TS + 1 * MiB, WS_END = WS_SALL + (size_t)DN_UNITS * 32768;
constexpr size_t WS_SS = WS_CTL + 512 * 1024;
constexpr int CW_BAR = 4096;

__device__ __forceinline__ void rows_to_bf16_ss(const float* x, bf16* ob, ssq_t* ss, int gw, int ngw, int lane) {
    for (int row = gw; row < M; row += ngw) {
        const f32x4* xr = (const f32x4*)(x + (size_t)row * DM) + lane; f32x4 v[16]; float s = 0.f;
#pragma unroll
        for (int j = 0; j < 16; ++j) { v[j] = __builtin_nontemporal_load(xr + 64 * j); s += (v[j].x * v[j].x + v[j].y * v[j].y) + (v[j].z * v[j].z + v[j].w * v[j].w); }
        s = wave_sum(s);
#pragma unroll
        for (int j = 0; j < 16; ++j) { u32x2 p; p.x = cvtpk(v[j].x, v[j].y); p.y = cvtpk(v[j].z, v[j].w); *((u32x2*)(ob + (size_t)row * DM) + lane + 64 * j) = p; }
        if (lane == 0) ss[row] = ssq_fix(s);
    }
}
__device__ __forceinline__ void final_norm_rows(const bf16* x, const ssq_t* ss, const float* w, float* of, int gw, int ngw, int lane) {
    for (int row = gw; row < M; row += ngw) {
        const u32x2* xr = (const u32x2*)(x + (size_t)row * DM) + lane; const f32x4* wr = (const f32x4*)w + lane; const float rstd = ssq_rstd(ss[row]);
#pragma unroll
        for (int j = 0; j < 16; ++j) { const u32x2 v = xr[64 * j]; const f32x4 o = (f32x4){bflo(v.x), bfhi(v.x), bflo(v.y), bfhi(v.y)} * rstd * wr[64 * j]; __builtin_nontemporal_store(o, (f32x4*)(of + (size_t)row * DM) + lane + 64 * j); }
    }
}
constexpr int I_IN = (DINP / 64) * (DM / 64), I_OUT = (DM / 64) * (DM / 64), I_UP = (2 * DFF / 64) * (DM / 64), I_DN = (DM / 64) * (DFF / 64), I_L = I_IN + I_OUT + I_UP + I_DN;
#ifndef TF_UP
#define TF_UP 9216
#endif
#ifndef TF_DN
#define TF_DN 6144
#endif
#ifndef TF_IN1
#define TF_IN1 4096
#endif
#ifndef TF_DN2
#define TF_DN2 4096
#endif
constexpr int I_KEPT = I_L - TF_UP - TF_DN, I_KEPT_A = I_IN + I_OUT + I_UP - TF_UP, I_KEPT1 = I_KEPT - TF_IN1 - TF_DN2;
static_assert(DEPTH == 2, "deferred weight-conversion bookkeeping assumes two layers");
template <class INP> __device__ __forceinline__ void convert_item(INP in, unsigned char* ws, int it, LAS float* scr, int lane) {
    const int l = it / I_L; int r = it % I_L;
    bf16* win = (bf16*)(ws + WS_W + l * SZ_WL); bf16* wout = (bf16*)((unsigned char*)win + SZ_WIN); bf16* wup = (bf16*)((unsigned char*)wout + SZ_WOUT); bf16* wdn = (bf16*)((unsigned char*)wup + SZ_WUP);
    if (r < I_IN) { const int nblk = DINP / 64, kb = r / nblk, n0 = (r % nblk) * 64; int src = n0, nv = 64;
        if (n0 < 6144) { src = n0; } else if (n0 < 11264) { src = n0 + 24; } else if (n0 == 11264) { src = 6144; nv = 24; } else { src = 0; nv = 0; }
        transpose_item(in[2] + (size_t)l * DM * DIN, DM, DIN, win, n0, src, nv, in[1] + l * DM, scr, kb, lane); return; }
    r -= I_IN;
    if (r < I_OUT) { const int nblk = DM / 64; transpose_item(in[20] + (size_t)l * DM * DM, DM, DM, wout, (r % nblk) * 64, (r % nblk) * 64, 64, nullptr, scr, r / nblk, lane); return; }
    r -= I_OUT;
    if (r < I_UP) { const int nblk = 2 * DFF / 64; const int n0 = (r % nblk) * 64, cch = n0 < DFF ? n0 : n0 - DFF;
        transpose_item(in[22] + (size_t)l * DM * 2 * DFF, DM, 2 * DFF, wup, (cch >> 7) * 256 + (n0 < DFF ? 0 : 128) + (cch & 127), n0, 64, in[21] + l * DM, scr, r / nblk, lane); return; }
    r -= I_UP;
    { const int nblk = DM / 64; transpose_item(in[25] + (size_t)l * DFF * DM, DFF, DM, wdn, (r % nblk) * 64, (r % nblk) * 64, 64, nullptr, scr, r / nblk, lane); }
}
template <class INP> __device__ __forceinline__ void convert_deferred(LAS unsigned char* lds, INP in, unsigned char* ws, int l, int which, int bx, int G, int wg_from, int wave, int lane) {
    LAS float* scr = (LAS float*)(lds + wave * 16640);
    const int first = l * I_L + (which == 0 ? I_IN + I_OUT + I_UP - TF_UP : which == 1 ? I_L - TF_DN : which == 2 ? I_IN - TF_IN1 : I_L - TF_DN - TF_DN2), cnt = which == 0 ? TF_UP : which == 1 ? TF_DN : which == 2 ? TF_IN1 : TF_DN2;
    for (int k = (bx - wg_from) * NWAVES + wave; k < cnt; k += (G - wg_from) * NWAVES) convert_item(in, ws, first + k, scr, lane);
}
template <class INP> __device__ __forceinline__ void phase_prologue(LAS unsigned char* lds, INP in, unsigned char* ws, int gw, int ngw, int gtid, int ngt, int wave, int lane) {
    LAS float* scr = (LAS float*)(lds + wave * 16640);
    for (int j = gw; j < I_KEPT + I_KEPT1; j += ngw) { const int l = j >= I_KEPT; int r = j - l * I_KEPT;
        if (l && r >= I_IN - TF_IN1) r += TF_IN1;
        convert_item(in, ws, l * I_L + (r < I_KEPT_A ? r : r + TF_UP), scr, lane); }
    bf16* wat = (bf16*)(ws + WS_WAT); bf16* wxt = (bf16*)(ws + WS_WXT); bf16* wsb = (bf16*)(ws + WS_WSB);
    for (int i = gtid; i < DEPTH * LRB * HD * HD; i += ngt) { const int ii = i & 127, j = (i >> 7) & 127, lg = i >> 14; const size_t src = ((size_t)lg * HD + ii) * HD + j;
        wat[i] = (bf16)f2bf(in[9][src]); wxt[i] = (bf16)f2bf(in[11][src]); }
    for (int i = gtid; i < DEPTH * SGG * 128 * 128; i += ngt) { const int s = i & 127, t = (i >> 7) & 127; wsb[i] = (s <= t) ? (bf16)f2bf(in[17][i]) : (bf16)0; }
    rows_to_bf16_ss(in[0], (bf16*)(ws + WS_HB), (ssq_t*)(ws + WS_SS), gw, ngw, lane);
}

template <int CTRL> __device__ __forceinline__ float dppf(float v) {
#if defined(NO_DPP)
    return v;
#endif
    return __builtin_bit_cast(float, __builtin_amdgcn_update_dpp(0, __builtin_bit_cast(int, v), CTRL, 0xF, 0xF, true)); }
struct EpiFfnAct {
    static constexpr bool PERM = true, AFTER_DRAIN = false;
    bf16* A_; bf16* H_; const ssq_t* ss; const float* cw; const float* cb; LAS unsigned char* lds;
    __device__ __forceinline__ void operator()(const pg8::f32x4 (&acc)[2][2][4][2], const pg8::Unit& u, int wr, int wc, int fr, int fq) const {
        const int row0 = u.pm * 256 + wr * 64 + fr, colg = u.pn * 128 + wc * 32 + 8 * fq;
        LAS float* halo = (LAS float*)(lds + pg8::STAGE_BYTES);
        LAS float* WT = (LAS float*)(lds + pg8::STAGE_BYTES + 8192);
        LAS float* RT = WT + 1024;
        {
            const int wid_ = wr * 4 + wc, ln = fq * 16 + fr, bj = wid_ >> 2, arr = wid_ & 3;
            const float* src = (arr < 3 ? cw + (size_t)arr * 2 * DFF : cb) + bj * DFF + u.pn * 128;
            typedef float f32x2_ __attribute__((ext_vector_type(2)));
            const f32x2_ wv = *(const f32x2_*)((const char*)src + (unsigned)(ln * 8));
            if (wid_ < 4) { const ssq_t sv = *(const ssq_t*)((const char*)(ss + u.pm * 256) + (unsigned)((wid_ * 64 + ln) * 8)); RT[wid_ * 64 + ln] = ssq_rstd(sv); }
            *(LAS f32x2_*)(WT + wid_ * 128 + 2 * ln) = wv;
        }
        asm volatile("s_waitcnt lgkmcnt(0)" ::: "memory"); __builtin_amdgcn_s_barrier();
        const float rs03 = RT[wr * 64 + fr + 48], rs13 = RT[wr * 64 + fr + 176], rs00 = RT[wr * 64 + fr];
        if (fr >= 14) {
#pragma unroll
            for (int ai = 0; ai < 2; ++ai)
#pragma unroll
                for (int bj = 0; bj < 2; ++bj) { LAS float* d = halo + (((((2 * ai + wr) * 2 + (fr - 14)) * 4 + wc) * 2 + bj) * 4 + fq) * 8;
                    const float r3 = ai ? rs13 : rs03; *(LAS pg8::f32x4*)d = acc[ai][bj][3][0] * r3; *(LAS pg8::f32x4*)(d + 4) = acc[ai][bj][3][1] * r3; }
        }
        if ((wr == 0 && fr < 2) || (wr == 1 && fr >= 14)) {
#pragma unroll
            for (int bj = 0; bj < 2; ++bj) { const float r_ = wr == 0 ? rs00 : rs13; const pg8::f32x4 v0 = (wr == 0 ? acc[0][bj][0][0] : acc[1][bj][3][0]) * r_, v1 = (wr == 0 ? acc[0][bj][0][1] : acc[1][bj][3][1]) * r_;
                u32x4 o; o.x = cvtpk(v0[0], v0[1]); o.y = cvtpk(v0[2], v0[3]); o.z = cvtpk(v1[0], v1[1]); o.w = cvtpk(v1[2], v1[3]);
                *(u32x4*)(H_ + (size_t)(row0 + (wr == 0 ? 0 : 176)) * (2 * DFF) + u.pn * 256 + bj * 128 + wc * 32 + 8 * fq) = o; }
        }
        asm volatile("s_waitcnt lgkmcnt(0)" ::: "memory"); __builtin_amdgcn_s_barrier();
        const bool l15 = fr == 15, l1415 = fr >= 14;
#pragma unroll
        for (int ai = 0; ai < 2; ++ai) { asm volatile("" ::: "memory"); float rs[4];
#pragma unroll
            for (int m = 0; m < 4; ++m) rs[m] = RT[wr * 64 + fr + ai * 128 + m * 16];
#pragma unroll
            for (int n = 0; n < 2; ++n) { pg8::f32x4 yg[4]; asm volatile("" ::: "memory");
#pragma unroll
                for (int bj = 0; bj < 2; ++bj) { const int ch = bj * DFF + colg + 4 * n;
                    const LAS float* wt = WT + bj * 512 + wc * 32 + 8 * fq + 4 * n; (void)ch;
                    const pg8::f32x4 w0 = *(const LAS pg8::f32x4*)wt, w1 = *(const LAS pg8::f32x4*)(wt + 128), w2 = *(const LAS pg8::f32x4*)(wt + 256), bb = *(const LAS pg8::f32x4*)(wt + 384);
                    pg8::f32x4 hc = acc[ai][bj][3][n] * rs[3];
#pragma unroll
                    for (int mm = 0; mm < 4; ++mm) { const int m = 3 - mm; pg8::f32x4 hp;
                        if (m > 0) hp = acc[ai][bj][m > 0 ? m - 1 : 0][n] * rs[m > 0 ? m - 1 : 0];
                        else if (2 * ai + wr > 0) hp = *(const LAS pg8::f32x4*)(halo + (((((2 * ai + wr - 1) * 2 + (fr & 1)) * 4 + wc) * 2 + bj) * 4 + fq) * 8 + 4 * n);
                        else hp = (pg8::f32x4){0.f, 0.f, 0.f, 0.f};
                        pg8::f32x4 h1, h2;
#pragma unroll
                        for (int i = 0; i < 4; ++i) { h1[i] = dppf<0x121>(l15 ? hp[i] : hc[i]); h2[i] = dppf<0x122>(l1415 ? hp[i] : hc[i]); }
                        const pg8::f32x4 y = bb + w2 * hc + w1 * h1 + w0 * h2;
                        if (bj == 0) yg[m] = y;
                        else { u32x2 o; o.x = cvtpk(siluf_(yg[m][0]) * y[0], siluf_(yg[m][1]) * y[1]); o.y = cvtpk(siluf_(yg[m][2]) * y[2], siluf_(yg[m][3]) * y[3]);
                            *(u32x2*)((char*)A_ + (unsigned)((row0 + ai * 128 + m * 16) * DFF + colg + 4 * n) * 2u) = o; }
                        hc = hp; }
                }
            }
        }
    }
};
__device__ __forceinline__ void phase_ffn_fix(const bf16* hidp, const float* cw, const float* cb, bf16* actp, int gtid, int ngt) {
    constexpr int NOCT = DFF / 8;
    for (int it = gtid; it < (M / 256) * NOCT; it += ngt) { const int pm = it / NOCT, oct = it % NOCT, r0 = pm * 256;
        if (r0 % SEQ == 0) continue;
        const int c0 = oct * 8, colp = (c0 >> 7) * 256 + (c0 & 127);
        float g[4][8], uu[4][8];
#pragma unroll
        for (int r = 0; r < 4; ++r) { const bf16* pr = hidp + (size_t)(r0 - 2 + r) * (2 * DFF) + colp; unpack8(*(const u32x4*)pr, g[r]); unpack8(*(const u32x4*)(pr + 128), uu[r]); }
        float wg[3][8], wu[3][8], bg[8], bu[8];
#pragma unroll
        for (int j = 0; j < 3; ++j)
#pragma unroll
            for (int i = 0; i < 8; ++i) { wg[j][i] = cw[(size_t)j * 2 * DFF + c0 + i]; wu[j][i] = cw[(size_t)j * 2 * DFF + DFF + c0 + i]; }
#pragma unroll
        for (int i = 0; i < 8; ++i) { bg[i] = cb[c0 + i]; bu[i] = cb[DFF + c0 + i]; }
#pragma unroll
        for (int r = 0; r < 2; ++r) { float o[8];
#pragma unroll
            for (int i = 0; i < 8; ++i) { const float yg = bg[i] + wg[0][i] * g[r][i] + wg[1][i] * g[r + 1][i] + wg[2][i] * g[r + 2][i], yu = bu[i] + wu[0][i] * uu[r][i] + wu[1][i] * uu[r + 1][i] + wu[2][i] * uu[r + 2][i];
                o[i] = siluf_(yg) * yu; }
            u32x4 pk; pk.x = cvtpk(o[0], o[1]); pk.y = cvtpk(o[2], o[3]); pk.z = cvtpk(o[4], o[5]); pk.w = cvtpk(o[6], o[7]);
            *(u32x4*)(actp + (size_t)(r0 + r) * DFF + c0) = pk; }
    }
}

__device__ __forceinline__ void phase_ffn_act(const bf16* hid, const float* cw, const float* cb, bf16* act, int gw, int ngw, int lane) {
    constexpr int NOG = (DFF / 8 + 63) / 64, NSTRIP = M / 16;
    for (int item = gw; item < NOG * NSTRIP; item += ngw) {
        const int strip = item / NOG, og = item % NOG, oct = og * 64 + lane;
        if (oct < DFF / 8) {
            const int c0 = oct * 8, m0 = strip * 16, t0 = m0 % SEQ;
            float wg[3][8], wu[3][8], bg[8], bu[8];
#pragma unroll
            for (int j = 0; j < 3; ++j) { const f32x4 a0 = *(const f32x4*)(cw + (size_t)j * 2 * DFF + c0), a1 = *(const f32x4*)(cw + (size_t)j * 2 * DFF + c0 + 4), b0 = *(const f32x4*)(cw + (size_t)j * 2 * DFF + DFF + c0), b1 = *(const f32x4*)(cw + (size_t)j * 2 * DFF + DFF + c0 + 4);
                wg[j][0] = a0.x; wg[j][1] = a0.y; wg[j][2] = a0.z; wg[j][3] = a0.w; wg[j][4] = a1.x; wg[j][5] = a1.y; wg[j][6] = a1.z; wg[j][7] = a1.w;
                wu[j][0] = b0.x; wu[j][1] = b0.y; wu[j][2] = b0.z; wu[j][3] = b0.w; wu[j][4] = b1.x; wu[j][5] = b1.y; wu[j][6] = b1.z; wu[j][7] = b1.w; }
            { const f32x4 a0 = *(const f32x4*)(cb + c0), a1 = *(const f32x4*)(cb + c0 + 4), b0 = *(const f32x4*)(cb + DFF + c0), b1 = *(const f32x4*)(cb + DFF + c0 + 4);
              bg[0] = a0.x; bg[1] = a0.y; bg[2] = a0.z; bg[3] = a0.w; bg[4] = a1.x; bg[5] = a1.y; bg[6] = a1.z; bg[7] = a1.w; bu[0] = b0.x; bu[1] = b0.y; bu[2] = b0.z; bu[3] = b0.w; bu[4] = b1.x; bu[5] = b1.y; bu[6] = b1.z; bu[7] = b1.w; }
            float g0[8], g1[8], u0[8], u1[8];
            if (t0 > 0) { const bf16* pr = hid + (size_t)(m0 - 2) * (2 * DFF) + c0;
                unpack8(*(const u32x4*)pr, g0); unpack8(*(const u32x4*)(pr + DFF), u0); unpack8(*(const u32x4*)(pr + 2 * DFF), g1); unpack8(*(const u32x4*)(pr + 3 * DFF), u1); }
            else {
#pragma unroll
                for (int i = 0; i < 8; ++i) { g0[i] = 0.f; g1[i] = 0.f; u0[i] = 0.f; u1[i] = 0.f; } }
#pragma unroll 4
            for (int r = 0; r < 16; ++r) {
                const bf16* pr = hid + (size_t)(m0 + r) * (2 * DFF) + c0; float g2[8], u2[8]; unpack8(*(const u32x4*)pr, g2); unpack8(*(const u32x4*)(pr + DFF), u2);
                float o[8];
#pragma unroll
                for (int i = 0; i < 8; ++i) { const float yg = bg[i] + wg[0][i] * g0[i] + wg[1][i] * g1[i] + wg[2][i] * g2[i], yu = bu[i] + wu[0][i] * u0[i] + wu[1][i] * u1[i] + wu[2][i] * u2[i];
                    o[i] = siluf_(yg) * yu; g0[i] = g1[i]; g1[i] = g2[i]; u0[i] = u1[i]; u1[i] = u2[i]; }
                u32x4 pk; pk.x = cvtpk(o[0], o[1]); pk.y = cvtpk(o[2], o[3]); pk.z = cvtpk(o[4], o[5]); pk.w = cvtpk(o[6], o[7]);
                *(u32x4*)(act + (size_t)(m0 + r) * DFF + c0) = pk;
            }
        }
    }
}
__device__ __forceinline__ void phase_sg_stats(const bf16* proj, float* sgst, int gw, int ngw, int lane) {
    for (int m = gw; m < M; m += ngw) { const bf16* p = proj + (size_t)m * DINP + SV0 + 8 * lane; float s = 0.f, s2 = 0.f;
#pragma unroll
        for (int jj = 0; jj < 2; ++jj) { const u32x4 v = *(const u32x4*)(p + 512 * jj); float f[8]; unpack8(v, f);
#pragma unroll
            for (int i = 0; i < 8; ++i) { const float gv = geluf_(f[i]); s += gv; s2 += gv * gv; } }
        s = wave_sum(s); s2 = wave_sum(s2);
        if (lane == 0) { const float mu = s * (1.0f / SGW); float var = s2 * (1.0f / SGW) - mu * mu; var = var > 0.f ? var : 0.f; sgst[2 * m] = mu; sgst[2 * m + 1] = 1.0f / sqrtf(var + EPS); } }
}

#if defined(DIAG)
#define DP_STAMP(k) do { if (tid == 0 && unit >= (int)gridDim.x && unit < 2 * (int)gridDim.x) *(volatile LAS unsigned long long*)(lds + MISC_OFF - 256 + 8 * (k)) = __builtin_amdgcn_s_memrealtime(); } while (0)
#else
#define DP_STAMP(k) do { } while (0)
#endif
__device__ __forceinline__ void dn_gates_all(LAS unsigned char* lds, int wave, int lane, int bx, int G, const bf16* proj, const float* a_log, const float* dt_bias, float* dec_all) {
    const int unit = bx + wave * G;
    if (unit < DN_UNITS) {
        const int n = unit & 63, bh = unit >> 6, b = bh / DNH, h = bh % DNH; const size_t m = (size_t)b * SEQ + n * 64 + lane;
        LAS float* SMb = (LAS float*)(lds + 145408 + wave * 1280);
        const float braw = bf2f(proj[m * DINP + BA0 + h]), araw = bf2f(proj[m * DINP + BA0 + DNH + h]);
        const float beta = sigmoidf_(braw), g = -expf(a_log[h]) * softplusf_(araw + dt_bias[h]);
        float gc = g;
#pragma unroll
        for (int o = 1; o < 64; o <<= 1) { const float t = __shfl_up(gc, o); if (lane >= o) gc += t; }
        const float gl = __shfl(gc, 63);
        const float eg = __expf(gc); SMb[lane] = beta; SMb[64 + lane] = gc; SMb[128 + lane] = eg; SMb[192 + lane] = __expf(gl - gc); SMb[256 + lane] = beta * eg;
        if (lane == 63) dec_all[unit] = eg;
    }
    WG_SYNC();
}
__device__ __forceinline__ void dn_prep_unit(LAS unsigned char* lds, int tid, int wave, int lane, int unit, int unit_next, int slot, const bf16* proj, const float* convw, const float* a_log, const float* dt_bias,
                                             unsigned char* stg_all, float* ug_all, float* dec_all) {
    const int n = unit & 63, bh = unit >> 6, b = bh / DNH, h = bh % DNH, t0 = n * 64; const size_t m0 = (size_t)b * SEQ + t0;
    DP_STAMP(22);
    LAS float* KS = (LAS float*)(lds); LAS float* VS = (LAS float*)(lds + 33792);
    LAS bf16* QB = (LAS bf16*)(lds + 67584); LAS bf16* KB = (LAS bf16*)(lds + 84992);
    LAS float* AM = (LAS float*)(lds + 102400); LAS float* AT = (LAS float*)(lds + 119808);
    const LAS float* SMb = (const LAS float*)(lds + 145408 + slot * 1280);
    unsigned char* stg = stg_all + (size_t)unit * DN_STAGE; float* ug = ug_all + (size_t)unit * 8192;
    {
        const int rb = tid >> 4, cg = tid & 15;
        u32x4 xr[3][5];
#pragma unroll
        for (int p = 0; p < 3; ++p)
#pragma unroll
            for (int k = 0; k < 5; ++k) { const int rr = 2 * rb - 3 + k; xr[p][k] = (t0 + rr >= 0) ? *(const u32x4*)(proj + (size_t)((long)m0 + rr) * DINP + p * DNW + h * HD + cg * 8) : (u32x4){0u, 0u, 0u, 0u}; }
#pragma unroll
        for (int p = 0; p < 3; ++p) {
            const int c0 = p * DNW + h * HD + cg * 8;
            float w[4][8];
#pragma unroll
            for (int j = 0; j < 4; ++j) { const f32x4 a = *(const f32x4*)(convw + j * 3 * DNW + c0), bq = *(const f32x4*)(convw + j * 3 * DNW + c0 + 4);
                w[j][0] = a.x; w[j][1] = a.y; w[j][2] = a.z; w[j][3] = a.w; w[j][4] = bq.x; w[j][5] = bq.y; w[j][6] = bq.z; w[j][7] = bq.w; }
            float x[5][8];
#pragma unroll
            for (int k = 0; k < 5; ++k) unpack8(xr[p][k], x[k]);
#pragma unroll
            for (int rr = 0; rr < 2; ++rr) {
                const int row = 2 * rb + rr; float y[8]; float ss = 0.f;
#pragma unroll
                for (int i = 0; i < 8; ++i) { float a = 0.f;
#pragma unroll
                    for (int j = 0; j < 4; ++j) a += w[j][i] * x[rr + j][i];
                    y[i] = siluf_(a); ss += y[i] * y[i]; }
                if (p < 2) { ss += __shfl_xor(ss, 1); ss += __shfl_xor(ss, 2); ss += __shfl_xor(ss, 4); ss += __shfl_xor(ss, 8); const float rn = 1.0f / sqrtf(ss + EPS);
#pragma unroll
                    for (int i = 0; i < 8; ++i) y[i] *= rn; }
                if (p == 0) {
                    u32x4 pk; pk.x = cvtpk(y[0], y[1]); pk.y = cvtpk(y[2], y[3]); pk.z = cvtpk(y[4], y[5]); pk.w = cvtpk(y[6], y[7]);
                    *(LAS u32x4*)(QB + row * 136 + cg * 8) = pk;
                    const float sc = SMb[128 + row] * 0.08838834764831845f;
                    const int mt = row >> 4, rp = row & 15, s = cg >> 2, jj = (cg & 3) >> 1, q0 = 2 * (cg & 1);
                    u32x2 a0, a1; a0.x = cvtpk(y[0] * sc, y[1] * sc); a0.y = cvtpk(y[2] * sc, y[3] * sc); a1.x = cvtpk(y[4] * sc, y[5] * sc); a1.y = cvtpk(y[6] * sc, y[7] * sc);
                    bf16* qf = (bf16*)(stg + DN_Q_OFF);
                    *(u32x2*)(qf + ((size_t)((mt * 4 + s) * 64 + q0 * 16 + rp)) * 8 + 4 * jj) = a0;
                    *(u32x2*)(qf + ((size_t)((mt * 4 + s) * 64 + (q0 + 1) * 16 + rp)) * 8 + 4 * jj) = a1;
                } else if (p == 1) {
                    *(LAS f32x4*)(KS + row * 132 + cg * 8) = (f32x4){y[0], y[1], y[2], y[3]}; *(LAS f32x4*)(KS + row * 132 + cg * 8 + 4) = (f32x4){y[4], y[5], y[6], y[7]};
                    u32x4 pk; pk.x = cvtpk(y[0], y[1]); pk.y = cvtpk(y[2], y[3]); pk.z = cvtpk(y[4], y[5]); pk.w = cvtpk(y[6], y[7]);
                    *(LAS u32x4*)(KB + row * 136 + cg * 8) = pk;
                } else {
                    const float bt = SMb[row];
                    *(LAS f32x4*)(VS + row * 132 + cg * 8) = (f32x4){y[0] * bt, y[1] * bt, y[2] * bt, y[3] * bt}; *(LAS f32x4*)(VS + row * 132 + cg * 8 + 4) = (f32x4){y[4] * bt, y[5] * bt, y[6] * bt, y[7] * bt};
                }
            }
        }
    }
    WG_SYNC(); DP_STAMP(24);
    {
        const int p = wave >> 2, mt = wave & 3, r = lane & 15, q = lane >> 4;
        LAS bf16* Aop = p ? QB : KB;
#pragma unroll
        for (int nt = 0; nt < 4; ++nt) {
            if (nt <= mt) {
                f32x4 acc = (f32x4){0.f, 0.f, 0.f, 0.f};
#pragma unroll
                for (int s = 0; s < 4; ++s) { const bf16x8 a = *(const LAS bf16x8*)(Aop + (16 * mt + r) * 136 + 32 * s + 8 * q), bb = *(const LAS bf16x8*)(KB + (16 * nt + r) * 136 + 32 * s + 8 * q);
                    acc = MFMA16(a, bb, acc); }
                const int jc = 16 * nt + r; const float gj = SMb[64 + jc];
#pragma unroll
                for (int i = 0; i < 4; ++i) { const int ir = 16 * mt + 4 * q + i; const float gi = SMb[64 + ir]; float v;
                    if (p == 0) v = (ir > jc) ? SMb[ir] * acc[i] * __expf(gi - gj) : 0.f; else v = (ir >= jc) ? acc[i] * __expf(gi - gj) * 0.08838834764831845f : 0.f;
                    if (p == 0) AM[ir * 68 + jc] = v; else AT[ir * 68 + jc] = v; }
            } else {
#pragma unroll
                for (int i = 0; i < 4; ++i) { if (p == 0) AM[(16 * mt + 4 * q + i) * 68 + 16 * nt + r] = 0.f; else AT[(16 * mt + 4 * q + i) * 68 + 16 * nt + r] = 0.f; }
            }
        }
    }
    WG_SYNC(); DP_STAMP(25);
    { const int ch = tid, mt = ch >> 7, s = (ch >> 6) & 1, ln = ch & 63, rp = ln & 15, q = ln >> 4, row = 16 * mt + rp;
        const f32x4 a0 = *(const LAS f32x4*)(AT + row * 68 + 32 * s + 4 * q), a1 = *(const LAS f32x4*)(AT + row * 68 + 32 * s + 16 + 4 * q);
        u32x4 pk; pk.x = cvtpk(a0.x, a0.y); pk.y = cvtpk(a0.z, a0.w); pk.z = cvtpk(a1.x, a1.y); pk.w = cvtpk(a1.z, a1.w);
        *(u32x4*)(stg + DN_AT_OFF + (size_t)ch * 16) = pk; }
#pragma unroll
    for (int k = 0; k < 2; ++k) { const int ch = tid + 512 * k, mt = ch >> 7, s = (ch >> 6) & 1, ln = ch & 63, rp = ln & 15, q = ln >> 4, d = 16 * mt + rp; float v[8];
#pragma unroll
        for (int j = 0; j < 8; ++j) { const int c = 32 * s + 16 * (j >> 2) + 4 * q + (j & 3); v[j] = KS[c * 132 + d] * SMb[192 + c]; }
        u32x4 pk; pk.x = cvtpk(v[0], v[1]); pk.y = cvtpk(v[2], v[3]); pk.z = cvtpk(v[4], v[5]); pk.w = cvtpk(v[6], v[7]);
        *(u32x4*)(stg + DN_KT_OFF + (size_t)ch * 16) = pk; }
    WG_SYNC(); DP_STAMP(26);
#if !defined(NO_WARM)
    if (unit_next < DN_UNITS) { const int n2 = unit_next & 63, bh2 = unit_next >> 6, b2 = bh2 / DNH, h2 = bh2 % DNH, t02 = n2 * 64; const long m02 = (long)b2 * SEQ + t02; const bf16* src = proj + (size_t)m02 * DINP + BA0;
        if (tid < 402) { const int rr = tid / 6 - 3, pp = (tid % 6) >> 1, hf = tid & 1; if (t02 + rr >= 0) src = proj + (size_t)(m02 + rr) * DINP + pp * DNW + h2 * HD + hf * 64; }
        else if (tid < 466) src = proj + (size_t)(m02 + (tid - 402)) * DINP + BA0;
        __builtin_amdgcn_global_load_lds((const unsigned*)src, (LAS unsigned*)(lds + 143360 + wave * 256), 4, 0, 0); }
#endif
    {
        const int r = lane & 15, q = lane >> 4; const bool isv = wave < 4; const LAS float* RS = isv ? VS : KS; const int cbase = (wave & 3) * 32;
        LAS float* NL = (LAS float*)(lds + 138752);
        f32x4 R[2][4];
#pragma unroll
        for (int tl = 0; tl < 2; ++tl)
#pragma unroll
            for (int I = 0; I < 4; ++I)
#pragma unroll
                for (int i = 0; i < 4; ++i) { const int row = 16 * I + 4 * q + i; float v = RS[row * 132 + cbase + 16 * tl + r]; if (!isv) v *= SMb[256 + row]; R[tl][I][i] = v; }
        bf16x8 fa[4];
#pragma unroll
        for (int f = 0; f < 4; ++f) { const int I = (f < 3) ? f + 1 : 3, s = (f == 3) ? 1 : 0, row = 16 * I + r;
            const f32x4 a0 = *(const LAS f32x4*)(AM + row * 68 + 32 * s + 4 * q), a1 = *(const LAS f32x4*)(AM + row * 68 + 32 * s + 16 + 4 * q);
            fa[f] = pack8((f32x4){-a0.x, -a0.y, -a0.z, -a0.w}, (f32x4){-a1.x, -a1.y, -a1.z, -a1.w}); }
        if (wave == 0) {
            const LAS float* L = AM + (16 * q) * 68 + 16 * q; float x[16];
#pragma unroll
            for (int i = 0; i < 16; ++i) { float s = 0.f;
#pragma unroll
                for (int j = 0; j < i; ++j) s += L[i * 68 + j] * x[j];
                x[i] = (i == r) ? 1.0f : ((i > r) ? -s : 0.0f); }
#pragma unroll
            for (int i = 0; i < 16; ++i) NL[(q * 16 + i) * 16 + r] = (i > r) ? x[i] : 0.0f;
        }
        WG_SYNC();
        const f32x4 zero4 = (f32x4){0.f, 0.f, 0.f, 0.f};
        bf16x8 fn[4];
#pragma unroll
        for (int B = 0; B < 4; ++B) fn[B] = pack8(*(const LAS f32x4*)(NL + (B * 16 + r) * 16 + 4 * q), zero4);
#pragma unroll
        for (int tl = 0; tl < 2; ++tl) {
            f32x4 X0 = MFMA16(fn[0], pack8(R[tl][0], zero4), R[tl][0]);
            const f32x4 Y1 = MFMA16(fa[0], pack8(X0, zero4), R[tl][1]);
            const f32x4 X1 = MFMA16(fn[1], pack8(Y1, zero4), Y1);
            const bf16x8 Xb0 = pack8(X0, X1);
            const f32x4 Y2 = MFMA16(fa[1], Xb0, R[tl][2]);
            const f32x4 X2 = MFMA16(fn[2], pack8(Y2, zero4), Y2);
            f32x4 Y3 = MFMA16(fa[2], Xb0, R[tl][3]); Y3 = MFMA16(fa[3], pack8(X2, zero4), Y3);
            const f32x4 X3 = MFMA16(fn[3], pack8(Y3, zero4), Y3);
            const f32x4 X[4] = {X0, X1, X2, X3};
            if (isv) {
                const int wv = 2 * wave + tl;
#pragma unroll
                for (int I = 0; I < 4; ++I) { const int ch = (wv * 4 + I) * 64 + lane; (void)ug;
                    u32x2 ub; ub.x = cvtpk(X[I].x, X[I].y); ub.y = cvtpk(X[I].z, X[I].w); *(u32x2*)(stg + DN_UB_OFF + (size_t)ch * 8) = ub; }
            } else {
                const int d = cbase + 16 * tl + r;
#pragma unroll
                for (int I = 0; I < 4; ++I)
#pragma unroll
                    for (int i = 0; i < 4; ++i) KS[(16 * I + 4 * q + i) * 132 + d] = X[I][i];
            }
        }
    }
    WG_SYNC(); DP_STAMP(27);
#pragma unroll
    for (int k = 0; k < 2; ++k) { const int ch = tid + 512 * k, mt = ch >> 8, s = (ch >> 6) & 3, ln = ch & 63, rp = ln & 15, q = ln >> 4, row = 16 * mt + rp;
        const f32x4 a0 = *(const LAS f32x4*)(KS + row * 132 + 32 * s + 4 * q), a1 = *(const LAS f32x4*)(KS + row * 132 + 32 * s + 16 + 4 * q);
        u32x4 pk; pk.x = cvtpk(-a0.x, -a0.y); pk.y = cvtpk(-a0.z, -a0.w); pk.z = cvtpk(-a1.x, -a1.y); pk.w = cvtpk(-a1.z, -a1.w);
        *(u32x4*)(stg + DN_W_OFF + (size_t)ch * 16) = pk; }
    WG_SYNC(); DP_STAMP(28);
}

__device__ __forceinline__ void dn_seq_bh(LAS unsigned char* lds, int tid, int wave, int lane, int bh, int half, const unsigned char* stg_all, const float* dec_all, unsigned char* sall) {
    #ifndef SEQ_WARM
#define SEQ_WARM 6
#endif
    constexpr int SLOT = 40960, SX_OFF = 3 * SLOT;
    const bool cw = wave < 4; const int wl = wave & 3, wv = 4 * half + wl;
    f32x4 S[8];
#pragma unroll
    for (int i = 0; i < 8; ++i) S[i] = (f32x4){0.f, 0.f, 0.f, 0.f};
    bf16x8 Sb[4];
#pragma unroll
    for (int s = 0; s < 4; ++s) Sb[s] = (bf16x8){0, 0, 0, 0, 0, 0, 0, 0};
    const unsigned char* stg_bh = stg_all + (size_t)bh * 64 * DN_STAGE; const float* dec_bh = dec_all + bh * 64;
    u32x4* sout = (u32x4*)(sall + ((size_t)bh * 64 * 8 + wv) * 4096) + lane;
#if defined(SEQ_HOT)
#define SQ_SRC(n_) ((n_) & 1)
#else
#define SQ_SRC(n_) (n_)
#endif
#define SQ_DMA(n_) do { const unsigned char* g_ = stg_bh + (size_t)SQ_SRC(n_) * DN_STAGE; const int sl_ = (n_) % 3; _Pragma("unroll") for (int k_ = 0; k_ < 10; ++k_) { const int ch_ = wave * 10 + k_; \
        const unsigned char* src_ = (ch_ < 32) ? (g_ + (size_t)ch_ * 1024) : (g_ + DN_UB_OFF + (size_t)half * 8192 + (size_t)(ch_ - 32) * 1024); \
        __builtin_amdgcn_global_load_lds((const unsigned*)(src_ + lane * 16), (LAS unsigned*)(lds + sl_ * SLOT + ch_ * 1024), 16, 0, 0); } } while (0)
    LAS float* DECL = (LAS float*)(lds + SX_OFF + 32768 + 2048);
    if (tid < 64) DECL[tid] = dec_bh[tid];
    if (cw) { SQ_DMA(0); SQ_DMA(1); }
    else {
#pragma unroll
        for (int s = 0; s < 4; ++s) *(LAS u32x4*)(lds + SX_OFF + ((wl * 4 + s) * 64 + lane) * 16) = (u32x4){0u, 0u, 0u, 0u};
    }
#pragma unroll 1
    for (int n = 0; n < 64; ++n) {
        if (cw) { if (n + 1 < 64) asm volatile("s_waitcnt vmcnt(10)" ::: "memory"); else asm volatile("s_waitcnt vmcnt(0)" ::: "memory"); }
        RAW_BAR();
        if (!cw) {
#pragma unroll
            for (int s = 0; s < 4; ++s) sout[(size_t)n * 2048 + s * 64] = *(const LAS u32x4*)(lds + SX_OFF + (n & 1) * 16384 + ((wl * 4 + s) * 64 + lane) * 16);
#if !defined(SEQ_NO_WARM)
            if (n + SEQ_WARM < 64) { const unsigned char* g_ = stg_bh + (size_t)(n + SEQ_WARM) * DN_STAGE; const int hl = wl * 64 + lane;
                __builtin_amdgcn_global_load_lds((const unsigned*)(g_ + (size_t)hl * 128), (LAS unsigned*)(lds + SX_OFF + 32768 + wl * 256), 4, 0, 0);
                if (wl == 0) __builtin_amdgcn_global_load_lds((const unsigned*)(g_ + DN_UB_OFF + (size_t)half * 8192 + (size_t)lane * 128), (LAS unsigned*)(lds + SX_OFF + 32768 + 1024), 4, 0, 0); }
#endif
        } else {
            if (n + 2 < 64) SQ_DMA(n + 2);
            const float dec = DECL[n];
            const LAS unsigned char* st = lds + (n % 3) * SLOT;
            f32x4 vn[4];
#pragma unroll
            for (int ct = 0; ct < 4; ++ct) { const u32x2 ub = *(const LAS u32x2*)(st + DN_UB_OFF + ((wl * 4 + ct) * 64 + lane) * 8); vn[ct] = (f32x4){bflo(ub.x), bfhi(ub.x), bflo(ub.y), bfhi(ub.y)}; }
            bf16x8 F0[4], F1[4];
#define SQ_LD4(F, off_, f0_) do { _Pragma("unroll") for (int i_ = 0; i_ < 4; ++i_) F[i_] = *(const LAS bf16x8*)(st + (off_) + (((f0_) + i_) * 64 + lane) * 16); } while (0)
            SQ_LD4(F0, DN_W_OFF, 0); SQ_LD4(F1, DN_W_OFF, 4);
#pragma unroll
            for (int s = 0; s < 4; ++s) vn[0] = MFMA16(F0[s], Sb[s], vn[0]);
            SQ_LD4(F0, DN_W_OFF, 8);
#pragma unroll
            for (int s = 0; s < 4; ++s) vn[1] = MFMA16(F1[s], Sb[s], vn[1]);
            SQ_LD4(F1, DN_W_OFF, 12);
#pragma unroll
            for (int s = 0; s < 4; ++s) vn[2] = MFMA16(F0[s], Sb[s], vn[2]);
            SQ_LD4(F0, DN_KT_OFF, 0);
#pragma unroll
            for (int s = 0; s < 4; ++s) vn[3] = MFMA16(F1[s], Sb[s], vn[3]);
            SQ_LD4(F1, DN_KT_OFF, 4);
            bf16x8 Vb[2];
#pragma unroll
            for (int s = 0; s < 2; ++s) Vb[s] = pack8(vn[2 * s], vn[2 * s + 1]);
#pragma unroll
            for (int dt = 0; dt < 8; ++dt) S[dt] = S[dt] * dec;
            S[0] = MFMA16(F0[0], Vb[0], S[0]); S[1] = MFMA16(F0[2], Vb[0], S[1]); S[0] = MFMA16(F0[1], Vb[1], S[0]); S[1] = MFMA16(F0[3], Vb[1], S[1]);
            SQ_LD4(F0, DN_KT_OFF, 8);
            S[2] = MFMA16(F1[0], Vb[0], S[2]); S[3] = MFMA16(F1[2], Vb[0], S[3]); S[2] = MFMA16(F1[1], Vb[1], S[2]); S[3] = MFMA16(F1[3], Vb[1], S[3]);
            SQ_LD4(F1, DN_KT_OFF, 12);
            S[4] = MFMA16(F0[0], Vb[0], S[4]); S[5] = MFMA16(F0[2], Vb[0], S[5]); S[4] = MFMA16(F0[1], Vb[1], S[4]); S[5] = MFMA16(F0[3], Vb[1], S[5]);
            S[6] = MFMA16(F1[0], Vb[0], S[6]); S[7] = MFMA16(F1[2], Vb[0], S[7]); S[6] = MFMA16(F1[1], Vb[1], S[6]); S[7] = MFMA16(F1[3], Vb[1], S[7]);
#pragma unroll
            for (int s = 0; s < 4; ++s) { Sb[s] = pack8(S[2 * s], S[2 * s + 1]); *(LAS u32x4*)(lds + SX_OFF + ((n + 1) & 1) * 16384 + ((wl * 4 + s) * 64 + lane) * 16) = __builtin_bit_cast(u32x4, Sb[s]); }
        }
    }
#undef SQ_DMA
#undef SQ_LD4
    asm volatile("s_waitcnt vmcnt(0) lgkmcnt(0)" ::: "memory"); __builtin_amdgcn_s_barrier(); asm volatile("" ::: "memory");
}

__device__ __forceinline__ void dn_out_unit(LAS unsigned char* lds, int tid, int wave, int lane, int unit, const unsigned char* stg_all, const float* ug_all, const unsigned char* sall,
                                            const bf16* proj, const float* normw, bf16* mix) {
    const int n = unit & 63, bh = unit >> 6, b = bh / DNH, h = bh % DNH, r = lane & 15, q = lane >> 4;
    LAS unsigned char* st = lds;
    LAS float* OB = (LAS float*)(lds + 40960);
    const unsigned char* stg = stg_all + (size_t)unit * DN_STAGE;
#pragma unroll
    for (int k = 0; k < 5; ++k) { const int ch = wave * 5 + k; const unsigned char* g = (ch < 16) ? (stg + DN_W_OFF + (size_t)ch * 1024) : (stg + DN_Q_OFF + (size_t)(ch - 16) * 1024);
        __builtin_amdgcn_global_load_lds((const unsigned*)(g + lane * 16), (LAS unsigned*)(st + ch * 1024), 16, 0, 0); }
    f32x4 vn[4]; u32x4 sbw[4];
#pragma unroll
    for (int ct = 0; ct < 4; ++ct) { const u32x2 ub = *(const u32x2*)(stg + DN_UB_OFF + (size_t)((wave * 4 + ct) * 64 + lane) * 8); vn[ct] = (f32x4){bflo(ub.x), bfhi(ub.x), bflo(ub.y), bfhi(ub.y)}; }
#pragma unroll
    for (int s = 0; s < 4; ++s) sbw[s] = *((const u32x4*)(sall + ((size_t)unit * 8 + wave) * 4096) + s * 64 + lane);
    const int prow = tid >> 3, pcg = tid & 7;
    const bf16* zp = proj + ((size_t)b * SEQ + n * 64 + prow) * DINP + Z0 + h * HD + 16 * pcg;
    const u32x4 z0 = *(const u32x4*)zp, z1 = *(const u32x4*)(zp + 8);
    f32x4 nwv[4];
#pragma unroll
    for (int k = 0; k < 4; ++k) nwv[k] = *(const f32x4*)(normw + 16 * pcg + 4 * k);
    asm volatile("s_waitcnt vmcnt(0)" ::: "memory"); RAW_BAR();
    bf16x8 Sb[4];
#pragma unroll
    for (int s = 0; s < 4; ++s) Sb[s] = __builtin_bit_cast(bf16x8, sbw[s]);
    f32x4 o[4];
#pragma unroll
    for (int ct = 0; ct < 4; ++ct) o[ct] = (f32x4){0.f, 0.f, 0.f, 0.f};
#pragma unroll
    for (int ct = 0; ct < 4; ++ct) { bf16x8 fw[4], fq[4];
#pragma unroll
        for (int s = 0; s < 4; ++s) { fw[s] = *(const LAS bf16x8*)(st + ((ct * 4 + s) * 64 + lane) * 16); fq[s] = *(const LAS bf16x8*)(st + 16384 + ((ct * 4 + s) * 64 + lane) * 16); }
#pragma unroll
        for (int s = 0; s < 4; ++s) { vn[ct] = MFMA16(fw[s], Sb[s], vn[ct]); o[ct] = MFMA16(fq[s], Sb[s], o[ct]); } }
    bf16x8 Vb[2];
#pragma unroll
    for (int s = 0; s < 2; ++s) Vb[s] = pack8(vn[2 * s], vn[2 * s + 1]);
    { bf16x8 fa[8];
#pragma unroll
        for (int i = 0; i < 8; ++i) fa[i] = *(const LAS bf16x8*)(st + 32768 + (i * 64 + lane) * 16);
#pragma unroll
        for (int ct = 0; ct < 4; ++ct) { o[ct] = MFMA16(fa[ct * 2], Vb[0], o[ct]); o[ct] = MFMA16(fa[ct * 2 + 1], Vb[1], o[ct]); } }
#pragma unroll
    for (int ct = 0; ct < 4; ++ct)
#pragma unroll
        for (int i = 0; i < 4; ++i) OB[(16 * ct + 4 * q + i) * 132 + 16 * wave + r] = o[ct][i];
    RAW_BAR();
    {
        f32x4 v[4]; float ss = 0.f;
#pragma unroll
        for (int k = 0; k < 4; ++k) { v[k] = *(const LAS f32x4*)(OB + prow * 132 + 16 * pcg + 4 * k); ss += (v[k].x * v[k].x + v[k].y * v[k].y) + (v[k].z * v[k].z + v[k].w * v[k].w); }
        ss += __shfl_xor(ss, 1); ss += __shfl_xor(ss, 2); ss += __shfl_xor(ss, 4);
        const float rstd = __builtin_amdgcn_rsqf(ss * (1.0f / HD) + EPS);
        float z[16]; { float t8[8]; unpack8(z0, t8);
#pragma unroll
            for (int i = 0; i < 8; ++i) z[i] = t8[i]; unpack8(z1, t8);
#pragma unroll
            for (int i = 0; i < 8; ++i) z[8 + i] = t8[i]; }
        float o16[16];
#pragma unroll
        for (int k = 0; k < 4; ++k) { o16[4 * k] = v[k].x * rstd * nwv[k].x * siluf_(z[4 * k]); o16[4 * k + 1] = v[k].y * rstd * nwv[k].y * siluf_(z[4 * k + 1]);
            o16[4 * k + 2] = v[k].z * rstd * nwv[k].z * siluf_(z[4 * k + 2]); o16[4 * k + 3] = v[k].w * rstd * nwv[k].w * siluf_(z[4 * k + 3]); }
        u32x4 p0, p1; p0.x = cvtpk(o16[0], o16[1]); p0.y = cvtpk(o16[2], o16[3]); p0.z = cvtpk(o16[4], o16[5]); p0.w = cvtpk(o16[6], o16[7]);
        p1.x = cvtpk(o16[8], o16[9]); p1.y = cvtpk(o16[10], o16[11]); p1.z = cvtpk(o16[12], o16[13]); p1.w = cvtpk(o16[14], o16[15]);
        bf16* mp = mix + ((size_t)b * SEQ + n * 64 + prow) * DM + h * HD + 16 * pcg;
        *(u32x4*)mp = p0; *(u32x4*)(mp + 8) = p1;
    }
    RAW_BAR();
}

#if defined(DIAG)
#define LR_STAMP(k) do { if (tid == 0 && unit >= (int)gridDim.x && unit < 2 * (int)gridDim.x) *(volatile LAS unsigned long long*)(lds + MISC_OFF - 256 + 8 * (k)) = __builtin_amdgcn_s_memrealtime(); } while (0)
#else
#define LR_STAMP(k) do { } while (0)
#endif
__device__ __forceinline__ void lru1_unit(LAS unsigned char* lds, int tid, int wave, int lane, int unit, const bf16* proj, const float* convw, const float* convb, const bf16* wat, const bf16* wxt,
                                          const float* ba, const float* bx, const float* lam, float* HL, float* PC, float* CAR) {
    const int rb = unit & 31, bg = unit >> 5, b = bg / LRB, g = bg % LRB, t0 = rb * 128, cb = g * HD; const size_t m0 = (size_t)b * SEQ + t0;
    LR_STAMP(22);
    LAS float* XC = (LAS float*)lds; LAS float* AA = (LAS float*)(lds + 67584); LAS float* SE = (LAS float*)(lds + 135168);
    u32x4 wstage[4];
    {
#pragma unroll
        for (int k = 0; k < 4; ++k) { const int ch = tid + 512 * k, j = (ch >> 4) & 127, c = ch & 15;
            wstage[k] = *(const u32x4*)(wat + ((size_t)(g * HD + j)) * HD + 8 * c); }
    }
    {
        const int rq = tid >> 4, cg = tid & 15, c0 = cb + 8 * cg; float w[4][8], bias[8];
#pragma unroll
        for (int j = 0; j < 4; ++j) { const f32x4 a = *(const f32x4*)(convw + j * LRW + c0), bq = *(const f32x4*)(convw + j * LRW + c0 + 4);
            w[j][0] = a.x; w[j][1] = a.y; w[j][2] = a.z; w[j][3] = a.w; w[j][4] = bq.x; w[j][5] = bq.y; w[j][6] = bq.z; w[j][7] = bq.w; }
        { const f32x4 a = *(const f32x4*)(convb + c0), bq = *(const f32x4*)(convb + c0 + 4); bias[0] = a.x; bias[1] = a.y; bias[2] = a.z; bias[3] = a.w; bias[4] = bq.x; bias[5] = bq.y; bias[6] = bq.z; bias[7] = bq.w; }
        float x[7][8];
#pragma unroll
        for (int k = 0; k < 7; ++k) { const int rr = 4 * rq - 3 + k;
            if (t0 + rr >= 0) { const u32x4 v = *(const u32x4*)(proj + (size_t)((long)m0 + rr) * DINP + LX0 + c0); unpack8(v, x[k]); }
            else {
#pragma unroll
                for (int i = 0; i < 8; ++i) x[k][i] = 0.f; } }
#pragma unroll
        for (int rr = 0; rr < 4; ++rr) { float y[8];
#pragma unroll
            for (int i = 0; i < 8; ++i) { float a = bias[i];
#pragma unroll
                for (int j = 0; j < 4; ++j) a += w[j][i] * x[rr + j][i];
                y[i] = a; }
            *(LAS f32x4*)(XC + (4 * rq + rr) * 132 + 8 * cg) = (f32x4){y[0], y[1], y[2], y[3]}; *(LAS f32x4*)(XC + (4 * rq + rr) * 132 + 8 * cg + 4) = (f32x4){y[4], y[5], y[6], y[7]}; }
    }
    { LAS unsigned char* WL = (LAS unsigned char*)AA;
#pragma unroll
        for (int k = 0; k < 4; ++k) { const int ch = tid + 512 * k, j = (ch >> 4) & 127, c = ch & 15; *(LAS u32x4*)(WL + j * 256 + ((c ^ (j & 15)) << 4)) = wstage[k]; }
#pragma unroll
        for (int k = 0; k < 4; ++k) { const int ch = tid + 512 * k, j = (ch >> 4) & 127, c = ch & 15;
            *(LAS u32x4*)(WL + 32768 + j * 256 + ((c ^ (j & 15)) << 4)) = *(const u32x4*)(wxt + ((size_t)(g * HD + j)) * HD + 8 * c); } }
    WG_SYNC(); LR_STAMP(23);
    {
        const int mt = wave & 3, nh = wave >> 2, r = lane & 31, hh = lane >> 5; const LAS unsigned char* WL = (const LAS unsigned char*)AA;
        float spv[2], bAv[2], bXv[2];
#pragma unroll
        for (int nt = 0; nt < 2; ++nt) { const int c = cb + 64 * nh + 32 * nt + r; spv[nt] = lam[c]; bAv[nt] = ba[c]; bXv[nt] = bx[c]; }
        f32x16 accA[2], accX[2];
#pragma unroll
        for (int nt = 0; nt < 2; ++nt)
#pragma unroll
            for (int i = 0; i < 16; ++i) { accA[nt][i] = 0.f; accX[nt][i] = 0.f; }
#pragma unroll
        for (int s = 0; s < 8; ++s) {
            const f32x4 a0 = *(const LAS f32x4*)(XC + (32 * mt + r) * 132 + 16 * s + 8 * hh), a1 = *(const LAS f32x4*)(XC + (32 * mt + r) * 132 + 16 * s + 8 * hh + 4);
            const bf16x8 a = pack8(a0, a1);
#pragma unroll
            for (int nt = 0; nt < 2; ++nt) { const int j = 64 * nh + 32 * nt + r; const int wo = j * 256 + (((2 * s + hh) ^ (j & 15)) << 4);
                const bf16x8 b1 = *(const LAS bf16x8*)(WL + wo), b2 = *(const LAS bf16x8*)(WL + 32768 + wo);
                accA[nt] = MFMA32(a, b1, accA[nt]); accX[nt] = MFMA32(a, b2, accX[nt]); }
        }
        WG_SYNC();
#pragma unroll
        for (int nt = 0; nt < 2; ++nt) { const int j = 64 * nh + 32 * nt + r; const float sp = softplusf_(-spv[nt]), bA = bAv[nt], bX = bXv[nt];
#pragma unroll
            for (int i = 0; i < 16; ++i) { const int t = 32 * mt + crow32(i, hh); const float xc = XC[t * 132 + j];
                const float rr = sigmoidf_(accA[nt][i] + bA), ig = sigmoidf_(accX[nt][i] + bX), la = -8.0f * rr * sp;
                const float av = __expf(la); AA[t * 132 + j] = av; XC[t * 132 + j] = sqrtf(1.0f - av * av) * (ig * xc); } }
    }
    WG_SYNC(); LR_STAMP(24);
    {
        const int j = tid & 127, sg = tid >> 7; float P = 1.f, H = 0.f;
#pragma unroll 4
        for (int tt = 0; tt < 32; ++tt) { const int o = (32 * sg + tt) * 132 + j; const float a = AA[o]; H = a * H + XC[o]; P *= a; XC[o] = H; AA[o] = P; }
        SE[(sg * 128 + j) * 2] = P; SE[(sg * 128 + j) * 2 + 1] = H;
        WG_SYNC(); LR_STAMP(25);
        float Pin = 1.f, Hin = 0.f;
        for (int s2 = 0; s2 < sg; ++s2) { const float Pe = SE[(s2 * 128 + j) * 2], He = SE[(s2 * 128 + j) * 2 + 1]; Hin = Pe * Hin + He; Pin *= Pe; }
#pragma unroll 4
        for (int tt = 0; tt < 32; ++tt) { const int t = 32 * sg + tt, o = t * 132 + j; const size_t go = (m0 + t) * LRW + cb + j; HL[go] = XC[o] + AA[o] * Hin; PC[go] = AA[o] * Pin; }
        if (sg == 3) { const float Pe = SE[(3 * 128 + j) * 2], He = SE[(3 * 128 + j) * 2 + 1]; CAR[((size_t)unit * 128 + j) * 2] = Pin * Pe; CAR[((size_t)unit * 128 + j) * 2 + 1] = Pe * Hin + He; }
    }
    WG_SYNC(); LR_STAMP(26);
}
__device__ __forceinline__ void lru3_unit(LAS unsigned char* lds, int tid, int unit, const bf16* proj, const float* HL, const float* PC, const float* CAR, const float* normw, bf16* mix) {
    const int rb = unit & 31, bg = unit >> 5, b = bg / LRB, g = bg % LRB, t0 = rb * 128, cb = g * HD; const size_t m0 = (size_t)b * SEQ + t0;
    LAS float* HIN = (LAS float*)lds;
    if (tid < 128) { typedef float f32x2_t __attribute__((ext_vector_type(2))); f32x2_t ph[32];
#pragma unroll
        for (int u2 = 0; u2 < 32; ++u2) ph[u2] = (u2 < rb) ? *(const f32x2_t*)(CAR + ((size_t)(bg * 32 + u2) * 128 + tid) * 2) : (f32x2_t){1.f, 0.f};
        float H = 0.f;
#pragma unroll
        for (int u2 = 0; u2 < 32; ++u2) H = (u2 < rb) ? ph[u2].x * H + ph[u2].y : H;
        HIN[tid] = H; }
    WG_SYNC();
    const int row = tid >> 2, part = tid & 3, c0 = cb + 32 * part; const size_t m = m0 + row;
    float y[32]; float ss = 0.f;
#pragma unroll
    for (int k = 0; k < 4; ++k) { const u32x4 gv = *(const u32x4*)(proj + m * DINP + LG0 + c0 + 8 * k); float g8[8]; unpack8(gv, g8);
#pragma unroll
        for (int hf = 0; hf < 2; ++hf) { const f32x4 hl = *(const f32x4*)(HL + m * LRW + c0 + 8 * k + 4 * hf), pc = *(const f32x4*)(PC + m * LRW + c0 + 8 * k + 4 * hf);
#pragma unroll
            for (int i = 0; i < 4; ++i) { const int ci = 8 * k + 4 * hf + i; const float hv = hl[i] + pc[i] * HIN[32 * part + ci]; const float yv = hv * geluf_(g8[4 * hf + i]); y[ci] = yv; ss += yv * yv; } } }
    ss += __shfl_xor(ss, 1); ss += __shfl_xor(ss, 2);
    const float rstd = 1.0f / sqrtf(ss * (1.0f / HD) + EPS);
#pragma unroll
    for (int k = 0; k < 4; ++k) { const f32x4 w0 = *(const f32x4*)(normw + c0 + 8 * k), w1 = *(const f32x4*)(normw + c0 + 8 * k + 4);
        u32x4 pk; pk.x = cvtpk(y[8 * k] * rstd * w0.x, y[8 * k + 1] * rstd * w0.y); pk.y = cvtpk(y[8 * k + 2] * rstd * w0.z, y[8 * k + 3] * rstd * w0.w);
        pk.z = cvtpk(y[8 * k + 4] * rstd * w1.x, y[8 * k + 5] * rstd * w1.y); pk.w = cvtpk(y[8 * k + 6] * rstd * w1.z, y[8 * k + 7] * rstd * w1.w);
        *(u32x4*)(mix + m * DM + DNW + c0 + 8 * k) = pk; }
    WG_SYNC();
}

__device__ __forceinline__ void sg_unit(LAS unsigned char* lds, int tid, int wave, int lane, int unit, const bf16* proj, const float* sgst, const float* lnw, const float* lnb, const bf16* wsb, const float* bs, const float* normw, bf16* mix) {
    const int g = unit & 7, bn = unit >> 3; const size_t m0 = (size_t)bn * 128;
    LAS bf16* VT = (LAS bf16*)lds; LAS float* YB = (LAS float*)(lds + 34816);
    {
        const int s_ = tid >> 2, part = tid & 3; const float mu = sgst[2 * (m0 + s_)], rs = sgst[2 * (m0 + s_) + 1];
#pragma unroll
        for (int k = 0; k < 4; ++k) { const u32x4 v = *(const u32x4*)(proj + (m0 + s_) * DINP + SV0 + g * HD + 32 * part + 8 * k); float f[8]; unpack8(v, f);
            const f32x4 w0 = *(const f32x4*)(lnw + g * HD + 32 * part + 8 * k), w1 = *(const f32x4*)(lnw + g * HD + 32 * part + 8 * k + 4), b0 = *(const f32x4*)(lnb + g * HD + 32 * part + 8 * k), b1 = *(const f32x4*)(lnb + g * HD + 32 * part + 8 * k + 4);
            const float ww[8] = {w0.x, w0.y, w0.z, w0.w, w1.x, w1.y, w1.z, w1.w}, bb[8] = {b0.x, b0.y, b0.z, b0.w, b1.x, b1.y, b1.z, b1.w};
#pragma unroll
            for (int i = 0; i < 8; ++i) VT[(32 * part + 8 * k + i) * 136 + s_] = (bf16)f2bf((geluf_(f[i]) - mu) * rs * ww[i] + bb[i]); }
#pragma unroll
        for (int k = 0; k < 4; ++k) { const u32x4 v = *(const u32x4*)(proj + (m0 + s_) * DINP + SU0 + g * HD + 32 * part + 8 * k); float f[8]; unpack8(v, f);
            *(LAS f32x4*)(YB + s_ * 132 + 32 * part + 8 * k) = (f32x4){geluf_(f[0]), geluf_(f[1]), geluf_(f[2]), geluf_(f[3])};
            *(LAS f32x4*)(YB + s_ * 132 + 32 * part + 8 * k + 4) = (f32x4){geluf_(f[4]), geluf_(f[5]), geluf_(f[6]), geluf_(f[7])}; }
    }
    bf16x8 afr[8];
    { const int mt = wave & 3, r = lane & 31, hh = lane >> 5;
#pragma unroll
        for (int s = 0; s < 8; ++s) afr[s] = *(const bf16x8*)(wsb + ((size_t)(g * 128 + 32 * mt + r)) * 128 + 16 * s + 8 * hh); }
    WG_SYNC();
    {
        const int mt = wave & 3, nh = wave >> 2, r = lane & 31, hh = lane >> 5;
        f32x16 acc[2]; float bsv[16];
#pragma unroll
        for (int i = 0; i < 16; ++i) bsv[i] = bs[g * 128 + 32 * mt + crow32(i, hh)];
#pragma unroll
        for (int nt = 0; nt < 2; ++nt)
#pragma unroll
            for (int i = 0; i < 16; ++i) acc[nt][i] = 0.f;
#pragma unroll
        for (int s = 0; s < 8; ++s) { if (s < 2 * mt + 2) {
#pragma unroll
            for (int nt = 0; nt < 2; ++nt) { const bf16x8 bb = *(const LAS bf16x8*)(VT + (64 * nh + 32 * nt + r) * 136 + 16 * s + 8 * hh); acc[nt] = MFMA32(afr[s], bb, acc[nt]); } } }
#pragma unroll
        for (int nt = 0; nt < 2; ++nt) { const int c = 64 * nh + 32 * nt + r;
#pragma unroll
            for (int i = 0; i < 16; ++i) { const int t = 32 * mt + crow32(i, hh); const float z = acc[nt][i] + bsv[i];
                YB[t * 132 + c] *= z; } }
    }
    WG_SYNC();
    {
        const int t = tid >> 2, part = tid & 3; f32x4 v[8]; float ss = 0.f;
#pragma unroll
        for (int k = 0; k < 8; ++k) { v[k] = *(const LAS f32x4*)(YB + t * 132 + 32 * part + 4 * k); ss += (v[k].x * v[k].x + v[k].y * v[k].y) + (v[k].z * v[k].z + v[k].w * v[k].w); }
        ss += __shfl_xor(ss, 1); ss += __shfl_xor(ss, 2);
        const float rstd = 1.0f / sqrtf(ss * (1.0f / HD) + EPS);
#pragma unroll
        for (int k = 0; k < 4; ++k) { const f32x4 w0 = *(const f32x4*)(normw + g * HD + 32 * part + 8 * k), w1 = *(const f32x4*)(normw + g * HD + 32 * part + 8 * k + 4);
            u32x4 pk; pk.x = cvtpk(v[2 * k].x * rstd * w0.x, v[2 * k].y * rstd * w0.y); pk.y = cvtpk(v[2 * k].z * rstd * w0.z, v[2 * k].w * rstd * w0.w);
            pk.z = cvtpk(v[2 * k + 1].x * rstd * w1.x, v[2 * k + 1].y * rstd * w1.y); pk.w = cvtpk(v[2 * k + 1].z * rstd * w1.z, v[2 * k + 1].w * rstd * w1.w);
            *(u32x4*)(mix + (m0 + t) * DM + DNW + LRW + g * HD + 32 * part + 8 * k) = pk; }
    }
    WG_SYNC();
}
#ifndef USE_DN
#define USE_DN 1
#endif
#ifndef USE_LRU
#define USE_LRU 1
#endif
#ifndef USE_SG
#define USE_SG 1
#endif
#define LAUNDER() int tid = tid0, bx = bx0, G = G0; GASP unsigned char* wsg_ = (GASP unsigned char*)ws0; KIN kin_ = (KIN)__builtin_amdgcn_kernarg_segment_ptr(); asm volatile("" : "+v"(tid), "+s"(bx), "+s"(G), "+s"(wsg_), "+s"(kin_)); const InTab in_{kin_}; unsigned char* ws = (unsigned char*)wsg_;     const int lane = tid & 63, wave = __builtin_amdgcn_readfirstlane(tid >> 6), gw = bx * NWAVES + wave, ngw = G * NWAVES, gtid = bx * NTHR + tid, ngt = G * NTHR; (void)lane; (void)wave; (void)gw; (void)ngw; (void)gtid; (void)ngt
#ifndef DUP_MASK
#define DUP_MASK 0
#endif
#ifndef DUP_SUB
#define DUP_SUB 0
#endif
#define SREP(b) (((DUP_SUB) & (b)) && l == 0 ? 2 : 1)
#define NREP(j) ((((DUP_MASK) >> (j)) & 1) && l == 0 ? 2 : 1)
#ifndef GEMM_ALIGN
#define GEMM_ALIGN true
#endif
#ifndef GEMM_SP2
#define GEMM_SP2 true
#endif
constexpr int N_PHASES = 1 + 9 * DEPTH;
#define GASP __attribute__((address_space(1)))
typedef const float GASP* const __attribute__((address_space(4)))* KIN;
struct InTab { KIN t; __device__ __forceinline__ const float* operator[](int k) const { return (const float*)t[k]; } };
struct Args { const float* in[27]; float* out; unsigned char* ws; int ph_lo, ph_hi, li, pad; };
__global__ void __launch_bounds__(NTHR, 2) mega(Args a) {
    extern __shared__ __attribute__((aligned(16))) unsigned char lds_raw[];
    LAS unsigned char* lds = (LAS unsigned char*)lds_raw;
    const int tid0 = threadIdx.x, G0 = gridDim.x, bx0 = blockIdx.x;
    volatile LAS unsigned* MISC = (volatile LAS unsigned*)(lds + MISC_OFF);
    if (tid0 < 64) MISC[tid0] = 0u;
    __syncthreads();
    unsigned char* const ws0 = a.ws;
    XcdBarrier bar = xcd_barrier_post((unsigned*)(ws0 + WS_CTL) + CW_BAR + a.li * XCD_BAR_WORDS, MISC + 8);
    const int lo = a.ph_lo, hi = a.ph_hi;
#define IN(k) (lo <= (k) && (k) < hi)
#ifndef DIAG_LAYER
#define DIAG_LAYER 0
#endif
#if defined(DIAG)
#ifndef DIAG_OFF
#define DIAG_OFF 0.0f
#endif

#define STAMP(k) do { if (tid0 == 0) *(volatile LAS unsigned long long*)(lds + MISC_OFF - 256 + 8 * (k)) = __builtin_amdgcn_s_memrealtime(); } while (0)
#else
#define STAMP(k) do { } while (0)
#endif
#define SEAM(k) do { if (IN(k) && IN((k) + 1)) xcd_barrier(bar); } while (0)
#define hb ((bf16*)(ws + WS_HB))
#define proj ((bf16*)(ws + WS_PROJ))
#define mix ((bf16*)(ws + WS_MIX))
#define xa ((float*)(ws + WS_XA))
#define xb ((float*)(ws + WS_XB))
#define hid ((bf16*)(ws + WS_HID))
#define act ((bf16*)(ws + WS_ACT))
#define stg (ws + WS_STG)
#define ug ((float*)(ws + WS_UG))
#define decg ((float*)(ws + WS_DEC))
#define HL ((float*)(ws + WS_HL))
#define PC ((float*)(ws + WS_PC))
#define CAR ((float*)(ws + WS_CAR))

    STAMP(0);
    if (IN(0)) for (int rep = 0; rep < (((DUP_MASK) & 1) ? 2 : 1); ++rep) { LAUNDER(); phase_prologue(lds, in_, ws, gw, ngw, gtid, ngt, wave, lane); }
    STAMP(1); SEAM(0); STAMP(2);
    for (int l = 0; l < DEPTH; ++l) {
        const int pb = 1 + 9 * l;
        const bf16* win = (const bf16*)(ws0 + WS_W + l * SZ_WL); const bf16* wout = (const bf16*)((const unsigned char*)win + SZ_WIN);
        const bf16* wup = (const bf16*)((const unsigned char*)wout + SZ_WOUT); const bf16* wdn = (const bf16*)((const unsigned char*)wup + SZ_WUP);
        if (IN(pb + 0)) for (int rep = 0; rep < NREP(1); ++rep) { LAUNDER(); pg8::Gemm g{hb, win, M, DINP, DM}; pg8::StaticOrder S; S.init(M, DINP, G, bx); EpiBf16Rs E{proj, DINP, (const ssq_t*)(ws + WS_SS) + (size_t)(2 * l) * M};
            pg8::gemm_phase<EpiBf16Rs, pg8::StaticOrder, GEMM_ALIGN, GEMM_SP2>(lds, g, S, E);
            { const int idle_from = ((M / 256) * (DINP / 256)) % G; if (TF_UP > 0 && idle_from > 0 && bx >= idle_from) convert_deferred(lds, in_, ws, l, 0, bx, G, idle_from, wave, lane); } }
        if (l == DIAG_LAYER) STAMP(3); SEAM(pb + 0); if (l == DIAG_LAYER) STAMP(4);
        if (IN(pb + 1)) for (int rep = 0; rep < NREP(2); ++rep) { LAUNDER();
#if USE_DN
            static_assert(DN_UNITS <= 8 * 192, "dn_gates_all covers 8 units per workgroup");
            dn_gates_all(lds, wave, lane, bx, G, proj, in_[4] + l * DNH, in_[5] + l * DNH, decg);
            for (int u = bx, k = 0; u < DN_UNITS; u += G, ++k) dn_prep_unit(lds, tid, wave, lane, u, u + G, k, proj, in_[3] + (size_t)l * 4 * 3 * DNW, in_[4] + l * DNH, in_[5] + l * DNH, stg, ug, decg);
#endif
            if (l == DIAG_LAYER) STAMP(5);
#if USE_SG
            phase_sg_stats(proj, (float*)(ws + WS_SGST), gw, ngw, lane);
#endif
            if (l == DIAG_LAYER) STAMP(6);
#if USE_LRU
            for (int r2 = 0; r2 < SREP(2); ++r2) for (int u = bx; u < BATCH * LRB * 32; u += G) lru1_unit(lds, tid, wave, lane, u, proj, in_[7] + (size_t)l * 4 * LRW, in_[8] + l * LRW, (const bf16*)(ws + WS_WAT) + (size_t)l * LRB * HD * HD,
                                                                   (const bf16*)(ws + WS_WXT) + (size_t)l * LRB * HD * HD, in_[10] + l * LRW, in_[12] + l * LRW, in_[13] + l * LRW, HL, PC, CAR);
#endif
        }
        if (l == DIAG_LAYER) STAMP(7); SEAM(pb + 1); if (l == DIAG_LAYER) STAMP(8);
        if (IN(pb + 2)) for (int rep = 0; rep < NREP(3); ++rep) { LAUNDER();
            constexpr int NSEQ = 2 * BATCH * DNH;
            if (bx < NSEQ && G > NSEQ) {
#if USE_DN
                dn_seq_bh(lds, tid, wave, lane, bx % (BATCH * DNH), bx / (BATCH * DNH), stg, decg, ws + WS_SALL);
#endif
            } else {
                const int wb = bx - NSEQ, nwb = G - NSEQ; constexpr int NSG = BATCH * 32 * SGG, NL3 = BATCH * LRB * 32;
                for (int i = wb; i < NSG + NL3; i += nwb) {
                    if (i < NSG) sg_unit(lds, tid, wave, lane, i, proj, (const float*)(ws + WS_SGST), in_[15] + l * SGW, in_[16] + l * SGW, (const bf16*)(ws + WS_WSB) + (size_t)l * SGG * 128 * 128, in_[18] + l * SGG * 128, in_[19] + l * SGW, mix);
                    else lru3_unit(lds, tid, i - NSG, proj, HL, PC, CAR, in_[14] + l * LRW, mix);
                }
                __syncthreads(); if (TF_IN1 > 0 && TF_DN2 > 0) convert_deferred(lds, in_, ws, 1, l == 0 ? 2 : 3, bx, G, NSEQ, wave, lane);
                if (l == DIAG_LAYER) STAMP(9);
            }
        }
        if (l == DIAG_LAYER) STAMP(10); SEAM(pb + 2); if (l == DIAG_LAYER) STAMP(11);
        if (IN(pb + 3)) { LAUNDER();
#if USE_DN
            for (int u = bx; u < DN_UNITS; u += G) dn_out_unit(lds, tid, wave, lane, u, stg, ug, ws + WS_SALL, proj, in_[6] + l * HD, mix);
#endif
        }
        if (l == DIAG_LAYER) STAMP(20); SEAM(pb + 3); if (l == DIAG_LAYER) STAMP(21);
        if (IN(pb + 4)) for (int rep = 0; rep < NREP(4); ++rep) { LAUNDER(); pg8::Gemm g{mix, wout, M, DM, DM}; pg8::StaticOrder S; S.init(M, DM, G, bx); EpiResB16 E{hb, (ssq_t*)(ws + WS_SS) + (size_t)(2 * l + 1) * M, DM};
            pg8::gemm_phase<EpiResB16, pg8::StaticOrder, GEMM_ALIGN, GEMM_SP2>(lds, g, S, E); }
        if (l == DIAG_LAYER) STAMP(12); SEAM(pb + 4); if (l == DIAG_LAYER) STAMP(13);
        if (IN(pb + 5)) for (int rep = 0; rep < NREP(6); ++rep) { LAUNDER(); pg8::Gemm g{hb, wup, M, 2 * DFF, DM}; pg8::StaticOrder S; S.init(M, 2 * DFF, G, bx); EpiFfnAct E{act, hid, (const ssq_t*)(ws + WS_SS) + (size_t)(2 * l + 1) * M, in_[23] + (size_t)l * 3 * 2 * DFF, in_[24] + (size_t)l * 2 * DFF, lds};
            pg8::gemm_phase<EpiFfnAct, pg8::StaticOrder, GEMM_ALIGN, GEMM_SP2>(lds, g, S, E);
            { const int idle_from = ((M / 256) * (2 * DFF / 256)) % G; if (TF_DN > 0 && idle_from > 0 && bx >= idle_from) convert_deferred(lds, in_, ws, l, 1, bx, G, idle_from, wave, lane); } }
        if (l == DIAG_LAYER) STAMP(14); SEAM(pb + 5); if (l == DIAG_LAYER) STAMP(15);
        if (IN(pb + 6)) for (int rep = 0; rep < NREP(7); ++rep) { LAUNDER(); phase_ffn_fix(hid, in_[23] + (size_t)l * 3 * 2 * DFF, in_[24] + (size_t)l * 2 * DFF, act, gtid, ngt); }
        if (l == DIAG_LAYER) STAMP(16); SEAM(pb + 6); if (l == DIAG_LAYER) STAMP(17);
        if (IN(pb + 7)) for (int rep = 0; rep < NREP(8); ++rep) { LAUNDER(); pg8::Gemm g{act, wdn, M, DM, DFF}; pg8::StaticOrder S; S.init(M, DM, G, bx); EpiResB16 E{hb, (ssq_t*)(ws + WS_SS) + (size_t)(2 * l + 2) * M, DM};
            pg8::gemm_phase<EpiResB16, pg8::StaticOrder, GEMM_ALIGN, GEMM_SP2>(lds, g, S, E); }
        if (l == DIAG_LAYER) STAMP(18); SEAM(pb + 7); if (l == DIAG_LAYER) STAMP(19);
        if (IN(pb + 8) && l + 1 == DEPTH) { LAUNDER(); final_norm_rows(hb, (const ssq_t*)(ws + WS_SS) + (size_t)(2 * l + 2) * M, in_[26], (float*)in_[27], gw, ngw, lane); }
        if (l + 1 == DEPTH) SEAM(pb + 8);
    }
#if defined(DIAG)
    {
        STAMP(30);
        __syncthreads(); if (tid0 < 32) ((unsigned long long*)(ws0 + WS_TS))[(size_t)bx0 * 64 + tid0] = *(volatile LAS unsigned long long*)(lds + MISC_OFF - 256 + 8 * tid0);
        xcd_barrier(bar);
        if (bx0 == 0) { volatile LAS float* red = (volatile LAS float*)lds; const unsigned long long* ts = (const unsigned long long*)(ws0 + WS_TS); float* outp = (float*)a.out;
            float va = 0.f, vb = 0.f;
            if (tid0 < 256) { const int w = tid0; const unsigned long long* t = ts + (size_t)w * 64;
                if (w >= DIAG_LOA && w < DIAG_HIA) va = (float)(long long)(t[DIAG_K2A] - t[DIAG_K1A]) * 0.01f;
                if (w >= DIAG_LOB && w < DIAG_HIB) vb = (float)(long long)(t[DIAG_K2B] - t[DIAG_K1B]) * 0.01f; }
#if defined(DIAG_MIN)
            if (!(tid0 < 256 && tid0 >= DIAG_LOA && tid0 < DIAG_HIA)) va = 1e30f;
            for (int o = 32; o >= 1; o >>= 1) { va = fminf(va, __shfl_xor(va, o)); vb = fmaxf(vb, __shfl_xor(vb, o)); }
#else
            for (int o = 32; o >= 1; o >>= 1) { va = fmaxf(va, __shfl_xor(va, o)); vb = fmaxf(vb, __shfl_xor(vb, o)); }
#endif
            if ((tid0 & 63) == 0) { red[tid0 >> 6] = va; red[8 + (tid0 >> 6)] = vb; }
            __syncthreads();
#if defined(DIAG_MIN)
            va = fminf(fminf(red[0], red[1]), fminf(red[2], red[3]));
#else
            va = fmaxf(fmaxf(red[0], red[1]), fmaxf(red[2], red[3]));
#endif
            vb = fmaxf(fmaxf(red[8], red[9]), fmaxf(red[10], red[11]));
            asm volatile("s_waitcnt vmcnt(0)" ::: "memory");
#if defined(DIAG_ABS)
            (void)vb; if (tid0 == 0) outp[0] = (va - DIAG_OFF) * DIAG_SCALE;
#else
            (void)vb; if (tid0 == 0) outp[0] += (va - DIAG_OFF) * DIAG_SCALE;
#endif
            }
    }
#endif
#undef IN
#undef SEAM
#undef hb
#undef proj
#undef mix
#undef xa
#undef xb
#undef hid
#undef act
#undef stg
#undef ug
#undef decg
#undef HL
#undef PC
#undef CAR
}

extern "C" void kernel_launch(void* const* d_in, const int* in_sizes, int n_in, void* d_out, int out_size, void* d_ws, size_t ws_size, hipStream_t stream) {
    if (n_in != 27 || out_size != M * DM || ws_size < WS_END) { fprintf(stderr, "kernel_launch: unexpected shapes (n_in %d out %d ws %zu need %zu)\n", n_in, out_size, ws_size, (size_t)WS_END); return; }
    static int grid = 0;
    if (grid == 0) {
        int dev = 0, cus = 0, per_cu = 0;
        if (hipGetDevice(&dev) != hipSuccess || hipDeviceGetAttribute(&cus, hipDeviceAttributeMultiprocessorCount, dev) != hipSuccess) { fprintf(stderr, "kernel_launch: device query failed\n"); grid = -1; return; }
        if (hipFuncSetAttribute((const void*)mega, hipFuncAttributeMaxDynamicSharedMemorySize, LDS_BYTES) != hipSuccess) { fprintf(stderr, "kernel_launch: hipFuncSetAttribute(%d B LDS) failed\n", LDS_BYTES); grid = -1; return; }
        if (hipOccupancyMaxActiveBlocksPerMultiprocessor(&per_cu, (const void*)mega, NTHR, LDS_BYTES) != hipSuccess || per_cu < 1) { fprintf(stderr, "kernel_launch: occupancy query says %d blocks/CU\n", per_cu); }
        (void)hipGetLastError();
        grid = cus;
    }
    if (grid < 0) return;
    const float* const* in = (const float* const*)d_in; unsigned char* ws = (unsigned char*)d_ws;
    (void)hipMemsetAsync(ws + WS_CTL, 0, CTL_BYTES, stream);
    Args a{}; for (int i = 0; i < 27; ++i) a.in[i] = in[i]; a.out = (float*)d_out; a.ws = ws; a.pad = 0;
    int li = 0;
    auto launch = [&](int lo, int hi) { a.ph_lo = lo; a.ph_hi = hi; a.li = li++; hipLaunchKernelGGL(mega, dim3(grid), dim3(NTHR), LDS_BYTES, stream, a); };
#if USE_DN && USE_LRU && USE_SG
    launch(0, N_PHASES);
#else
    bf16* proj = (bf16*)(ws + WS_PROJ); bf16* mix = (bf16*)(ws + WS_MIX);
    float *qf = (float*)(ws + WS_QF), *kf = (float*)(ws + WS_KF), *vf = (float*)(ws + WS_VF), *of = (float*)(ws + WS_OF), *la = (float*)(ws + WS_LA), *lif = (float*)(ws + WS_LI), *sv = (float*)(ws + WS_SV), *sy = (float*)(ws + WS_SY);
    float* beta = (float*)(ws + WS_BG); float* gg = beta + M * DNH;
    int cur = 0;
    for (int l = 0; l < DEPTH; ++l) {
        const int pb = 1 + 9 * l;
        launch(cur, pb + 1); cur = pb + 1;
#if !USE_DN
        hipLaunchKernelGGL(k_dn_prep, dim3(M * DNH), dim3(128), 0, stream, (const bf16*)proj, in[3] + (size_t)l * 4 * 3 * DNW, in[4] + l * DNH, in[5] + l * DNH, qf, kf, vf, beta, gg);
        hipLaunchKernelGGL(k_dn_scan, dim3(BATCH * DNH), dim3(128), 0, stream, (const float*)qf, (const float*)kf, (const float*)vf, (const float*)beta, (const float*)gg, of);
        hipLaunchKernelGGL(k_groupnorm, dim3(M * DNH / 4), dim3(256), 0, stream, (const float*)of, DNW, in[6] + l * HD, (const bf16*)proj, mix, 0, 0);
#endif
#if !USE_LRU
        hipLaunchKernelGGL(k_lru_gates, dim3(M * LRB), dim3(128), 0, stream, (const bf16*)proj, in[7] + (size_t)l * 4 * LRW, in[8] + l * LRW, in[9] + (size_t)l * LRB * HD * HD, in[10] + l * LRW, in[11] + (size_t)l * LRB * HD * HD, in[12] + l * LRW, in[13] + l * LRW, la, lif);
        hipLaunchKernelGGL(k_lru_scan, dim3(BATCH * LRW / 64), dim3(64), 0, stream, (const float*)la, lif, (const bf16*)proj);
        hipLaunchKernelGGL(k_groupnorm, dim3(M * LRB / 4), dim3(256), 0, stream, (const float*)lif, LRW, in[14] + l * LRW, (const bf16*)proj, mix, DNW, 1);
#endif
#if !USE_SG
        hipLaunchKernelGGL(k_sg_ln, dim3(M), dim3(256), 0, stream, (const bf16*)proj, in[15] + l * SGW, in[16] + l * SGW, sv);
        hipLaunchKernelGGL(k_sg_mix, dim3(BATCH * (SEQ / 128) * SGG), dim3(128), 0, stream, (const float*)sv, in[17] + (size_t)l * SGG * 128 * 128, in[18] + l * SGG * 128, (const bf16*)proj, sy);
        hipLaunchKernelGGL(k_groupnorm, dim3(M * SGG / 4), dim3(256), 0, stream, (const float*)sy, SGW, in[19] + l * SGW, (const bf16*)proj, mix, DNW + LRW, 1);
#endif
    }
    launch(cur, N_PHASES);
#endif
}
```

```cpp
#include <hip/hip_runtime.h>
#include <cstdio>
#include <cstdint>
#define USE_DN 1
#define USE_LRU 1
#define USE_SG 1
#define DUP_MASK 0
#define DUP_SUB 0

namespace pg8 {
#define PG8_LAS __attribute__((address_space(3)))
typedef unsigned short bf16_t;
typedef short bf16x8 __attribute__((ext_vector_type(8)));
typedef float f32x4 __attribute__((ext_vector_type(4)));
typedef unsigned u32x4 __attribute__((ext_vector_type(4)));
constexpr int BM = 256, BK = 64, HALF = 128, HTB = HALF * BK * 2  , STAGE_BYTES = 8 * HTB, NXCD = 8, WGM = 8;

__host__ __device__ __forceinline__ int lds_byte(int r, int c) { const int st = (r >> 4) * 2 + (c >> 5), rr = r & 15, cc = c & 31, ob = rr * 64 + cc * 2; return st * 1024 + (ob ^ (((ob >> 9) & 1) << 5)); }
__host__ __device__ __forceinline__ void stage_rc(int b, int& R, int& C) { const int st = b / 1024, sb = b % 1024, swz = sb ^ (((sb >> 9) & 1) << 5); R = (st >> 1) * 16 + swz / 64; C = (st & 1) * 32 + (swz % 64) / 2; }
__host__ __device__ __forceinline__ int perm32(int rho) { const int n = rho >> 4, i = rho & 15; return 8 * (i >> 2) + 4 * n + (i & 3); }

struct Unit { int pm, pn; };
struct Gemm { const bf16_t* A; const bf16_t* Bt; int M, N, K; };

struct StaticOrder {
    int nM, nN, nwg, G, c;
    __host__ __device__ void init(int M, int N, int G_, int c_) { nM = M / BM; nN = N / BM; nwg = nM * nN; G = G_; c = c_; }
    __host__ __device__ bool next(int i, Unit& u) const {
        const long L = (long)i * G + c; if (L >= nwg) return false;
        int wgid = (int)L; { const int q = nwg / NXCD, r = nwg % NXCD, xcd = wgid % NXCD, off = wgid / NXCD; wgid = (xcd < r ? xcd * (q + 1) : r * (q + 1) + (xcd - r) * q) + off; }
        const int nig = WGM * nN, gid = wgid / nig, fm = gid * WGM, gsz = (nM - fm) < WGM ? (nM - fm) : WGM;
        u.pm = fm + ((wgid % nig) % gsz); u.pn = (wgid % nig) / gsz; return true;
    }
    __device__ __forceinline__ void a_ready(const Unit&) const {}
    __device__ __forceinline__ void done(const Unit&) const {}
};

__device__ __forceinline__ unsigned cvt_pk_bf16(float lo, float hi) { unsigned r; asm volatile("v_cvt_pk_bf16_f32 %0, %1, %2" : "=v"(r) : "v"(lo), "v"(hi)); return r; }
typedef float f32x2 __attribute__((ext_vector_type(2)));
__device__ __forceinline__ f32x2 gelu_pk(f32x2 v) {
    const f32x2 av = __builtin_elementwise_abs(v), d = av * 0.2316418882f + 1.0f;
    f32x2 t; t.x = __builtin_amdgcn_rcpf(d.x); t.y = __builtin_amdgcn_rcpf(d.y);
    f32x2 q = t * 0.5307027145f + (-0.7265760135f); q = q * t + 0.7107068705f; q = q * t + (-0.142248368f); q = q * t + 0.127414796f; q = q * t;
    const f32x2 s = (v * v) * (-0.72134752044f);
    f32x2 e; e.x = __builtin_amdgcn_exp2f(s.x); e.y = __builtin_amdgcn_exp2f(s.y);
    const f32x2 m = v * (q * e), r = v - m;
    f32x2 o; o.x = v.x < 0.f ? m.x : r.x; o.y = v.y < 0.f ? m.y : r.y; return o;
}

template <int ACT  > struct EpiBf16 {
    static constexpr bool PERM = true, AFTER_DRAIN = false; static_assert(ACT == 0 || ACT == 1, "EpiBf16: ACT is 0 (none) or 1 (gelu_pk)");
    bf16_t* O; int ldc; const float* bias; int split_cols; size_t split_stride; float scale0;
    __device__ __forceinline__ void operator()(const f32x4 (&acc)[2][2][4][2], const Unit& u, int wr, int wc, int fr, int fq) const {
        const int row0 = u.pm * BM + wr * 64 + fr; int colt = u.pn * BM; bf16_t* base = O;
        float sc = 1.f; if (split_cols) { const int t = colt / split_cols; base += (size_t)t * split_stride; colt -= t * split_cols; if (t == 0) sc = scale0; }
        const int col0 = colt + wc * 32 + 8 * fq, bcol0 = u.pn * BM + wc * 32 + 8 * fq;
        f32x4 bv[2][2];
#pragma unroll
        for (int bj = 0; bj < 2; ++bj)
#pragma unroll
            for (int n = 0; n < 2; ++n) bv[bj][n] = bias ? *(const f32x4*)(bias + bcol0 + bj * HALF + 4 * n) : (f32x4){0.f, 0.f, 0.f, 0.f};
#pragma unroll
        for (int ai = 0; ai < 2; ++ai)
#pragma unroll
            for (int m = 0; m < 4; ++m) { bf16_t* rowp = base + (size_t)(row0 + ai * HALF + m * 16) * ldc + col0;
#pragma unroll
                for (int bj = 0; bj < 2; ++bj) { f32x4 v0 = acc[ai][bj][m][0] + bv[bj][0], v1 = acc[ai][bj][m][1] + bv[bj][1];
                    if (ACT == 1) { f32x2 a = gelu_pk((f32x2){v0[0], v0[1]}), b = gelu_pk((f32x2){v0[2], v0[3]}), c = gelu_pk((f32x2){v1[0], v1[1]}), d = gelu_pk((f32x2){v1[2], v1[3]});
                        v0 = (f32x4){a.x, a.y, b.x, b.y}; v1 = (f32x4){c.x, c.y, d.x, d.y}; }
                    v0 = v0 * sc; v1 = v1 * sc; u32x4 w; w.x = cvt_pk_bf16(v0[0], v0[1]); w.y = cvt_pk_bf16(v0[2], v0[3]); w.z = cvt_pk_bf16(v1[0], v1[1]); w.w = cvt_pk_bf16(v1[2], v1[3]);
                    *(u32x4*)(rowp + bj * HALF) = w; } }
    }
};

template <class Epi, class Sched, bool ALIGN_EPI = false, bool SP2 = false>
__device__ __forceinline__ void gemm_phase(PG8_LAS unsigned char* lds, const Gemm g, const Sched& S, const Epi& E) {
    int tid_l = threadIdx.x; asm volatile("" : "+v"(tid_l));
    const int tid = tid_l, wid = __builtin_amdgcn_readfirstlane(tid >> 6), lane = tid & 63, wr = wid >> 2, wc = wid & 3, fr = lane & 15, fq = lane >> 4;
    const int K = g.K, nt = K / BK;
    unsigned voffA[2], voffB[2];
#pragma unroll
    for (int i = 0; i < 2; ++i) { int R, C; stage_rc(tid * 16 + i * 8192, R, C); const int Rb = Epi::PERM ? ((R & ~31) + perm32(R & 31)) : R;
        voffA[i] = (unsigned)(R * K + C) * 2u; voffB[i] = (unsigned)(Rb * K + C) * 2u; }
    const size_t kstep = (size_t)(BK * 2);
    const size_t hstep = (size_t)HALF * K * 2;
    const size_t tstep = 2 * hstep;
    const unsigned ldsw = (unsigned)wid * 1024u;
    const int aoff = lds_byte(wr * 64 + fr, fq * 8), boff = lds_byte(wc * 32 + fr, fq * 8);
#define PG8_SA(b, h) (((b) * 2 + (h)) * HTB)
#define PG8_SB(b, h) ((4 + (b) * 2 + (h)) * HTB)
#define PG8_STAGE(bufoff, gbase, voff) do { _Pragma("unroll") for (int _i = 0; _i < 2; ++_i) \
        __builtin_amdgcn_global_load_lds((const unsigned*)((const char*)(gbase) + (voff)[_i]), (PG8_LAS unsigned*)(lds + (bufoff) + ldsw + _i * 8192), 16, 0, 0); } while (0)
#define PG8_LDA(dst, b, h) do { _Pragma("unroll") for (int m = 0; m < 4; ++m) _Pragma("unroll") for (int k = 0; k < 2; ++k) dst[m][k] = *(const PG8_LAS bf16x8*)(lds + PG8_SA(b, h) + aoff + m * 2048 + k * 1024); } while (0)
#define PG8_LDB(dst, b, h) do { _Pragma("unroll") for (int n = 0; n < 2; ++n) _Pragma("unroll") for (int k = 0; k < 2; ++k) dst[n][k] = *(const PG8_LAS bf16x8*)(lds + PG8_SB(b, h) + boff + n * 2048 + k * 1024); } while (0)
#define PG8_MMA(ai, bj, At, Bt) do { __builtin_amdgcn_s_setprio(1); _Pragma("unroll") for (int m = 0; m < 4; ++m) _Pragma("unroll") for (int n = 0; n < 2; ++n) _Pragma("unroll") for (int k = 0; k < 2; ++k) \
        acc[ai][bj][m][n] = __builtin_amdgcn_mfma_f32_16x16x32_bf16(Bt[n][k], At[m][k], acc[ai][bj][m][n], 0, 0, 0); __builtin_amdgcn_s_setprio(0); } while (0)
#define PG8_WAIT_V(n) asm volatile("s_waitcnt vmcnt(" #n ")" ::: "memory")
#define PG8_WAIT_L(n) asm volatile("s_waitcnt lgkmcnt(" #n ")" ::: "memory")
#define PG8_BAR __builtin_amdgcn_s_barrier()
#define PG8_SCHED __builtin_amdgcn_sched_barrier(0)
    Unit cur, nxt; int ui = 0;
    if (!S.next(0, cur)) return;
    f32x4 acc[2][2][4][2];
#pragma unroll
    for (int a = 0; a < 2; ++a)
#pragma unroll
        for (int b = 0; b < 2; ++b)
#pragma unroll
            for (int m = 0; m < 4; ++m)
#pragma unroll
                for (int n = 0; n < 2; ++n) acc[a][b][m][n] = (f32x4){0.f, 0.f, 0.f, 0.f};
    bf16x8 At[4][2], B0[2][2], B1[2][2];
    const char* cA = (const char*)g.A + (size_t)cur.pm * tstep; const char* cB = (const char*)g.Bt + (size_t)cur.pn * tstep;
    S.a_ready(cur);
    if constexpr (SP2) {
        PG8_STAGE(PG8_SB(0, 0), cB, voffB); PG8_STAGE(PG8_SB(0, 1), cB + hstep, voffB); PG8_STAGE(PG8_SA(0, 0), cA, voffA); PG8_STAGE(PG8_SA(0, 1), cA + hstep, voffA);
        if (wr == 1) PG8_BAR;
        PG8_WAIT_V(2); PG8_BAR;
        PG8_STAGE(PG8_SB(1, 0), cB + kstep, voffB); PG8_STAGE(PG8_SA(1, 0), cA + kstep, voffA); PG8_STAGE(PG8_SB(1, 1), cB + hstep + kstep, voffB);
        PG8_WAIT_V(6); PG8_BAR;
    } else {
        PG8_STAGE(PG8_SB(0, 0), cB, voffB); PG8_STAGE(PG8_SA(0, 0), cA, voffA); PG8_STAGE(PG8_SB(0, 1), cB + hstep, voffB); PG8_STAGE(PG8_SA(0, 1), cA + hstep, voffA);
        if (wr == 1) PG8_BAR;
        PG8_WAIT_V(4); PG8_BAR;
        PG8_STAGE(PG8_SB(1, 0), cB + kstep, voffB); PG8_STAGE(PG8_SA(1, 0), cA + kstep, voffA); PG8_STAGE(PG8_SB(1, 1), cB + hstep + kstep, voffB);
        PG8_WAIT_V(6); PG8_BAR;
    }
    for (;;) {
        const bool has_next = S.next(ui + 1, nxt);
        const char* nA = has_next ? (const char*)g.A + (size_t)nxt.pm * tstep : cA; const char* nB = has_next ? (const char*)g.Bt + (size_t)nxt.pn * tstep : cB;
        for (int t = 0; t < nt; t += 2) {
            const bool last = (t == nt - 2);
            const char* a1 = cA + (size_t)(t + 1) * kstep;
            const char* a2 = last ? nA : cA + (size_t)(t + 2) * kstep; const char* b2 = last ? nB : cB + (size_t)(t + 2) * kstep;
            const char* a3 = a2 + kstep; const char* b3 = b2 + kstep;
            if (last && has_next) S.a_ready(nxt);
            if constexpr (SP2) {
            PG8_LDB(B0, 0, 0); PG8_LDB(B1, 0, 1); PG8_SCHED; PG8_LDA(At, 0, 0); PG8_STAGE(PG8_SA(1, 1), a1 + hstep, voffA);
            PG8_WAIT_V(8); PG8_WAIT_L(0); PG8_BAR; PG8_MMA(0, 0, At, B0); PG8_MMA(0, 1, At, B1); PG8_BAR; PG8_SCHED;
            PG8_LDA(At, 0, 1); PG8_STAGE(PG8_SB(0, 0), b2, voffB); PG8_STAGE(PG8_SB(0, 1), b2 + hstep, voffB); PG8_STAGE(PG8_SA(0, 0), a2, voffA);
            PG8_WAIT_V(8); PG8_WAIT_L(0); PG8_BAR; PG8_MMA(1, 0, At, B0); PG8_MMA(1, 1, At, B1); PG8_BAR; PG8_SCHED;
            PG8_LDB(B0, 1, 0); PG8_LDB(B1, 1, 1); PG8_SCHED; PG8_LDA(At, 1, 0); PG8_STAGE(PG8_SA(0, 1), a2 + hstep, voffA);
            PG8_WAIT_V(8); PG8_WAIT_L(0); PG8_BAR; PG8_MMA(0, 0, At, B0); PG8_MMA(0, 1, At, B1); PG8_BAR; PG8_SCHED;
            PG8_LDA(At, 1, 1); PG8_STAGE(PG8_SB(1, 0), b3, voffB); PG8_STAGE(PG8_SB(1, 1), b3 + hstep, voffB); PG8_STAGE(PG8_SA(1, 0), a3, voffA);
            PG8_WAIT_V(8); PG8_WAIT_L(0); PG8_BAR; PG8_MMA(1, 0, At, B0); PG8_MMA(1, 1, At, B1); PG8_BAR; PG8_SCHED;
            } else {
            PG8_LDB(B0, 0, 0); PG8_SCHED; PG8_LDA(At, 0, 0); PG8_STAGE(PG8_SA(1, 1), a1 + hstep, voffA);
            PG8_WAIT_L(8); PG8_BAR; PG8_WAIT_L(0); PG8_MMA(0, 0, At, B0); PG8_BAR; PG8_SCHED;
            PG8_LDB(B1, 0, 1); PG8_STAGE(PG8_SB(0, 0), b2, voffB);
            PG8_BAR; PG8_WAIT_L(0); PG8_MMA(0, 1, At, B1); PG8_BAR;
            PG8_LDA(At, 0, 1); PG8_STAGE(PG8_SA(0, 0), a2, voffA);
            PG8_BAR; PG8_WAIT_L(0); PG8_MMA(1, 0, At, B0); PG8_BAR; PG8_SCHED;
            PG8_STAGE(PG8_SB(0, 1), b2 + hstep, voffB);
            PG8_WAIT_V(6); PG8_BAR; PG8_MMA(1, 1, At, B1); PG8_BAR;
            PG8_LDB(B0, 1, 0); PG8_SCHED; PG8_LDA(At, 1, 0); PG8_STAGE(PG8_SA(0, 1), a2 + hstep, voffA);
            PG8_WAIT_L(8); PG8_BAR; PG8_WAIT_L(0); PG8_MMA(0, 0, At, B0); PG8_BAR; PG8_SCHED;
            PG8_LDB(B1, 1, 1); PG8_STAGE(PG8_SB(1, 0), b3, voffB);
            PG8_BAR; PG8_WAIT_L(0); PG8_MMA(0, 1, At, B1); PG8_BAR;
            PG8_LDA(At, 1, 1); PG8_STAGE(PG8_SA(1, 0), a3, voffA);
            PG8_BAR; PG8_WAIT_L(0); PG8_MMA(1, 0, At, B0); PG8_BAR; PG8_SCHED;
            PG8_STAGE(PG8_SB(1, 1), b3 + hstep, voffB);
            PG8_WAIT_V(6); PG8_BAR; PG8_MMA(1, 1, At, B1); PG8_BAR;
            }
        }
        if constexpr (ALIGN_EPI) { if (wr == 0) PG8_BAR; }
        if constexpr (!Epi::AFTER_DRAIN) { E(acc, cur, wr, wc, fr, fq); S.done(cur); }
        if (!has_next) break;
#pragma unroll
        for (int a = 0; a < 2; ++a)
#pragma unroll
            for (int b = 0; b < 2; ++b)
#pragma unroll
                for (int m = 0; m < 4; ++m)
#pragma unroll
                    for (int n = 0; n < 2; ++n) acc[a][b][m][n] = (f32x4){0.f, 0.f, 0.f, 0.f};
        cur = nxt; cA = nA; cB = nB; ++ui;
        if constexpr (ALIGN_EPI) { if (wr == 1) PG8_BAR; }
    }
    PG8_WAIT_V(0);
    if constexpr (!ALIGN_EPI) { if (wr == 0) PG8_BAR; }
    PG8_BAR;
    if constexpr (Epi::AFTER_DRAIN) { E.fused(acc, cur, wr, wc, fr, fq, lds, wid, lane); S.done(cur); }
#undef PG8_SA
#undef PG8_SB
#undef PG8_STAGE
#undef PG8_LDA
#undef PG8_LDB
#undef PG8_MMA
#undef PG8_WAIT_V
#undef PG8_WAIT_L
#undef PG8_BAR
#undef PG8_SCHED
}
}
constexpr int BATCH = 2, SEQ = 4096, M = BATCH * SEQ, DM = 4096, DEPTH = 2, HD = 128;
constexpr int DNW = 1536, LRW = 1536, SGW = 1024, DNH = 12, LRB = 12, SGG = 8, DFF = 11008, DIN = 11288, DINP = 11520;
constexpr int Q0 = 0, K0 = 1536, V0 = 3072, Z0 = 4608, LX0 = 6144, LG0 = 7680, SU0 = 9216, SV0 = 10240, BA0 = 11264;
constexpr float EPS = 1e-6f;
typedef unsigned short bf16;
typedef unsigned long long ssq_t;
__device__ __forceinline__ float ssq_rstd(ssq_t v) { return __builtin_amdgcn_rsqf((float)v * (1.0f / 65536.0f) * (1.0f / 4096.0f) + 1e-6f); }
__device__ __forceinline__ ssq_t ssq_fix(float s) { return (ssq_t)(s * 65536.0f + 0.5f); }
typedef float f32x4 __attribute__((ext_vector_type(4)));
typedef unsigned u32x4 __attribute__((ext_vector_type(4)));
typedef unsigned u32x2 __attribute__((ext_vector_type(2)));
#define LAS __attribute__((address_space(3)))
__device__ __forceinline__ unsigned f2bf(float f) { unsigned u = __builtin_bit_cast(unsigned, f); return (u + 0x7fffu + ((u >> 16) & 1u)) >> 16; }
__device__ __forceinline__ unsigned pk2(float lo, float hi) { return f2bf(lo) | (f2bf(hi) << 16); }
__device__ __forceinline__ float bf2f(unsigned short b) { return __builtin_bit_cast(float, ((unsigned)b) << 16); }
__device__ __forceinline__ float bflo(unsigned w) { return __builtin_bit_cast(float, w << 16); }
__device__ __forceinline__ float bfhi(unsigned w) { return __builtin_bit_cast(float, w & 0xffff0000u); }
__device__ __forceinline__ float rcpf_(float x) { return __builtin_amdgcn_rcpf(x); }
__device__ __forceinline__ float sigmoidf_(float x) { return rcpf_(1.0f + __expf(-x)); }
__device__ __forceinline__ float siluf_(float x) { return x * sigmoidf_(x); }
__device__ __forceinline__ float geluf_(float x) { const float u2 = 1.5957691216057308f * (x + 0.044715f * x * x * x); return x * rcpf_(1.0f + __expf(-u2)); }
__device__ __forceinline__ float softplusf_(float x) { return x > 20.f ? x : log1pf(expf(x)); }
__device__ __forceinline__ float wave_sum(float v) {
#pragma unroll
    for (int o = 1; o < 64; o <<= 1) v += __shfl_xor(v, o);
    return v;
}

__device__ __forceinline__ void transpose_item(const float* W, int K, int Nsrc, bf16* WT, int dst_row0, int src_col0, int nvalid  , const float* kscale, LAS float* scr, int kb, int lane) {
    const int k0 = 64 * kb, kr = lane >> 4, c4 = lane & 15; f32x4 v[16];
#pragma unroll
    for (int i = 0; i < 16; ++i) v[i] = (4 * c4 < nvalid) ? *(const f32x4*)(W + (size_t)(k0 + 4 * i + kr) * Nsrc + src_col0 + 4 * c4) : (f32x4){0.f, 0.f, 0.f, 0.f};
    if (kscale) {
#pragma unroll
        for (int i = 0; i < 16; ++i) v[i] = v[i] * kscale[k0 + 4 * i + kr]; }
#pragma unroll
    for (int i = 0; i < 16; ++i) { LAS float* d = scr + (4 * i + kr) * 65 + 4 * c4; d[0] = v[i].x; d[1] = v[i].y; d[2] = v[i].z; d[3] = v[i].w; }
    asm volatile("s_waitcnt lgkmcnt(0)" ::: "memory");
    const int nl = lane & 7, kc = lane >> 3;
#pragma unroll
    for (int j = 0; j < 8; ++j) { const LAS float* s = scr + (8 * kc) * 65 + 8 * j + nl;
        u32x4 o; o.x = pk2(s[0 * 65], s[1 * 65]); o.y = pk2(s[2 * 65], s[3 * 65]); o.z = pk2(s[4 * 65], s[5 * 65]); o.w = pk2(s[6 * 65], s[7 * 65]);
        __builtin_nontemporal_store(o, (u32x4*)(WT + (size_t)(dst_row0 + 8 * j + nl) * K + k0 + 8 * kc)); }
    asm volatile("s_waitcnt lgkmcnt(0)" ::: "memory");
}

struct EpiBf16Rs {
    static constexpr bool PERM = true, AFTER_DRAIN = false;
    bf16* O; int ldc; const ssq_t* ss;
    __device__ __forceinline__ void operator()(const pg8::f32x4 (&acc)[2][2][4][2], const pg8::Unit& u, int wr, int wc, int fr, int fq) const {
        const int row0 = u.pm * 256 + wr * 64 + fr, col0 = u.pn * 256 + wc * 32 + 8 * fq;
#pragma unroll
        for (int ai = 0; ai < 2; ++ai)
#pragma unroll
            for (int m = 0; m < 4; ++m) { const int row = row0 + ai * 128 + m * 16; const float rs = ssq_rstd(ss[row]); bf16* rowp = O + (size_t)row * ldc + col0;
#pragma unroll
                for (int bj = 0; bj < 2; ++bj) { const pg8::f32x4 v0 = acc[ai][bj][m][0] * rs, v1 = acc[ai][bj][m][1] * rs;
                    pg8::u32x4 w; w.x = pg8::cvt_pk_bf16(v0[0], v0[1]); w.y = pg8::cvt_pk_bf16(v0[2], v0[3]); w.z = pg8::cvt_pk_bf16(v1[0], v1[1]); w.w = pg8::cvt_pk_bf16(v1[2], v1[3]);
                    *(pg8::u32x4*)(rowp + bj * 128) = w; } }
    }
};

struct EpiResB16 {
    static constexpr bool PERM = true, AFTER_DRAIN = false;
    bf16* X; ssq_t* ss; int ldc;
    __device__ __forceinline__ void operator()(const pg8::f32x4 (&acc)[2][2][4][2], const pg8::Unit& u, int wr, int wc, int fr, int fq) const {
        const int row0 = u.pm * 256 + wr * 64 + fr, col0 = u.pn * 256 + wc * 32 + 8 * fq;
        u32x4 rv[8][2];
#pragma unroll
        for (int it = 0; it < 8; ++it) { const size_t off = (size_t)(row0 + (it >> 2) * 128 + (it & 3) * 16) * ldc + col0; rv[it][0] = *(const u32x4*)(X + off); rv[it][1] = *(const u32x4*)(X + off + 128); }
        __builtin_amdgcn_s_waitcnt(0x4F70);
#pragma unroll
        for (int it = 0; it < 8; ++it) { const int ai = it >> 2, m = it & 3, row = row0 + ai * 128 + m * 16; const size_t off = (size_t)row * ldc + col0; float s = 0.f;
#pragma unroll
            for (int bj = 0; bj < 2; ++bj) { float r8[8]; const u32x4 w = rv[it][bj]; r8[0] = bflo(w.x); r8[1] = bfhi(w.x); r8[2] = bflo(w.y); r8[3] = bfhi(w.y); r8[4] = bflo(w.z); r8[5] = bfhi(w.z); r8[6] = bflo(w.w); r8[7] = bfhi(w.w);
                const pg8::f32x4 v0 = acc[ai][bj][m][0] + (pg8::f32x4){r8[0], r8[1], r8[2], r8[3]}, v1 = acc[ai][bj][m][1] + (pg8::f32x4){r8[4], r8[5], r8[6], r8[7]};
                s += ((v0[0] * v0[0] + v0[1] * v0[1]) + (v0[2] * v0[2] + v0[3] * v0[3])) + ((v1[0] * v1[0] + v1[1] * v1[1]) + (v1[2] * v1[2] + v1[3] * v1[3]));
                u32x4 o; o.x = pg8::cvt_pk_bf16(v0[0], v0[1]); o.y = pg8::cvt_pk_bf16(v0[2], v0[3]); o.z = pg8::cvt_pk_bf16(v1[0], v1[1]); o.w = pg8::cvt_pk_bf16(v1[2], v1[3]);
                *(u32x4*)(X + off + bj * 128) = o; }
            s += __shfl_xor(s, 16); s += __shfl_xor(s, 32);
            if (fq == 0) __hip_atomic_fetch_add((__attribute__((address_space(1))) ssq_t*)(ss + row), ssq_fix(s), __ATOMIC_RELAXED, __HIP_MEMORY_SCOPE_AGENT); }
    }
};
#define XB_TMO      128
#define XB_XCNT(j)  (256  + 64 * (j))
#define XB_XSUB(j)  (1280 + 64 * (j))
#define XB_XGEN(j)  (2304 + 64 * (j))
#define XB_TOP      3328
#define XB_TOPGEN   3392
#define XCD_BAR_WORDS 3456
#define XB_SPIN_CAP (1u << 18)

__device__ __forceinline__ unsigned xb_ld(unsigned* p)              { return __hip_atomic_load(p, __ATOMIC_RELAXED, __HIP_MEMORY_SCOPE_AGENT); }
__device__ __forceinline__ unsigned xb_add(unsigned* p, unsigned v) { return __hip_atomic_fetch_add(p, v, __ATOMIC_RELAXED, __HIP_MEMORY_SCOPE_AGENT); }
__device__ __forceinline__ unsigned xb_xcc_id() { return (unsigned)__builtin_amdgcn_s_getreg((3 << 11) | 20) & 0xFu; }
#define XB_SPIN(cond, bar) do { unsigned _sp = 0; while (cond) { __builtin_amdgcn_s_sleep(1); \
    if ((++_sp & 255u) == 0u) { if (xb_ld(&(bar)[XB_TMO])) break; if (_sp > XB_SPIN_CAP) { atomicAdd(&(bar)[XB_TMO], 1u); break; } } } } while (0)

struct XcdBarrier {
    unsigned* bar; unsigned x;
    volatile LAS unsigned* st;
};

__device__ __forceinline__ XcdBarrier xcd_barrier_post(unsigned* bar, volatile LAS unsigned* st) {
    XcdBarrier b; b.bar = bar; b.x = xb_xcc_id(); b.st = st;
    if (threadIdx.x == 0) (void)xb_add(&bar[XB_XCNT(b.x)], 1u);
    return b;
}
__device__ __forceinline__ void xcd_barrier_complete(unsigned* bar, unsigned x, unsigned& nloc, unsigned& nx) {
    const unsigned G = gridDim.x * gridDim.y * gridDim.z;
    unsigned sum, cnt, mine, sp = 0u;
    for (;;) {
        sum = 0u; cnt = 0u; mine = 0u;
#pragma unroll
        for (unsigned j = 0; j < 16; ++j) { const unsigned c = xb_ld(&bar[XB_XCNT(j)]); sum += c; cnt += (c > 0u) ? 1u : 0u; mine = (j == x) ? c : mine; }
        if (sum == G) break;
        __builtin_amdgcn_s_sleep(1);
        if ((++sp & 255u) == 0u) { if (xb_ld(&bar[XB_TMO])) break; if (sp > XB_SPIN_CAP) { atomicAdd(&bar[XB_TMO], 1u); break; } }
    }
    nloc = mine > 0u ? mine : 1u; nx = cnt > 0u ? cnt : 1u;
}

__device__ __forceinline__ void xcd_barrier(const XcdBarrier& b) {
    asm volatile("s_waitcnt vmcnt(0)" ::: "memory");
    __syncthreads();
    if (threadIdx.x == 0) {
        unsigned* bar = b.bar;
        __builtin_amdgcn_s_waitcnt(0);
        unsigned nloc = b.st[0], nx = b.st[1];
        if (nloc == 0u) { xcd_barrier_complete(bar, b.x, nloc, nx); b.st[0] = nloc; b.st[1] = nx; }
        const unsigned old = xb_add(&bar[XB_XSUB(b.x)], 1u);
        const unsigned gen = old / nloc;
        if (old + 1u == (gen + 1u) * nloc) {
            __builtin_amdgcn_fence(__ATOMIC_RELEASE, "agent");
            asm volatile("s_waitcnt vmcnt(0)" ::: "memory");
            const unsigned og = xb_add(&bar[XB_TOP], 1u);
            const unsigned tg = og / nx;
            if (og + 1u == (tg + 1u) * nx) xb_add(&bar[XB_TOPGEN], 1u);
            else XB_SPIN(xb_ld(&bar[XB_TOPGEN]) == tg, bar);
            __builtin_amdgcn_fence(__ATOMIC_ACQUIRE, "agent");
            xb_add(&bar[XB_XGEN(b.x)], 1u);
            asm volatile("s_waitcnt vmcnt(0)" ::: "memory");
        } else {
            XB_SPIN(xb_ld(&bar[XB_XGEN(b.x)]) == gen, bar);
            __builtin_amdgcn_fence(__ATOMIC_ACQUIRE, "agent");
            asm volatile("s_waitcnt vmcnt(0)" ::: "memory");
        }
    }
    __syncthreads();
}

constexpr int NTHR = 512, NWAVES = 8;
constexpr int LDS_BYTES = 163840, MISC_OFF = LDS_BYTES - 256;
typedef short bf16x8 __attribute__((ext_vector_type(8)));
typedef float f32x16 __attribute__((ext_vector_type(16)));
#define MFMA16(a, b, c) __builtin_amdgcn_mfma_f32_16x16x32_bf16((a), (b), (c), 0, 0, 0)
#define MFMA32(a, b, c) __builtin_amdgcn_mfma_f32_32x32x16_bf16((a), (b), (c), 0, 0, 0)
#define WG_SYNC() do { asm volatile("s_waitcnt lgkmcnt(0)" ::: "memory"); __builtin_amdgcn_s_barrier(); asm volatile("" ::: "memory"); } while (0)
#define RAW_BAR() do { asm volatile("s_waitcnt lgkmcnt(0)" ::: "memory"); __builtin_amdgcn_s_barrier(); asm volatile("" ::: "memory"); } while (0)
typedef float f32x2_t __attribute__((ext_vector_type(2))); typedef __bf16 bf16x2_t __attribute__((ext_vector_type(2)));
__device__ __forceinline__ unsigned cvtpk(float lo, float hi) { const f32x2_t v = {lo, hi}; const bf16x2_t b = __builtin_convertvector(v, bf16x2_t); return __builtin_bit_cast(unsigned, b); }
__device__ __forceinline__ bf16x8 pack8(f32x4 a, f32x4 b) { u32x4 p; p.x = cvtpk(a.x, a.y); p.y = cvtpk(a.z, a.w); p.z = cvtpk(b.x, b.y); p.w = cvtpk(b.z, b.w); return __builtin_bit_cast(bf16x8, p); }
__device__ __forceinline__ int crow32(int i, int h) { return (i & 3) + 8 * (i >> 2) + 4 * h; }
__device__ __forceinline__ void unpack8(u32x4 w, float (&f)[8]) { f[0] = bflo(w.x); f[1] = bfhi(w.x); f[2] = bflo(w.y); f[3] = bfhi(w.y); f[4] = bflo(w.z); f[5] = bfhi(w.z); f[6] = bflo(w.w); f[7] = bfhi(w.w); }

constexpr size_t MiB = 1u << 20;
constexpr size_t SZ_WIN = (size_t)DINP * DM * 2, SZ_WOUT = (size_t)DM * DM * 2, SZ_WUP = (size_t)2 * DFF * DM * 2, SZ_WDN = (size_t)DM * DFF * 2;
constexpr size_t WS_CTL = 0, CTL_BYTES = 1 * MiB, WS_W = 1 * MiB, SZ_WL = SZ_WIN + SZ_WOUT + SZ_WUP + SZ_WDN;
constexpr size_t WS_HB = WS_W + 2 * SZ_WL, WS_PROJ = WS_HB + (size_t)M * DM * 2, WS_MIX = WS_PROJ + (size_t)M * DINP * 2, WS_XA = WS_MIX + (size_t)M * DM * 2, WS_XB = WS_XA + (size_t)M * DM * 4;
constexpr size_t WS_HID_OLD = WS_XB + (size_t)M * DM * 4, WS_ACT_OLD = WS_HID_OLD + (size_t)M * 2 * DFF * 2, WS_SCR = WS_ACT_OLD + (size_t)M * DFF * 2;
constexpr size_t WS_HID = WS_PROJ, WS_ACT = WS_HID + (size_t)M * 2 * DFF * 2;
static_assert(WS_ACT + (size_t)M * DFF * 2 <= WS_SCR, "hid | act overlay");
constexpr size_t SZ_F1536 = (size_t)M * 1536 * 4, SZ_F1024 = (size_t)M * 1024 * 4;
constexpr size_t WS_QF = WS_SCR, WS_KF = WS_QF + SZ_F1536, WS_VF = WS_KF + SZ_F1536, WS_OF = WS_VF + SZ_F1536, WS_LA = WS_OF + SZ_F1536, WS_LI = WS_LA + SZ_F1536,
                 WS_SV = WS_LI + SZ_F1536, WS_SY = WS_SV + SZ_F1024, WS_BG = WS_SY + SZ_F1024, WS_NAIVE_END = WS_BG + 2 * MiB;
constexpr int DN_UNITS = BATCH * DNH * 64, DN_STAGE = 73728, DN_W_OFF = 0, DN_KT_OFF = 16384, DN_UB_OFF = 32768, DN_Q_OFF = 49152, DN_AT_OFF = 65536, DN_SEQ_BYTES = 49152;

constexpr size_t WS_STG = WS_NAIVE_END, WS_UG = WS_STG + (size_t)DN_UNITS * DN_STAGE, WS_DEC = WS_UG + (size_t)DN_UNITS * 32768, WS_HL = WS_DEC + 1 * MiB, WS_PC = WS_HL + SZ_F1536,
                 WS_CAR = WS_PC + SZ_F1536, WS_WAT = WS_CAR + 1 * MiB, WS_WXT = WS_WAT + 1 * MiB, WS_WSB = WS_WXT + 1 * MiB, WS_SGST = WS_WSB + 1 * MiB, WS_TS = WS_SGST + 1 * MiB, WS_SALL = WS_TS + 1 * MiB, WS_END = WS_SALL + (size_t)DN_UNITS * 32768;
constexpr size_t WS_SS = WS_CTL + 512 * 1024;
constexpr int CW_BAR = 4096;

__device__ __forceinline__ void rows_to_bf16_ss(const float* x, bf16* ob, ssq_t* ss, int gw, int ngw, int lane) {
    for (int row = gw; row < M; row += ngw) {
        const f32x4* xr = (const f32x4*)(x + (size_t)row * DM) + lane; f32x4 v[16]; float s = 0.f;
#pragma unroll
        for (int j = 0; j < 16; ++j) { v[j] = xr[64 * j]; s += (v[j].x * v[j].x + v[j].y * v[j].y) + (v[j].z * v[j].z + v[j].w * v[j].w); }
        s = wave_sum(s);
#pragma unroll
        for (int j = 0; j < 16; ++j) { u32x2 p; p.x = cvtpk(v[j].x, v[j].y); p.y = cvtpk(v[j].z, v[j].w); *((u32x2*)(ob + (size_t)row * DM) + lane + 64 * j) = p; }
        if (lane == 0) ss[row] = ssq_fix(s);
    }
}
__device__ __forceinline__ void final_norm_rows(const bf16* x, const ssq_t* ss, const float* w, float* of, int gw, int ngw, int lane) {
    for (int row = gw; row < M; row += ngw) {
        const u32x2* xr = (const u32x2*)(x + (size_t)row * DM) + lane; const f32x4* wr = (const f32x4*)w + lane; const float rstd = ssq_rstd(ss[row]);
#pragma unroll
        for (int j = 0; j < 16; ++j) { const u32x2 v = xr[64 * j]; const f32x4 o = (f32x4){bflo(v.x), bfhi(v.x), bflo(v.y), bfhi(v.y)} * rstd * wr[64 * j]; __builtin_nontemporal_store(o, (f32x4*)(of + (size_t)row * DM) + lane + 64 * j); }
    }
}
constexpr int I_IN = (DINP / 64) * (DM / 64), I_OUT = (DM / 64) * (DM / 64), I_UP = (2 * DFF / 64) * (DM / 64), I_DN = (DM / 64) * (DFF / 64), I_L = I_IN + I_OUT + I_UP + I_DN;
#ifndef TF_UP
#define TF_UP 9216
#endif
#ifndef TF_DN
#define TF_DN 6144
#endif
#ifndef TF_IN1
#define TF_IN1 4096
#endif
#ifndef TF_DN2
#define TF_DN2 4096
#endif
constexpr int I_KEPT = I_L - TF_UP - TF_DN, I_KEPT_A = I_IN + I_OUT + I_UP - TF_UP, I_KEPT1 = I_KEPT - TF_IN1 - TF_DN2;
static_assert(DEPTH == 2, "deferred weight-conversion bookkeeping assumes two layers");
template <class INP> __device__ __forceinline__ void convert_item(INP in, unsigned char* ws, int it, LAS float* scr, int lane) {
    const int l = it / I_L; int r = it % I_L;
    bf16* win = (bf16*)(ws + WS_W + l * SZ_WL); bf16* wout = (bf16*)((unsigned char*)win + SZ_WIN); bf16* wup = (bf16*)((unsigned char*)wout + SZ_WOUT); bf16* wdn = (bf16*)((unsigned char*)wup + SZ_WUP);
    if (r < I_IN) { const int nblk = DINP / 64, kb = r / nblk, n0 = (r % nblk) * 64; int src = n0, nv = 64;
        if (n0 < 6144) { src = n0; } else if (n0 < 11264) { src = n0 + 24; } else if (n0 == 11264) { src = 6144; nv = 24; } else { src = 0; nv = 0; }
        transpose_item(in[2] + (size_t)l * DM * DIN, DM, DIN, win, n0, src, nv, in[1] + l * DM, scr, kb, lane); return; }
    r -= I_IN;
    if (r < I_OUT) { const int nblk = DM / 64; transpose_item(in[20] + (size_t)l * DM * DM, DM, DM, wout, (r % nblk) * 64, (r % nblk) * 64, 64, nullptr, scr, r / nblk, lane); return; }
    r -= I_OUT;
    if (r < I_UP) { const int nblk = 2 * DFF / 64; const int n0 = (r % nblk) * 64, cch = n0 < DFF ? n0 : n0 - DFF;
        transpose_item(in[22] + (size_t)l * DM * 2 * DFF, DM, 2 * DFF, wup, (cch >> 7) * 256 + (n0 < DFF ? 0 : 128) + (cch & 127), n0, 64, in[21] + l * DM, scr, r / nblk, lane); return; }
    r -= I_UP;
    { const int nblk = DM / 64; transpose_item(in[25] + (size_t)l * DFF * DM, DFF, DM, wdn, (r % nblk) * 64, (r % nblk) * 64, 64, nullptr, scr, r / nblk, lane); }
}
template <class INP> __device__ __forceinline__ void convert_deferred(LAS unsigned char* lds, INP in, unsigned char* ws, int l, int which, int bx, int G, int wg_from, int wave, int lane) {
    LAS float* scr = (LAS float*)(lds + wave * 16640);
    const int first = l * I_L + (which == 0 ? I_IN + I_OUT + I_UP - TF_UP : which == 1 ? I_L - TF_DN : which == 2 ? I_IN - TF_IN1 : I_L - TF_DN - TF_DN2), cnt = which == 0 ? TF_UP : which == 1 ? TF_DN : which == 2 ? TF_IN1 : TF_DN2;
    for (int k = (bx - wg_from) * NWAVES + wave; k < cnt; k += (G - wg_from) * NWAVES) convert_item(in, ws, first + k, scr, lane);
}
template <class INP> __device__ __forceinline__ void phase_prologue(LAS unsigned char* lds, INP in, unsigned char* ws, int gw, int ngw, int gtid, int ngt, int wave, int lane) {
    LAS float* scr = (LAS float*)(lds + wave * 16640);
    for (int j = gw; j < I_KEPT + I_KEPT1; j += ngw) { const int l = j >= I_KEPT; int r = j - l * I_KEPT;
        if (l && r >= I_IN - TF_IN1) r += TF_IN1;
        convert_item(in, ws, l * I_L + (r < I_KEPT_A ? r : r + TF_UP), scr, lane); }
    bf16* wat = (bf16*)(ws + WS_WAT); bf16* wxt = (bf16*)(ws + WS_WXT); bf16* wsb = (bf16*)(ws + WS_WSB);
    for (int i = gtid; i < DEPTH * LRB * HD * HD; i += ngt) { const int ii = i & 127, j = (i >> 7) & 127, lg = i >> 14; const size_t src = ((size_t)lg * HD + ii) * HD + j;
        wat[i] = (bf16)f2bf(in[9][src]); wxt[i] = (bf16)f2bf(in[11][src]); }
    for (int i = gtid; i < DEPTH * SGG * 128 * 128; i += ngt) { const int s = i & 127, t = (i >> 7) & 127; wsb[i] = (s <= t) ? (bf16)f2bf(in[17][i]) : (bf16)0; }
    rows_to_bf16_ss(in[0], (bf16*)(ws + WS_HB), (ssq_t*)(ws + WS_SS), gw, ngw, lane);
}

template <int CTRL> __device__ __forceinline__ float dppf(float v) {
#if defined(NO_DPP)
    return v;
#endif
    return __builtin_bit_cast(float, __builtin_amdgcn_update_dpp(0, __builtin_bit_cast(int, v), CTRL, 0xF, 0xF, true)); }
struct EpiFfnAct {
    static constexpr bool PERM = true, AFTER_DRAIN = false;
    bf16* A_; bf16* H_; const ssq_t* ss; const float* cw; const float* cb; LAS unsigned char* lds;
    __device__ __forceinline__ void operator()(const pg8::f32x4 (&acc)[2][2][4][2], const pg8::Unit& u, int wr, int wc, int fr, int fq) const {
        const int row0 = u.pm * 256 + wr * 64 + fr, colg = u.pn * 128 + wc * 32 + 8 * fq;
        LAS float* halo = (LAS float*)(lds + pg8::STAGE_BYTES);
        LAS float* WT = (LAS float*)(lds + pg8::STAGE_BYTES + 8192);
        LAS float* RT = WT + 1024;
        {
            const int wid_ = wr * 4 + wc, ln = fq * 16 + fr, bj = wid_ >> 2, arr = wid_ & 3;
            const float* src = (arr < 3 ? cw + (size_t)arr * 2 * DFF : cb) + bj * DFF + u.pn * 128;
            typedef float f32x2_ __attribute__((ext_vector_type(2)));
            const f32x2_ wv = *(const f32x2_*)((const char*)src + (unsigned)(ln * 8));
            if (wid_ < 4) { const ssq_t sv = *(const ssq_t*)((const char*)(ss + u.pm * 256) + (unsigned)((wid_ * 64 + ln) * 8)); RT[wid_ * 64 + ln] = ssq_rstd(sv); }
            *(LAS f32x2_*)(WT + wid_ * 128 + 2 * ln) = wv;
        }
        asm volatile("s_waitcnt lgkmcnt(0)" ::: "memory"); __builtin_amdgcn_s_barrier();
        const float rs03 = RT[wr * 64 + fr + 48], rs13 = RT[wr * 64 + fr + 176], rs00 = RT[wr * 64 + fr];
        if (fr >= 14) {
#pragma unroll
            for (int ai = 0; ai < 2; ++ai)
#pragma unroll
                for (int bj = 0; bj < 2; ++bj) { LAS float* d = halo + (((((2 * ai + wr) * 2 + (fr - 14)) * 4 + wc) * 2 + bj) * 4 + fq) * 8;
                    const float r3 = ai ? rs13 : rs03; *(LAS pg8::f32x4*)d = acc[ai][bj][3][0] * r3; *(LAS pg8::f32x4*)(d + 4) = acc[ai][bj][3][1] * r3; }
        }
        if ((wr == 0 && fr < 2) || (wr == 1 && fr >= 14)) {
#pragma unroll
            for (int bj = 0; bj < 2; ++bj) { const float r_ = wr == 0 ? rs00 : rs13; const pg8::f32x4 v0 = (wr == 0 ? acc[0][bj][0][0] : acc[1][bj][3][0]) * r_, v1 = (wr == 0 ? acc[0][bj][0][1] : acc[1][bj][3][1]) * r_;
                u32x4 o; o.x = cvtpk(v0[0], v0[1]); o.y = cvtpk(v0[2], v0[3]); o.z = cvtpk(v1[0], v1[1]); o.w = cvtpk(v1[2], v1[3]);
                *(u32x4*)(H_ + (size_t)(row0 + (wr == 0 ? 0 : 176)) * (2 * DFF) + u.pn * 256 + bj * 128 + wc * 32 + 8 * fq) = o; }
        }
        asm volatile("s_waitcnt lgkmcnt(0)" ::: "memory"); __builtin_amdgcn_s_barrier();
        const bool l15 = fr == 15, l1415 = fr >= 14;
#pragma unroll
        for (int ai = 0; ai < 2; ++ai) { asm volatile("" ::: "memory"); float rs[4];
#pragma unroll
            for (int m = 0; m < 4; ++m) rs[m] = RT[wr * 64 + fr + ai * 128 + m * 16];
#pragma unroll
            for (int n = 0; n < 2; ++n) { pg8::f32x4 yg[4]; asm volatile("" ::: "memory");
#pragma unroll
                for (int bj = 0; bj < 2; ++bj) { const int ch = bj * DFF + colg + 4 * n;
                    const LAS float* wt = WT + bj * 512 + wc * 32 + 8 * fq + 4 * n; (void)ch;
                    const pg8::f32x4 w0 = *(const LAS pg8::f32x4*)wt, w1 = *(const LAS pg8::f32x4*)(wt + 128), w2 = *(const LAS pg8::f32x4*)(wt + 256), bb = *(const LAS pg8::f32x4*)(wt + 384);
                    pg8::f32x4 hc = acc[ai][bj][3][n] * rs[3];
#pragma unroll
                    for (int mm = 0; mm < 4; ++mm) { const int m = 3 - mm; pg8::f32x4 hp;
                        if (m > 0) hp = acc[ai][bj][m > 0 ? m - 1 : 0][n] * rs[m > 0 ? m - 1 : 0];
                        else if (2 * ai + wr > 0) hp = *(const LAS pg8::f32x4*)(halo + (((((2 * ai + wr - 1) * 2 + (fr & 1)) * 4 + wc) * 2 + bj) * 4 + fq) * 8 + 4 * n);
                        else hp = (pg8::f32x4){0.f, 0.f, 0.f, 0.f};
                        pg8::f32x4 h1, h2;
#pragma unroll
                        for (int i = 0; i < 4; ++i) { h1[i] = dppf<0x121>(l15 ? hp[i] : hc[i]); h2[i] = dppf<0x122>(l1415 ? hp[i] : hc[i]); }
                        const pg8::f32x4 y = bb + w2 * hc + w1 * h1 + w0 * h2;
                        if (bj == 0) yg[m] = y;
                        else { u32x2 o; o.x = cvtpk(siluf_(yg[m][0]) * y[0], siluf_(yg[m][1]) * y[1]); o.y = cvtpk(siluf_(yg[m][2]) * y[2], siluf_(yg[m][3]) * y[3]);
                            *(u32x2*)((char*)A_ + (unsigned)((row0 + ai * 128 + m * 16) * DFF + colg + 4 * n) * 2u) = o; }
                        hc = hp; }
                }
            }
        }
    }
};
__device__ __forceinline__ void phase_ffn_fix(const bf16* hidp, const float* cw, const float* cb, bf16* actp, int gtid, int ngt) {
    constexpr int NOCT = DFF / 8;
    for (int it = gtid; it < (M / 256) * NOCT; it += ngt) { const int pm = it / NOCT, oct = it % NOCT, r0 = pm * 256;
        if (r0 % SEQ == 0) continue;
        const int c0 = oct * 8, colp = (c0 >> 7) * 256 + (c0 & 127);
        float g[4][8], uu[4][8];
#pragma unroll
        for (int r = 0; r < 4; ++r) { const bf16* pr = hidp + (size_t)(r0 - 2 + r) * (2 * DFF) + colp; unpack8(*(const u32x4*)pr, g[r]); unpack8(*(const u32x4*)(pr + 128), uu[r]); }
        float wg[3][8], wu[3][8], bg[8], bu[8];
#pragma unroll
        for (int j = 0; j < 3; ++j)
#pragma unroll
            for (int i = 0; i < 8; ++i) { wg[j][i] = cw[(size_t)j * 2 * DFF + c0 + i]; wu[j][i] = cw[(size_t)j * 2 * DFF + DFF + c0 + i]; }
#pragma unroll
        for (int i = 0; i < 8; ++i) { bg[i] = cb[c0 + i]; bu[i] = cb[DFF + c0 + i]; }
#pragma unroll
        for (int r = 0; r < 2; ++r) { float o[8];
#pragma unroll
            for (int i = 0; i < 8; ++i) { const float yg = bg[i] + wg[0][i] * g[r][i] + wg[1][i] * g[r + 1][i] + wg[2][i] * g[r + 2][i], yu = bu[i] + wu[0][i] * uu[r][i] + wu[1][i] * uu[r + 1][i] + wu[2][i] * uu[r + 2][i];
                o[i] = siluf_(yg) * yu; }
            u32x4 pk; pk.x = cvtpk(o[0], o[1]); pk.y = cvtpk(o[2], o[3]); pk.z = cvtpk(o[4], o[5]); pk.w = cvtpk(o[6], o[7]);
            *(u32x4*)(actp + (size_t)(r0 + r) * DFF + c0) = pk; }
    }
}

__device__ __forceinline__ void phase_ffn_act(const bf16* hid, const float* cw, const float* cb, bf16* act, int gw, int ngw, int lane) {
    constexpr int NOG = (DFF / 8 + 63) / 64, NSTRIP = M / 16;
    for (int item = gw; item < NOG * NSTRIP; item += ngw) {
        const int strip = item / NOG, og = item % NOG, oct = og * 64 + lane;
        if (oct < DFF / 8) {
            const int c0 = oct * 8, m0 = strip * 16, t0 = m0 % SEQ;
            float wg[3][8], wu[3][8], bg[8], bu[8];
#pragma unroll
            for (int j = 0; j < 3; ++j) { const f32x4 a0 = *(const f32x4*)(cw + (size_t)j * 2 * DFF + c0), a1 = *(const f32x4*)(cw + (size_t)j * 2 * DFF + c0 + 4), b0 = *(const f32x4*)(cw + (size_t)j * 2 * DFF + DFF + c0), b1 = *(const f32x4*)(cw + (size_t)j * 2 * DFF + DFF + c0 + 4);
                wg[j][0] = a0.x; wg[j][1] = a0.y; wg[j][2] = a0.z; wg[j][3] = a0.w; wg[j][4] = a1.x; wg[j][5] = a1.y; wg[j][6] = a1.z; wg[j][7] = a1.w;
                wu[j][0] = b0.x; wu[j][1] = b0.y; wu[j][2] = b0.z; wu[j][3] = b0.w; wu[j][4] = b1.x; wu[j][5] = b1.y; wu[j][6] = b1.z; wu[j][7] = b1.w; }
            { const f32x4 a0 = *(const f32x4*)(cb + c0), a1 = *(const f32x4*)(cb + c0 + 4), b0 = *(const f32x4*)(cb + DFF + c0), b1 = *(const f32x4*)(cb + DFF + c0 + 4);
              bg[0] = a0.x; bg[1] = a0.y; bg[2] = a0.z; bg[3] = a0.w; bg[4] = a1.x; bg[5] = a1.y; bg[6] = a1.z; bg[7] = a1.w; bu[0] = b0.x; bu[1] = b0.y; bu[2] = b0.z; bu[3] = b0.w; bu[4] = b1.x; bu[5] = b1.y; bu[6] = b1.z; bu[7] = b1.w; }
            float g0[8], g1[8], u0[8], u1[8];
            if (t0 > 0) { const bf16* pr = hid + (size_t)(m0 - 2) * (2 * DFF) + c0;
                unpack8(*(const u32x4*)pr, g0); unpack8(*(const u32x4*)(pr + DFF), u0); unpack8(*(const u32x4*)(pr + 2 * DFF), g1); unpack8(*(const u32x4*)(pr + 3 * DFF), u1); }
            else {
#pragma unroll
                for (int i = 0; i < 8; ++i) { g0[i] = 0.f; g1[i] = 0.f; u0[i] = 0.f; u1[i] = 0.f; } }
#pragma unroll 4
            for (int r = 0; r < 16; ++r) {
                const bf16* pr = hid + (size_t)(m0 + r) * (2 * DFF) + c0; float g2[8], u2[8]; unpack8(*(const u32x4*)pr, g2); unpack8(*(const u32x4*)(pr + DFF), u2);
                float o[8];
#pragma unroll
                for (int i = 0; i < 8; ++i) { const float yg = bg[i] + wg[0][i] * g0[i] + wg[1][i] * g1[i] + wg[2][i] * g2[i], yu = bu[i] + wu[0][i] * u0[i] + wu[1][i] * u1[i] + wu[2][i] * u2[i];
                    o[i] = siluf_(yg) * yu; g0[i] = g1[i]; g1[i] = g2[i]; u0[i] = u1[i]; u1[i] = u2[i]; }
                u32x4 pk; pk.x = cvtpk(o[0], o[1]); pk.y = cvtpk(o[2], o[3]); pk.z = cvtpk(o[4], o[5]); pk.w = cvtpk(o[6], o[7]);
                *(u32x4*)(act + (size_t)(m0 + r) * DFF + c0) = pk;
            }
        }
    }
}
__device__ __forceinline__ void phase_sg_stats(const bf16* proj, float* sgst, int gw, int ngw, int lane) {
    for (int m = gw; m < M; m += ngw) { const bf16* p = proj + (size_t)m * DINP + SV0 + 8 * lane; float s = 0.f, s2 = 0.f;
#pragma unroll
        for (int jj = 0; jj < 2; ++jj) { const u32x4 v = *(const u32x4*)(p + 512 * jj); float f[8]; unpack8(v, f);
#pragma unroll
            for (int i = 0; i < 8; ++i) { const float gv = geluf_(f[i]); s += gv; s2 += gv * gv; } }
        s = wave_sum(s); s2 = wave_sum(s2);
        if (lane == 0) { const float mu = s * (1.0f / SGW); float var = s2 * (1.0f / SGW) - mu * mu; var = var > 0.f ? var : 0.f; sgst[2 * m] = mu; sgst[2 * m + 1] = 1.0f / sqrtf(var + EPS); } }
}

#if defined(DIAG)
#define DP_STAMP(k) do { if (tid == 0 && unit >= (int)gridDim.x && unit < 2 * (int)gridDim.x) *(volatile LAS unsigned long long*)(lds + MISC_OFF - 256 + 8 * (k)) = __builtin_amdgcn_s_memrealtime(); } while (0)
#else
#define DP_STAMP(k) do { } while (0)
#endif
__device__ __forceinline__ void dn_gates_all(LAS unsigned char* lds, int wave, int lane, int bx, int G, const bf16* proj, const float* a_log, const float* dt_bias, float* dec_all) {
    const int unit = bx + wave * G;
    if (unit < DN_UNITS) {
        const int n = unit & 63, bh = unit >> 6, b = bh / DNH, h = bh % DNH; const size_t m = (size_t)b * SEQ + n * 64 + lane;
        LAS float* SMb = (LAS float*)(lds + 145408 + wave * 1280);
        const float braw = bf2f(proj[m * DINP + BA0 + h]), araw = bf2f(proj[m * DINP + BA0 + DNH + h]);
        const float beta = sigmoidf_(braw), g = -expf(a_log[h]) * softplusf_(araw + dt_bias[h]);
        float gc = g;
#pragma unroll
        for (int o = 1; o < 64; o <<= 1) { const float t = __shfl_up(gc, o); if (lane >= o) gc += t; }
        const float gl = __shfl(gc, 63);
        const float eg = __expf(gc); SMb[lane] = beta; SMb[64 + lane] = gc; SMb[128 + lane] = eg; SMb[192 + lane] = __expf(gl - gc); SMb[256 + lane] = beta * eg;
        if (lane == 63) dec_all[unit] = eg;
    }
    WG_SYNC();
}
__device__ __forceinline__ void dn_prep_unit(LAS unsigned char* lds, int tid, int wave, int lane, int unit, int unit_next, int slot, const bf16* proj, const float* convw, const float* a_log, const float* dt_bias,
                                             unsigned char* stg_all, float* ug_all, float* dec_all) {
    const int n = unit & 63, bh = unit >> 6, b = bh / DNH, h = bh % DNH, t0 = n * 64; const size_t m0 = (size_t)b * SEQ + t0;
    DP_STAMP(22);
    LAS float* KS = (LAS float*)(lds); LAS float* VS = (LAS float*)(lds + 33792);
    LAS bf16* QB = (LAS bf16*)(lds + 67584); LAS bf16* KB = (LAS bf16*)(lds + 84992);
    LAS float* AM = (LAS float*)(lds + 102400); LAS float* AT = (LAS float*)(lds + 119808);
    const LAS float* SMb = (const LAS float*)(lds + 145408 + slot * 1280);
    unsigned char* stg = stg_all + (size_t)unit * DN_STAGE; float* ug = ug_all + (size_t)unit * 8192;
    {
        const int rb = tid >> 4, cg = tid & 15;
        u32x4 xr[3][5];
#pragma unroll
        for (int p = 0; p < 3; ++p)
#pragma unroll
            for (int k = 0; k < 5; ++k) { const int rr = 2 * rb - 3 + k; xr[p][k] = (t0 + rr >= 0) ? *(const u32x4*)(proj + (size_t)((long)m0 + rr) * DINP + p * DNW + h * HD + cg * 8) : (u32x4){0u, 0u, 0u, 0u}; }
#pragma unroll
        for (int p = 0; p < 3; ++p) {
            const int c0 = p * DNW + h * HD + cg * 8;
            float w[4][8];
#pragma unroll
            for (int j = 0; j < 4; ++j) { const f32x4 a = *(const f32x4*)(convw + j * 3 * DNW + c0), bq = *(const f32x4*)(convw + j * 3 * DNW + c0 + 4);
                w[j][0] = a.x; w[j][1] = a.y; w[j][2] = a.z; w[j][3] = a.w; w[j][4] = bq.x; w[j][5] = bq.y; w[j][6] = bq.z; w[j][7] = bq.w; }
            float x[5][8];
#pragma unroll
            for (int k = 0; k < 5; ++k) unpack8(xr[p][k], x[k]);
#pragma unroll
            for (int rr = 0; rr < 2; ++rr) {
                const int row = 2 * rb + rr; float y[8]; float ss = 0.f;
#pragma unroll
                for (int i = 0; i < 8; ++i) { float a = 0.f;
#pragma unroll
                    for (int j = 0; j < 4; ++j) a += w[j][i] * x[rr + j][i];
                    y[i] = siluf_(a); ss += y[i] * y[i]; }
                if (p < 2) { ss += __shfl_xor(ss, 1); ss += __shfl_xor(ss, 2); ss += __shfl_xor(ss, 4); ss += __shfl_xor(ss, 8); const float rn = 1.0f / sqrtf(ss + EPS);
#pragma unroll
                    for (int i = 0; i < 8; ++i) y[i] *= rn; }
                if (p == 0) {
                    u32x4 pk; pk.x = cvtpk(y[0], y[1]); pk.y = cvtpk(y[2], y[3]); pk.z = cvtpk(y[4], y[5]); pk.w = cvtpk(y[6], y[7]);
                    *(LAS u32x4*)(QB + row * 136 + cg * 8) = pk;
                    const float sc = SMb[128 + row] * 0.08838834764831845f;
                    const int mt = row >> 4, rp = row & 15, s = cg >> 2, jj = (cg & 3) >> 1, q0 = 2 * (cg & 1);
                    u32x2 a0, a1; a0.x = cvtpk(y[0] * sc, y[1] * sc); a0.y = cvtpk(y[2] * sc, y[3] * sc); a1.x = cvtpk(y[4] * sc, y[5] * sc); a1.y = cvtpk(y[6] * sc, y[7] * sc);
                    bf16* qf = (bf16*)(stg + DN_Q_OFF);
                    *(u32x2*)(qf + ((size_t)((mt * 4 + s) * 64 + q0 * 16 + rp)) * 8 + 4 * jj) = a0;
                    *(u32x2*)(qf + ((size_t)((mt * 4 + s) * 64 + (q0 + 1) * 16 + rp)) * 8 + 4 * jj) = a1;
                } else if (p == 1) {
                    *(LAS f32x4*)(KS + row * 132 + cg * 8) = (f32x4){y[0], y[1], y[2], y[3]}; *(LAS f32x4*)(KS + row * 132 + cg * 8 + 4) = (f32x4){y[4], y[5], y[6], y[7]};
                    u32x4 pk; pk.x = cvtpk(y[0], y[1]); pk.y = cvtpk(y[2], y[3]); pk.z = cvtpk(y[4], y[5]); pk.w = cvtpk(y[6], y[7]);
                    *(LAS u32x4*)(KB + row * 136 + cg * 8) = pk;
                } else {
                    const float bt = SMb[row];
                    *(LAS f32x4*)(VS + row * 132 + cg * 8) = (f32x4){y[0] * bt, y[1] * bt, y[2] * bt, y[3] * bt}; *(LAS f32x4*)(VS + row * 132 + cg * 8 + 4) = (f32x4){y[4] * bt, y[5] * bt, y[6] * bt, y[7] * bt};
                }
            }
        }
    }
    WG_SYNC(); DP_STAMP(24);
    {
        const int p = wave >> 2, mt = wave & 3, r = lane & 15, q = lane >> 4;
        LAS bf16* Aop = p ? QB : KB;
#pragma unroll
        for (int nt = 0; nt < 4; ++nt) {
            if (nt <= mt) {
                f32x4 acc = (f32x4){0.f, 0.f, 0.f, 0.f};
#pragma unroll
                for (int s = 0; s < 4; ++s) { const bf16x8 a = *(const LAS bf16x8*)(Aop + (16 * mt + r) * 136 + 32 * s + 8 * q), bb = *(const LAS bf16x8*)(KB + (16 * nt + r) * 136 + 32 * s + 8 * q);
                    acc = MFMA16(a, bb, acc); }
                const int jc = 16 * nt + r; const float gj = SMb[64 + jc];
#pragma unroll
                for (int i = 0; i < 4; ++i) { const int ir = 16 * mt + 4 * q + i; const float gi = SMb[64 + ir]; float v;
                    if (p == 0) v = (ir > jc) ? SMb[ir] * acc[i] * __expf(gi - gj) : 0.f; else v = (ir >= jc) ? acc[i] * __expf(gi - gj) * 0.08838834764831845f : 0.f;
                    if (p == 0) AM[ir * 68 + jc] = v; else AT[ir * 68 + jc] = v; }
            } else {
#pragma unroll
                for (int i = 0; i < 4; ++i) { if (p == 0) AM[(16 * mt + 4 * q + i) * 68 + 16 * nt + r] = 0.f; else AT[(16 * mt + 4 * q + i) * 68 + 16 * nt + r] = 0.f; }
            }
        }
    }
    WG_SYNC(); DP_STAMP(25);
    { const int ch = tid, mt = ch >> 7, s = (ch >> 6) & 1, ln = ch & 63, rp = ln & 15, q = ln >> 4, row = 16 * mt + rp;
        const f32x4 a0 = *(const LAS f32x4*)(AT + row * 68 + 32 * s + 4 * q), a1 = *(const LAS f32x4*)(AT + row * 68 + 32 * s + 16 + 4 * q);
        u32x4 pk; pk.x = cvtpk(a0.x, a0.y); pk.y = cvtpk(a0.z, a0.w); pk.z = cvtpk(a1.x, a1.y); pk.w = cvtpk(a1.z, a1.w);
        *(u32x4*)(stg + DN_AT_OFF + (size_t)ch * 16) = pk; }
#pragma unroll
    for (int k = 0; k < 2; ++k) { const int ch = tid + 512 * k, mt = ch >> 7, s = (ch >> 6) & 1, ln = ch & 63, rp = ln & 15, q = ln >> 4, d = 16 * mt + rp; float v[8];
#pragma unroll
        for (int j = 0; j < 8; ++j) { const int c = 32 * s + 16 * (j >> 2) + 4 * q + (j & 3); v[j] = KS[c * 132 + d] * SMb[192 + c]; }
        u32x4 pk; pk.x = cvtpk(v[0], v[1]); pk.y = cvtpk(v[2], v[3]); pk.z = cvtpk(v[4], v[5]); pk.w = cvtpk(v[6], v[7]);
        *(u32x4*)(stg + DN_KT_OFF + (size_t)ch * 16) = pk; }
    WG_SYNC(); DP_STAMP(26);
#if !defined(NO_WARM)
    if (unit_next < DN_UNITS) { const int n2 = unit_next & 63, bh2 = unit_next >> 6, b2 = bh2 / DNH, h2 = bh2 % DNH, t02 = n2 * 64; const long m02 = (long)b2 * SEQ + t02; const bf16* src = proj + (size_t)m02 * DINP + BA0;
        if (tid < 402) { const int rr = tid / 6 - 3, pp = (tid % 6) >> 1, hf = tid & 1; if (t02 + rr >= 0) src = proj + (size_t)(m02 + rr) * DINP + pp * DNW + h2 * HD + hf * 64; }
        else if (tid < 466) src = proj + (size_t)(m02 + (tid - 402)) * DINP + BA0;
        __builtin_amdgcn_global_load_lds((const unsigned*)src, (LAS unsigned*)(lds + 143360 + wave * 256), 4, 0, 0); }
#endif
    {
        const int r = lane & 15, q = lane >> 4; const bool isv = wave < 4; const LAS float* RS = isv ? VS : KS; const int cbase = (wave & 3) * 32;
        LAS float* NL = (LAS float*)(lds + 138752);
        f32x4 R[2][4];
#pragma unroll
        for (int tl = 0; tl < 2; ++tl)
#pragma unroll
            for (int I = 0; I < 4; ++I)
#pragma unroll
                for (int i = 0; i < 4; ++i) { const int row = 16 * I + 4 * q + i; float v = RS[row * 132 + cbase + 16 * tl + r]; if (!isv) v *= SMb[256 + row]; R[tl][I][i] = v; }
        bf16x8 fa[4];
#pragma unroll
        for (int f = 0; f < 4; ++f) { const int I = (f < 3) ? f + 1 : 3, s = (f == 3) ? 1 : 0, row = 16 * I + r;
            const f32x4 a0 = *(const LAS f32x4*)(AM + row * 68 + 32 * s + 4 * q), a1 = *(const LAS f32x4*)(AM + row * 68 + 32 * s + 16 + 4 * q);
            fa[f] = pack8((f32x4){-a0.x, -a0.y, -a0.z, -a0.w}, (f32x4){-a1.x, -a1.y, -a1.z, -a1.w}); }
        if (wave == 0) {
            const LAS float* L = AM + (16 * q) * 68 + 16 * q; float x[16];
#pragma unroll
            for (int i = 0; i < 16; ++i) { float s = 0.f;
#pragma unroll
                for (int j = 0; j < i; ++j) s += L[i * 68 + j] * x[j];
                x[i] = (i == r) ? 1.0f : ((i > r) ? -s : 0.0f); }
#pragma unroll
            for (int i = 0; i < 16; ++i) NL[(q * 16 + i) * 16 + r] = (i > r) ? x[i] : 0.0f;
        }
        WG_SYNC();
        const f32x4 zero4 = (f32x4){0.f, 0.f, 0.f, 0.f};
        bf16x8 fn[4];
#pragma unroll
        for (int B = 0; B < 4; ++B) fn[B] = pack8(*(const LAS f32x4*)(NL + (B * 16 + r) * 16 + 4 * q), zero4);
#pragma unroll
        for (int tl = 0; tl < 2; ++tl) {
            f32x4 X0 = MFMA16(fn[0], pack8(R[tl][0], zero4), R[tl][0]);
            const f32x4 Y1 = MFMA16(fa[0], pack8(X0, zero4), R[tl][1]);
            const f32x4 X1 = MFMA16(fn[1], pack8(Y1, zero4), Y1);
            const bf16x8 Xb0 = pack8(X0, X1);
            const f32x4 Y2 = MFMA16(fa[1], Xb0, R[tl][2]);
            const f32x4 X2 = MFMA16(fn[2], pack8(Y2, zero4), Y2);
            f32x4 Y3 = MFMA16(fa[2], Xb0, R[tl][3]); Y3 = MFMA16(fa[3], pack8(X2, zero4), Y3);
            const f32x4 X3 = MFMA16(fn[3], pack8(Y3, zero4), Y3);
            const f32x4 X[4] = {X0, X1, X2, X3};
            if (isv) {
                const int wv = 2 * wave + tl;
#pragma unroll
                for (int I = 0; I < 4; ++I) { const int ch = (wv * 4 + I) * 64 + lane; (void)ug;
                    u32x2 ub; ub.x = cvtpk(X[I].x, X[I].y); ub.y = cvtpk(X[I].z, X[I].w); *(u32x2*)(stg + DN_UB_OFF + (size_t)ch * 8) = ub; }
            } else {
                const int d = cbase + 16 * tl + r;
#pragma unroll
                for (int I = 0; I < 4; ++I)
#pragma unroll
                    for (int i = 0; i < 4; ++i) KS[(16 * I + 4 * q + i) * 132 + d] = X[I][i];
            }
        }
    }
    WG_SYNC(); DP_STAMP(27);
#pragma unroll
    for (int k = 0; k < 2; ++k) { const int ch = tid + 512 * k, mt = ch >> 8, s = (ch >> 6) & 3, ln = ch & 63, rp = ln & 15, q = ln >> 4, row = 16 * mt + rp;
        const f32x4 a0 = *(const LAS f32x4*)(KS + row * 132 + 32 * s + 4 * q), a1 = *(const LAS f32x4*)(KS + row * 132 + 32 * s + 16 + 4 * q);
        u32x4 pk; pk.x = cvtpk(-a0.x, -a0.y); pk.y = cvtpk(-a0.z, -a0.w); pk.z = cvtpk(-a1.x, -a1.y); pk.w = cvtpk(-a1.z, -a1.w);
        *(u32x4*)(stg + DN_W_OFF + (size_t)ch * 16) = pk; }
    WG_SYNC(); DP_STAMP(28);
}

__device__ __forceinline__ void dn_seq_bh(LAS unsigned char* lds, int tid, int wave, int lane, int bh, int half, const unsigned char* stg_all, const float* dec_all, unsigned char* sall) {
    #ifndef SEQ_WARM
#define SEQ_WARM 6
#endif
    constexpr int SLOT = 40960, SX_OFF = 3 * SLOT;
    const bool cw = wave < 4; const int wl = wave & 3, wv = 4 * half + wl;
    f32x4 S[8];
#pragma unroll
    for (int i = 0; i < 8; ++i) S[i] = (f32x4){0.f, 0.f, 0.f, 0.f};
    bf16x8 Sb[4];
#pragma unroll
    for (int s = 0; s < 4; ++s) Sb[s] = (bf16x8){0, 0, 0, 0, 0, 0, 0, 0};
    const unsigned char* stg_bh = stg_all + (size_t)bh * 64 * DN_STAGE; const float* dec_bh = dec_all + bh * 64;
    u32x4* sout = (u32x4*)(sall + ((size_t)bh * 64 * 8 + wv) * 4096) + lane;
#if defined(SEQ_HOT)
#define SQ_SRC(n_) ((n_) & 1)
#else
#define SQ_SRC(n_) (n_)
#endif
#define SQ_DMA(n_) do { const unsigned char* g_ = stg_bh + (size_t)SQ_SRC(n_) * DN_STAGE; const int sl_ = (n_) % 3; _Pragma("unroll") for (int k_ = 0; k_ < 10; ++k_) { const int ch_ = wave * 10 + k_; \
        const unsigned char* src_ = (ch_ < 32) ? (g_ + (size_t)ch_ * 1024) : (g_ + DN_UB_OFF + (size_t)half * 8192 + (size_t)(ch_ - 32) * 1024); \
        __builtin_amdgcn_global_load_lds((const unsigned*)(src_ + lane * 16), (LAS unsigned*)(lds + sl_ * SLOT + ch_ * 1024), 16, 0, 0); } } while (0)
    LAS float* DECL = (LAS float*)(lds + SX_OFF + 32768 + 2048);
    if (tid < 64) DECL[tid] = dec_bh[tid];
    if (cw) { SQ_DMA(0); SQ_DMA(1); }
    else {
#pragma unroll
        for (int s = 0; s < 4; ++s) *(LAS u32x4*)(lds + SX_OFF + ((wl * 4 + s) * 64 + lane) * 16) = (u32x4){0u, 0u, 0u, 0u};
    }
#pragma unroll 1
    for (int n = 0; n < 64; ++n) {
        if (cw) { if (n + 1 < 64) asm volatile("s_waitcnt vmcnt(10)" ::: "memory"); else asm volatile("s_waitcnt vmcnt(0)" ::: "memory"); }
        RAW_BAR();
        if (!cw) {
#pragma unroll
            for (int s = 0; s < 4; ++s) sout[(size_t)n * 2048 + s * 64] = *(const LAS u32x4*)(lds + SX_OFF + (n & 1) * 16384 + ((wl * 4 + s) * 64 + lane) * 16);
#if !defined(SEQ_NO_WARM)
            if (n + SEQ_WARM < 64) { const unsigned char* g_ = stg_bh + (size_t)(n + SEQ_WARM) * DN_STAGE; const int hl = wl * 64 + lane;
                __builtin_amdgcn_global_load_lds((const unsigned*)(g_ + (size_t)hl * 128), (LAS unsigned*)(lds + SX_OFF + 32768 + wl * 256), 4, 0, 0);
                if (wl == 0) __builtin_amdgcn_global_load_lds((const unsigned*)(g_ + DN_UB_OFF + (size_t)half * 8192 + (size_t)lane * 128), (LAS unsigned*)(lds + SX_OFF + 32768 + 1024), 4, 0, 0); }
#endif
        } else {
            if (n + 2 < 64) SQ_DMA(n + 2);
            const float dec = DECL[n];
            const LAS unsigned char* st = lds + (n % 3) * SLOT;
            f32x4 vn[4];
#pragma unroll
            for (int ct = 0; ct < 4; ++ct) { const u32x2 ub = *(const LAS u32x2*)(st + DN_UB_OFF + ((wl * 4 + ct) * 64 + lane) * 8); vn[ct] = (f32x4){bflo(ub.x), bfhi(ub.x), bflo(ub.y), bfhi(ub.y)}; }
            bf16x8 F0[4], F1[4];
#define SQ_LD4(F, off_, f0_) do { _Pragma("unroll") for (int i_ = 0; i_ < 4; ++i_) F[i_] = *(const LAS bf16x8*)(st + (off_) + (((f0_) + i_) * 64 + lane) * 16); } while (0)
            SQ_LD4(F0, DN_W_OFF, 0); SQ_LD4(F1, DN_W_OFF, 4);
#pragma unroll
            for (int s = 0; s < 4; ++s) vn[0] = MFMA16(F0[s], Sb[s], vn[0]);
            SQ_LD4(F0, DN_W_OFF, 8);
#pragma unroll
            for (int s = 0; s < 4; ++s) vn[1] = MFMA16(F1[s], Sb[s], vn[1]);
            SQ_LD4(F1, DN_W_OFF, 12);
#pragma unroll
            for (int s = 0; s < 4; ++s) vn[2] = MFMA16(F0[s], Sb[s], vn[2]);
            SQ_LD4(F0, DN_KT_OFF, 0);
#pragma unroll
            for (int s = 0; s < 4; ++s) vn[3] = MFMA16(F1[s], Sb[s], vn[3]);
            SQ_LD4(F1, DN_KT_OFF, 4);
            bf16x8 Vb[2];
#pragma unroll
            for (int s = 0; s < 2; ++s) Vb[s] = pack8(vn[2 * s], vn[2 * s + 1]);
#pragma unroll
            for (int dt = 0; dt < 8; ++dt) S[dt] = S[dt] * dec;
            S[0] = MFMA16(F0[0], Vb[0], S[0]); S[1] = MFMA16(F0[2], Vb[0], S[1]); S[0] = MFMA16(F0[1], Vb[1], S[0]); S[1] = MFMA16(F0[3], Vb[1], S[1]);
            SQ_LD4(F0, DN_KT_OFF, 8);
            S[2] = MFMA16(F1[0], Vb[0], S[2]); S[3] = MFMA16(F1[2], Vb[0], S[3]); S[2] = MFMA16(F1[1], Vb[1], S[2]); S[3] = MFMA16(F1[3], Vb[1], S[3]);
            SQ_LD4(F1, DN_KT_OFF, 12);
            S[4] = MFMA16(F0[0], Vb[0], S[4]); S[5] = MFMA16(F0[2], Vb[0], S[5]); S[4] = MFMA16(F0[1], Vb[1], S[4]); S[5] = MFMA16(F0[3], Vb[1], S[5]);
            S[6] = MFMA16(F1[0], Vb[0], S[6]); S[7] = MFMA16(F1[2], Vb[0], S[7]); S[6] = MFMA16(F1[1], Vb[1], S[6]); S[7] = MFMA16(F1[3], Vb[1], S[7]);
#pragma unroll
            for (int s = 0; s < 4; ++s) { Sb[s] = pack8(S[2 * s], S[2 * s + 1]); *(LAS u32x4*)(lds + SX_OFF + ((n + 1) & 1) * 16384 + ((wl * 4 + s) * 64 + lane) * 16) = __builtin_bit_cast(u32x4, Sb[s]); }
        }
    }
#undef SQ_DMA
#undef SQ_LD4
    asm volatile("s_waitcnt vmcnt(0) lgkmcnt(0)" ::: "memory"); __builtin_amdgcn_s_barrier(); asm volatile("" ::: "memory");
}

__device__ __forceinline__ void dn_out_unit(LAS unsigned char* lds, int tid, int wave, int lane, int unit, const unsigned char* stg_all, const float* ug_all, const unsigned char* sall,
                                            const bf16* proj, const float* normw, bf16* mix) {
    const int n = unit & 63, bh = unit >> 6, b = bh / DNH, h = bh % DNH, r = lane & 15, q = lane >> 4;
    LAS unsigned char* st = lds;
    LAS float* OB = (LAS float*)(lds + 40960);
    const unsigned char* stg = stg_all + (size_t)unit * DN_STAGE;
#pragma unroll
    for (int k = 0; k < 5; ++k) { const int ch = wave * 5 + k; const unsigned char* g = (ch < 16) ? (stg + DN_W_OFF + (size_t)ch * 1024) : (stg + DN_Q_OFF + (size_t)(ch - 16) * 1024);
        __builtin_amdgcn_global_load_lds((const unsigned*)(g + lane * 16), (LAS unsigned*)(st + ch * 1024), 16, 0, 0); }
    f32x4 vn[4]; u32x4 sbw[4];
#pragma unroll
    for (int ct = 0; ct < 4; ++ct) { const u32x2 ub = *(const u32x2*)(stg + DN_UB_OFF + (size_t)((wave * 4 + ct) * 64 + lane) * 8); vn[ct] = (f32x4){bflo(ub.x), bfhi(ub.x), bflo(ub.y), bfhi(ub.y)}; }
#pragma unroll
    for (int s = 0; s < 4; ++s) sbw[s] = *((const u32x4*)(sall + ((size_t)unit * 8 + wave) * 4096) + s * 64 + lane);
    const int prow = tid >> 3, pcg = tid & 7;
    const bf16* zp = proj + ((size_t)b * SEQ + n * 64 + prow) * DINP + Z0 + h * HD + 16 * pcg;
    const u32x4 z0 = *(const u32x4*)zp, z1 = *(const u32x4*)(zp + 8);
    f32x4 nwv[4];
#pragma unroll
    for (int k = 0; k < 4; ++k) nwv[k] = *(const f32x4*)(normw + 16 * pcg + 4 * k);
    asm volatile("s_waitcnt vmcnt(0)" ::: "memory"); RAW_BAR();
    bf16x8 Sb[4];
#pragma unroll
    for (int s = 0; s < 4; ++s) Sb[s] = __builtin_bit_cast(bf16x8, sbw[s]);
    f32x4 o[4];
#pragma unroll
    for (int ct = 0; ct < 4; ++ct) o[ct] = (f32x4){0.f, 0.f, 0.f, 0.f};
#pragma unroll
    for (int ct = 0; ct < 4; ++ct) { bf16x8 fw[4], fq[4];
#pragma unroll
        for (int s = 0; s < 4; ++s) { fw[s] = *(const LAS bf16x8*)(st + ((ct * 4 + s) * 64 + lane) * 16); fq[s] = *(const LAS bf16x8*)(st + 16384 + ((ct * 4 + s) * 64 + lane) * 16); }
#pragma unroll
        for (int s = 0; s < 4; ++s) { vn[ct] = MFMA16(fw[s], Sb[s], vn[ct]); o[ct] = MFMA16(fq[s], Sb[s], o[ct]); } }
    bf16x8 Vb[2];
#pragma unroll
    for (int s = 0; s < 2; ++s) Vb[s] = pack8(vn[2 * s], vn[2 * s + 1]);
    { bf16x8 fa[8];
#pragma unroll
        for (int i = 0; i < 8; ++i) fa[i] = *(const LAS bf16x8*)(st + 32768 + (i * 64 + lane) * 16);
#pragma unroll
        for (int ct = 0; ct < 4; ++ct) { o[ct] = MFMA16(fa[ct * 2], Vb[0], o[ct]); o[ct] = MFMA16(fa[ct * 2 + 1], Vb[1], o[ct]); } }
#pragma unroll
    for (int ct = 0; ct < 4; ++ct)
#pragma unroll
        for (int i = 0; i < 4; ++i) OB[(16 * ct + 4 * q + i) * 132 + 16 * wave + r] = o[ct][i];
    RAW_BAR();
    {
        f32x4 v[4]; float ss = 0.f;
#pragma unroll
        for (int k = 0; k < 4; ++k) { v[k] = *(const LAS f32x4*)(OB + prow * 132 + 16 * pcg + 4 * k); ss += (v[k].x * v[k].x + v[k].y * v[k].y) + (v[k].z * v[k].z + v[k].w * v[k].w); }
        ss += __shfl_xor(ss, 1); ss += __shfl_xor(ss, 2); ss += __shfl_xor(ss, 4);
        const float rstd = __builtin_amdgcn_rsqf(ss * (1.0f / HD) + EPS);
        float z[16]; { float t8[8]; unpack8(z0, t8);
#pragma unroll
            for (int i = 0; i < 8; ++i) z[i] = t8[i]; unpack8(z1, t8);
#pragma unroll
            for (int i = 0; i < 8; ++i) z[8 + i] = t8[i]; }
        float o16[16];
#pragma unroll
        for (int k = 0; k < 4; ++k) { o16[4 * k] = v[k].x * rstd * nwv[k].x * siluf_(z[4 * k]); o16[4 * k + 1] = v[k].y * rstd * nwv[k].y * siluf_(z[4 * k + 1]);
            o16[4 * k + 2] = v[k].z * rstd * nwv[k].z * siluf_(z[4 * k + 2]); o16[4 * k + 3] = v[k].w * rstd * nwv[k].w * siluf_(z[4 * k + 3]); }
        u32x4 p0, p1; p0.x = cvtpk(o16[0], o16[1]); p0.y = cvtpk(o16[2], o16[3]); p0.z = cvtpk(o16[4], o16[5]); p0.w = cvtpk(o16[6], o16[7]);
        p1.x = cvtpk(o16[8], o16[9]); p1.y = cvtpk(o16[10], o16[11]); p1.z = cvtpk(o16[12], o16[13]); p1.w = cvtpk(o16[14], o16[15]);
        bf16* mp = mix + ((size_t)b * SEQ + n * 64 + prow) * DM + h * HD + 16 * pcg;
        *(u32x4*)mp = p0; *(u32x4*)(mp + 8) = p1;
    }
    RAW_BAR();
}

#if defined(DIAG)
#define LR_STAMP(k) do { if (tid == 0 && unit >= (int)gridDim.x && unit < 2 * (int)gridDim.x) *(volatile LAS unsigned long long*)(lds + MISC_OFF - 256 + 8 * (k)) = __builtin_amdgcn_s_memrealtime(); } while (0)
#else
#define LR_STAMP(k) do { } while (0)
#endif
__device__ __forceinline__ void lru1_unit(LAS unsigned char* lds, int tid, int wave, int lane, int unit, const bf16* proj, const float* convw, const float* convb, const bf16* wat, const bf16* wxt,
                                          const float* ba, const float* bx, const float* lam, float* HL, float* PC, float* CAR) {
    const int rb = unit & 31, bg = unit >> 5, b = bg / LRB, g = bg % LRB, t0 = rb * 128, cb = g * HD; const size_t m0 = (size_t)b * SEQ + t0;
    LR_STAMP(22);
    LAS float* XC = (LAS float*)lds; LAS float* AA = (LAS float*)(lds + 67584); LAS float* SE = (LAS float*)(lds + 135168);
    u32x4 wstage[4];
    {
#pragma unroll
        for (int k = 0; k < 4; ++k) { const int ch = tid + 512 * k, j = (ch >> 4) & 127, c = ch & 15;
            wstage[k] = *(const u32x4*)(wat + ((size_t)(g * HD + j)) * HD + 8 * c); }
    }
    {
        const int rq = tid >> 4, cg = tid & 15, c0 = cb + 8 * cg; float w[4][8], bias[8];
#pragma unroll
        for (int j = 0; j < 4; ++j) { const f32x4 a = *(const f32x4*)(convw + j * LRW + c0), bq = *(const f32x4*)(convw + j * LRW + c0 + 4);
            w[j][0] = a.x; w[j][1] = a.y; w[j][2] = a.z; w[j][3] = a.w; w[j][4] = bq.x; w[j][5] = bq.y; w[j][6] = bq.z; w[j][7] = bq.w; }
        { const f32x4 a = *(const f32x4*)(convb + c0), bq = *(const f32x4*)(convb + c0 + 4); bias[0] = a.x; bias[1] = a.y; bias[2] = a.z; bias[3] = a.w; bias[4] = bq.x; bias[5] = bq.y; bias[6] = bq.z; bias[7] = bq.w; }
        float x[7][8];
#pragma unroll
        for (int k = 0; k < 7; ++k) { const int rr = 4 * rq - 3 + k;
            if (t0 + rr >= 0) { const u32x4 v = *(const u32x4*)(proj + (size_t)((long)m0 + rr) * DINP + LX0 + c0); unpack8(v, x[k]); }
            else {
#pragma unroll
                for (int i = 0; i < 8; ++i) x[k][i] = 0.f; } }
#pragma unroll
        for (int rr = 0; rr < 4; ++rr) { float y[8];
#pragma unroll
            for (int i = 0; i < 8; ++i) { float a = bias[i];
#pragma unroll
                for (int j = 0; j < 4; ++j) a += w[j][i] * x[rr + j][i];
                y[i] = a; }
            *(LAS f32x4*)(XC + (4 * rq + rr) * 132 + 8 * cg) = (f32x4){y[0], y[1], y[2], y[3]}; *(LAS f32x4*)(XC + (4 * rq + rr) * 132 + 8 * cg + 4) = (f32x4){y[4], y[5], y[6], y[7]}; }
    }
    { LAS unsigned char* WL = (LAS unsigned char*)AA;
#pragma unroll
        for (int k = 0; k < 4; ++k) { const int ch = tid + 512 * k, j = (ch >> 4) & 127, c = ch & 15; *(LAS u32x4*)(WL + j * 256 + ((c ^ (j & 15)) << 4)) = wstage[k]; }
#pragma unroll
        for (int k = 0; k < 4; ++k) { const int ch = tid + 512 * k, j = (ch >> 4) & 127, c = ch & 15;
            *(LAS u32x4*)(WL + 32768 + j * 256 + ((c ^ (j & 15)) << 4)) = *(const u32x4*)(wxt + ((size_t)(g * HD + j)) * HD + 8 * c); } }
    WG_SYNC(); LR_STAMP(23);
    {
        const int mt = wave & 3, nh = wave >> 2, r = lane & 31, hh = lane >> 5; const LAS unsigned char* WL = (const LAS unsigned char*)AA;
        float spv[2], bAv[2], bXv[2];
#pragma unroll
        for (int nt = 0; nt < 2; ++nt) { const int c = cb + 64 * nh + 32 * nt + r; spv[nt] = lam[c]; bAv[nt] = ba[c]; bXv[nt] = bx[c]; }
        f32x16 accA[2], accX[2];
#pragma unroll
        for (int nt = 0; nt < 2; ++nt)
#pragma unroll
            for (int i = 0; i < 16; ++i) { accA[nt][i] = 0.f; accX[nt][i] = 0.f; }
#pragma unroll
        for (int s = 0; s < 8; ++s) {
            const f32x4 a0 = *(const LAS f32x4*)(XC + (32 * mt + r) * 132 + 16 * s + 8 * hh), a1 = *(const LAS f32x4*)(XC + (32 * mt + r) * 132 + 16 * s + 8 * hh + 4);
            const bf16x8 a = pack8(a0, a1);
#pragma unroll
            for (int nt = 0; nt < 2; ++nt) { const int j = 64 * nh + 32 * nt + r; const int wo = j * 256 + (((2 * s + hh) ^ (j & 15)) << 4);
                const bf16x8 b1 = *(const LAS bf16x8*)(WL + wo), b2 = *(const LAS bf16x8*)(WL + 32768 + wo);
                accA[nt] = MFMA32(a, b1, accA[nt]); accX[nt] = MFMA32(a, b2, accX[nt]); }
        }
        WG_SYNC();
#pragma unroll
        for (int nt = 0; nt < 2; ++nt) { const int j = 64 * nh + 32 * nt + r; const float sp = softplusf_(-spv[nt]), bA = bAv[nt], bX = bXv[nt];
#pragma unroll
            for (int i = 0; i < 16; ++i) { const int t = 32 * mt + crow32(i, hh); const float xc = XC[t * 132 + j];
                const float rr = sigmoidf_(accA[nt][i] + bA), ig = sigmoidf_(accX[nt][i] + bX), la = -8.0f * rr * sp;
                const float av = __expf(la); AA[t * 132 + j] = av; XC[t * 132 + j] = sqrtf(1.0f - av * av) * (ig * xc); } }
    }
    WG_SYNC(); LR_STAMP(24);
    {
        const int j = tid & 127, sg = tid >> 7; float P = 1.f, H = 0.f;
#pragma unroll 4
        for (int tt = 0; tt < 32; ++tt) { const int o = (32 * sg + tt) * 132 + j; const float a = AA[o]; H = a * H + XC[o]; P *= a; XC[o] = H; AA[o] = P; }
        SE[(sg * 128 + j) * 2] = P; SE[(sg * 128 + j) * 2 + 1] = H;
        WG_SYNC(); LR_STAMP(25);
        float Pin = 1.f, Hin = 0.f;
        for (int s2 = 0; s2 < sg; ++s2) { const float Pe = SE[(s2 * 128 + j) * 2], He = SE[(s2 * 128 + j) * 2 + 1]; Hin = Pe * Hin + He; Pin *= Pe; }
#pragma unroll 4
        for (int tt = 0; tt < 32; ++tt) { const int t = 32 * sg + tt, o = t * 132 + j; const size_t go = (m0 + t) * LRW + cb + j; HL[go] = XC[o] + AA[o] * Hin; PC[go] = AA[o] * Pin; }
        if (sg == 3) { const float Pe = SE[(3 * 128 + j) * 2], He = SE[(3 * 128 + j) * 2 + 1]; CAR[((size_t)unit * 128 + j) * 2] = Pin * Pe; CAR[((size_t)unit * 128 + j) * 2 + 1] = Pe * Hin + He; }
    }
    WG_SYNC(); LR_STAMP(26);
}
__device__ __forceinline__ void lru3_unit(LAS unsigned char* lds, int tid, int unit, const bf16* proj, const float* HL, const float* PC, const float* CAR, const float* normw, bf16* mix) {
    const int rb = unit & 31, bg = unit >> 5, b = bg / LRB, g = bg % LRB, t0 = rb * 128, cb = g * HD; const size_t m0 = (size_t)b * SEQ + t0;
    LAS float* HIN = (LAS float*)lds;
    if (tid < 128) { typedef float f32x2_t __attribute__((ext_vector_type(2))); f32x2_t ph[32];
#pragma unroll
        for (int u2 = 0; u2 < 32; ++u2) ph[u2] = (u2 < rb) ? *(const f32x2_t*)(CAR + ((size_t)(bg * 32 + u2) * 128 + tid) * 2) : (f32x2_t){1.f, 0.f};
        float H = 0.f;
#pragma unroll
        for (int u2 = 0; u2 < 32; ++u2) H = (u2 < rb) ? ph[u2].x * H + ph[u2].y : H;
        HIN[tid] = H; }
    WG_SYNC();
    const int row = tid >> 2, part = tid & 3, c0 = cb + 32 * part; const size_t m = m0 + row;
    float y[32]; float ss = 0.f;
#pragma unroll
    for (int k = 0; k < 4; ++k) { const u32x4 gv = *(const u32x4*)(proj + m * DINP + LG0 + c0 + 8 * k); float g8[8]; unpack8(gv, g8);
#pragma unroll
        for (int hf = 0; hf < 2; ++hf) { const f32x4 hl = *(const f32x4*)(HL + m * LRW + c0 + 8 * k + 4 * hf), pc = *(const f32x4*)(PC + m * LRW + c0 + 8 * k + 4 * hf);
#pragma unroll
            for (int i = 0; i < 4; ++i) { const int ci = 8 * k + 4 * hf + i; const float hv = hl[i] + pc[i] * HIN[32 * part + ci]; const float yv = hv * geluf_(g8[4 * hf + i]); y[ci] = yv; ss += yv * yv; } } }
    ss += __shfl_xor(ss, 1); ss += __shfl_xor(ss, 2);
    const float rstd = 1.0f / sqrtf(ss * (1.0f / HD) + EPS);
#pragma unroll
    for (int k = 0; k < 4; ++k) { const f32x4 w0 = *(const f32x4*)(normw + c0 + 8 * k), w1 = *(const f32x4*)(normw + c0 + 8 * k + 4);
        u32x4 pk; pk.x = cvtpk(y[8 * k] * rstd * w0.x, y[8 * k + 1] * rstd * w0.y); pk.y = cvtpk(y[8 * k + 2] * rstd * w0.z, y[8 * k + 3] * rstd * w0.w);
        pk.z = cvtpk(y[8 * k + 4] * rstd * w1.x, y[8 * k + 5] * rstd * w1.y); pk.w = cvtpk(y[8 * k + 6] * rstd * w1.z, y[8 * k + 7] * rstd * w1.w);
        *(u32x4*)(mix + m * DM + DNW + c0 + 8 * k) = pk; }
    WG_SYNC();
}

__device__ __forceinline__ void sg_unit(LAS unsigned char* lds, int tid, int wave, int lane, int unit, const bf16* proj, const float* sgst, const float* lnw, const float* lnb, const bf16* wsb, const float* bs, const float* normw, bf16* mix) {
    const int g = unit & 7, bn = unit >> 3; const size_t m0 = (size_t)bn * 128;
    LAS bf16* VT = (LAS bf16*)lds; LAS float* YB = (LAS float*)(lds + 34816);
    {
        const int s_ = tid >> 2, part = tid & 3; const float mu = sgst[2 * (m0 + s_)], rs = sgst[2 * (m0 + s_) + 1];
#pragma unroll
        for (int k = 0; k < 4; ++k) { const u32x4 v = *(const u32x4*)(proj + (m0 + s_) * DINP + SV0 + g * HD + 32 * part + 8 * k); float f[8]; unpack8(v, f);
            const f32x4 w0 = *(const f32x4*)(lnw + g * HD + 32 * part + 8 * k), w1 = *(const f32x4*)(lnw + g * HD + 32 * part + 8 * k + 4), b0 = *(const f32x4*)(lnb + g * HD + 32 * part + 8 * k), b1 = *(const f32x4*)(lnb + g * HD + 32 * part + 8 * k + 4);
            const float ww[8] = {w0.x, w0.y, w0.z, w0.w, w1.x, w1.y, w1.z, w1.w}, bb[8] = {b0.x, b0.y, b0.z, b0.w, b1.x, b1.y, b1.z, b1.w};
#pragma unroll
            for (int i = 0; i < 8; ++i) VT[(32 * part + 8 * k + i) * 136 + s_] = (bf16)f2bf((geluf_(f[i]) - mu) * rs * ww[i] + bb[i]); }
#pragma unroll
        for (int k = 0; k < 4; ++k) { const u32x4 v = *(const u32x4*)(proj + (m0 + s_) * DINP + SU0 + g * HD + 32 * part + 8 * k); float f[8]; unpack8(v, f);
            *(LAS f32x4*)(YB + s_ * 132 + 32 * part + 8 * k) = (f32x4){geluf_(f[0]), geluf_(f[1]), geluf_(f[2]), geluf_(f[3])};
            *(LAS f32x4*)(YB + s_ * 132 + 32 * part + 8 * k + 4) = (f32x4){geluf_(f[4]), geluf_(f[5]), geluf_(f[6]), geluf_(f[7])}; }
    }
    bf16x8 afr[8];
    { const int mt = wave & 3, r = lane & 31, hh = lane >> 5;
#pragma unroll
        for (int s = 0; s < 8; ++s) afr[s] = *(const bf16x8*)(wsb + ((size_t)(g * 128 + 32 * mt + r)) * 128 + 16 * s + 8 * hh); }
    WG_SYNC();
    {
        const int mt = wave & 3, nh = wave >> 2, r = lane & 31, hh = lane >> 5;
        f32x16 acc[2]; float bsv[16];
#pragma unroll
        for (int i = 0; i < 16; ++i) bsv[i] = bs[g * 128 + 32 * mt + crow32(i, hh)];
#pragma unroll
        for (int nt = 0; nt < 2; ++nt)
#pragma unroll
            for (int i = 0; i < 16; ++i) acc[nt][i] = 0.f;
#pragma unroll
        for (int s = 0; s < 8; ++s) { if (s < 2 * mt + 2) {
#pragma unroll
            for (int nt = 0; nt < 2; ++nt) { const bf16x8 bb = *(const LAS bf16x8*)(VT + (64 * nh + 32 * nt + r) * 136 + 16 * s + 8 * hh); acc[nt] = MFMA32(afr[s], bb, acc[nt]); } } }
#pragma unroll
        for (int nt = 0; nt < 2; ++nt) { const int c = 64 * nh + 32 * nt + r;
#pragma unroll
            for (int i = 0; i < 16; ++i) { const int t = 32 * mt + crow32(i, hh); const float z = acc[nt][i] + bsv[i];
                YB[t * 132 + c] *= z; } }
    }
    WG_SYNC();
    {
        const int t = tid >> 2, part = tid & 3; f32x4 v[8]; float ss = 0.f;
#pragma unroll
        for (int k = 0; k < 8; ++k) { v[k] = *(const LAS f32x4*)(YB + t * 132 + 32 * part + 4 * k); ss += (v[k].x * v[k].x + v[k].y * v[k].y) + (v[k].z * v[k].z + v[k].w * v[k].w); }
        ss += __shfl_xor(ss, 1); ss += __shfl_xor(ss, 2);
        const float rstd = 1.0f / sqrtf(ss * (1.0f / HD) + EPS);
#pragma unroll
        for (int k = 0; k < 4; ++k) { const f32x4 w0 = *(const f32x4*)(normw + g * HD + 32 * part + 8 * k), w1 = *(const f32x4*)(normw + g * HD + 32 * part + 8 * k + 4);
            u32x4 pk; pk.x = cvtpk(v[2 * k].x * rstd * w0.x, v[2 * k].y * rstd * w0.y); pk.y = cvtpk(v[2 * k].z * rstd * w0.z, v[2 * k].w * rstd * w0.w);
            pk.z = cvtpk(v[2 * k + 1].x * rstd * w1.x, v[2 * k + 1].y * rstd * w1.y); pk.w = cvtpk(v[2 * k + 1].z * rstd * w1.z, v[2 * k + 1].w * rstd * w1.w);
            *(u32x4*)(mix + (m0 + t) * DM + DNW + LRW + g * HD + 32 * part + 8 * k) = pk; }
    }
    WG_SYNC();
}
#ifndef USE_DN
#define USE_DN 1
#endif
#ifndef USE_LRU
#define USE_LRU 1
#endif
#ifndef USE_SG
#define USE_SG 1
#endif
#define LAUNDER() int tid = tid0, bx = bx0, G = G0; GASP unsigned char* wsg_ = (GASP unsigned char*)ws0; KIN kin_ = (KIN)__builtin_amdgcn_kernarg_segment_ptr(); asm volatile("" : "+v"(tid), "+s"(bx), "+s"(G), "+s"(wsg_), "+s"(kin_)); const InTab in_{kin_}; unsigned char* ws = (unsigned char*)wsg_;     const int lane = tid & 63, wave = __builtin_amdgcn_readfirstlane(tid >> 6), gw = bx * NWAVES + wave, ngw = G * NWAVES, gtid = bx * NTHR + tid, ngt = G * NTHR; (void)lane; (void)wave; (void)gw; (void)ngw; (void)gtid; (void)ngt
#ifndef DUP_MASK
#define DUP_MASK 0
#endif
#ifndef DUP_SUB
#define DUP_SUB 0
#endif
#define SREP(b) (((DUP_SUB) & (b)) && l == 0 ? 2 : 1)
#define NREP(j) ((((DUP_MASK) >> (j)) & 1) && l == 0 ? 2 : 1)
#ifndef GEMM_ALIGN
#define GEMM_ALIGN true
#endif
#ifndef GEMM_SP2
#define GEMM_SP2 true
#endif
constexpr int N_PHASES = 1 + 9 * DEPTH;
#define GASP __attribute__((address_space(1)))
typedef const float GASP* const __attribute__((address_space(4)))* KIN;
struct InTab { KIN t; __device__ __forceinline__ const float* operator[](int k) const { return (const float*)t[k]; } };
struct Args { const float* in[27]; float* out; unsigned char* ws; int ph_lo, ph_hi, li, pad; };
__global__ void __launch_bounds__(NTHR, 2) mega(Args a) {
    extern __shared__ __attribute__((aligned(16))) unsigned char lds_raw[];
    LAS unsigned char* lds = (LAS unsigned char*)lds_raw;
    const int tid0 = threadIdx.x, G0 = gridDim.x, bx0 = blockIdx.x;
    volatile LAS unsigned* MISC = (volatile LAS unsigned*)(lds + MISC_OFF);
    if (tid0 < 64) MISC[tid0] = 0u;
    __syncthreads();
    unsigned char* const ws0 = a.ws;
    XcdBarrier bar = xcd_barrier_post((unsigned*)(ws0 + WS_CTL) + CW_BAR + a.li * XCD_BAR_WORDS, MISC + 8);
    const int lo = a.ph_lo, hi = a.ph_hi;
#define IN(k) (lo <= (k) && (k) < hi)
#ifndef DIAG_LAYER
#define DIAG_LAYER 0
#endif
#if defined(DIAG)
#ifndef DIAG_OFF
#define DIAG_OFF 0.0f
#endif

#define STAMP(k) do { if (tid0 == 0) *(volatile LAS unsigned long long*)(lds + MISC_OFF - 256 + 8 * (k)) = __builtin_amdgcn_s_memrealtime(); } while (0)
#else
#define STAMP(k) do { } while (0)
#endif
#define SEAM(k) do { if (IN(k) && IN((k) + 1)) xcd_barrier(bar); } while (0)
#define hb ((bf16*)(ws + WS_HB))
#define proj ((bf16*)(ws + WS_PROJ))
#define mix ((bf16*)(ws + WS_MIX))
#define xa ((float*)(ws + WS_XA))
#define xb ((float*)(ws + WS_XB))
#define hid ((bf16*)(ws + WS_HID))
#define act ((bf16*)(ws + WS_ACT))
#define stg (ws + WS_STG)
#define ug ((float*)(ws + WS_UG))
#define decg ((float*)(ws + WS_DEC))
#define HL ((float*)(ws + WS_HL))
#define PC ((float*)(ws + WS_PC))
#define CAR ((float*)(ws + WS_CAR))

    STAMP(0);
    if (IN(0)) for (int rep = 0; rep < (((DUP_MASK) & 1) ? 2 : 1); ++rep) { LAUNDER(); phase_prologue(lds, in_, ws, gw, ngw, gtid, ngt, wave, lane); }
    STAMP(1); SEAM(0); STAMP(2);
    for (int l = 0; l < DEPTH; ++l) {
        const int pb = 1 + 9 * l;
        const bf16* win = (const bf16*)(ws0 + WS_W + l * SZ_WL); const bf16* wout = (const bf16*)((const unsigned char*)win + SZ_WIN);
        const bf16* wup = (const bf16*)((const unsigned char*)wout + SZ_WOUT); const bf16* wdn = (const bf16*)((const unsigned char*)wup + SZ_WUP);
        if (IN(pb + 0)) for (int rep = 0; rep < NREP(1); ++rep) { LAUNDER(); pg8::Gemm g{hb, win, M, DINP, DM}; pg8::StaticOrder S; S.init(M, DINP, G, bx); EpiBf16Rs E{proj, DINP, (const ssq_t*)(ws + WS_SS) + (size_t)(2 * l) * M};
            pg8::gemm_phase<EpiBf16Rs, pg8::StaticOrder, GEMM_ALIGN, GEMM_SP2>(lds, g, S, E);
            { const int idle_from = ((M / 256) * (DINP / 256)) % G; if (TF_UP > 0 && idle_from > 0 && bx >= idle_from) convert_deferred(lds, in_, ws, l, 0, bx, G, idle_from, wave, lane); } }
        if (l == DIAG_LAYER) STAMP(3); SEAM(pb + 0); if (l == DIAG_LAYER) STAMP(4);
        if (IN(pb + 1)) for (int rep = 0; rep < NREP(2); ++rep) { LAUNDER();
#if USE_DN
            static_assert(DN_UNITS <= 8 * 192, "dn_gates_all covers 8 units per workgroup");
            dn_gates_all(lds, wave, lane, bx, G, proj, in_[4] + l * DNH, in_[5] + l * DNH, decg);
            for (int u = bx, k = 0; u < DN_UNITS; u += G, ++k) dn_prep_unit(lds, tid, wave, lane, u, u + G, k, proj, in_[3] + (size_t)l * 4 * 3 * DNW, in_[4] + l * DNH, in_[5] + l * DNH, stg, ug, decg);
#endif
            if (l == DIAG_LAYER) STAMP(5);
#if USE_SG
            phase_sg_stats(proj, (float*)(ws + WS_SGST), gw, ngw, lane);
#endif
            if (l == DIAG_LAYER) STAMP(6);
#if USE_LRU
            for (int r2 = 0; r2 < SREP(2); ++r2) for (int u = bx; u < BATCH * LRB * 32; u += G) lru1_unit(lds, tid, wave, lane, u, proj, in_[7] + (size_t)l * 4 * LRW, in_[8] + l * LRW, (const bf16*)(ws + WS_WAT) + (size_t)l * LRB * HD * HD,
                                                                   (const bf16*)(ws + WS_WXT) + (size_t)l * LRB * HD * HD, in_[10] + l * LRW, in_[12] + l * LRW, in_[13] + l * LRW, HL, PC, CAR);
#endif
        }
        if (l == DIAG_LAYER) STAMP(7); SEAM(pb + 1); if (l == DIAG_LAYER) STAMP(8);
        if (IN(pb + 2)) for (int rep = 0; rep < NREP(3); ++rep) { LAUNDER();
            constexpr int NSEQ = 2 * BATCH * DNH;
            if (bx < NSEQ && G > NSEQ) {
#if USE_DN
                dn_seq_bh(lds, tid, wave, lane, bx % (BATCH * DNH), bx / (BATCH * DNH), stg, decg, ws + WS_SALL);
#endif
            } else {
                const int wb = bx - NSEQ, nwb = G - NSEQ; constexpr int NSG = BATCH * 32 * SGG, NL3 = BATCH * LRB * 32;
                for (int i = wb; i < NSG + NL3; i += nwb) {
                    if (i < NSG) sg_unit(lds, tid, wave, lane, i, proj, (const float*)(ws + WS_SGST), in_[15] + l * SGW, in_[16] + l * SGW, (const bf16*)(ws + WS_WSB) + (size_t)l * SGG * 128 * 128, in_[18] + l * SGG * 128, in_[19] + l * SGW, mix);
                    else lru3_unit(lds, tid, i - NSG, proj, HL, PC, CAR, in_[14] + l * LRW, mix);
                }
                __syncthreads(); if (TF_IN1 > 0 && TF_DN2 > 0) convert_deferred(lds, in_, ws, 1, l == 0 ? 2 : 3, bx, G, NSEQ, wave, lane);
                if (l == DIAG_LAYER) STAMP(9);
            }
        }
        if (l == DIAG_LAYER) STAMP(10); SEAM(pb + 2); if (l == DIAG_LAYER) STAMP(11);
        if (IN(pb + 3)) { LAUNDER();
#if USE_DN
            for (int u = bx; u < DN_UNITS; u += G) dn_out_unit(lds, tid, wave, lane, u, stg, ug, ws + WS_SALL, proj, in_[6] + l * HD, mix);
#endif
        }
        if (l == DIAG_LAYER) STAMP(20); SEAM(pb + 3); if (l == DIAG_LAYER) STAMP(21);
        if (IN(pb + 4)) for (int rep = 0; rep < NREP(4); ++rep) { LAUNDER(); pg8::Gemm g{mix, wout, M, DM, DM}; pg8::StaticOrder S; S.init(M, DM, G, bx); EpiResB16 E{hb, (ssq_t*)(ws + WS_SS) + (size_t)(2 * l + 1) * M, DM};
            pg8::gemm_phase<EpiResB16, pg8::StaticOrder, GEMM_ALIGN, GEMM_SP2>(lds, g, S, E); }
        if (l == DIAG_LAYER) STAMP(12); SEAM(pb + 4); if (l == DIAG_LAYER) STAMP(13);
        if (IN(pb + 5)) for (int rep = 0; rep < NREP(6); ++rep) { LAUNDER(); pg8::Gemm g{hb, wup, M, 2 * DFF, DM}; pg8::StaticOrder S; S.init(M, 2 * DFF, G, bx); EpiFfnAct E{act, hid, (const ssq_t*)(ws + WS_SS) + (size_t)(2 * l + 1) * M, in_[23] + (size_t)l * 3 * 2 * DFF, in_[24] + (size_t)l * 2 * DFF, lds};
            pg8::gemm_phase<EpiFfnAct, pg8::StaticOrder, GEMM_ALIGN, GEMM_SP2>(lds, g, S, E);
            { const int idle_from = ((M / 256) * (2 * DFF / 256)) % G; if (TF_DN > 0 && idle_from > 0 && bx >= idle_from) convert_deferred(lds, in_, ws, l, 1, bx, G, idle_from, wave, lane); } }
        if (l == DIAG_LAYER) STAMP(14); SEAM(pb + 5); if (l == DIAG_LAYER) STAMP(15);
        if (IN(pb + 6)) for (int rep = 0; rep < NREP(7); ++rep) { LAUNDER(); phase_ffn_fix(hid, in_[23] + (size_t)l * 3 * 2 * DFF, in_[24] + (size_t)l * 2 * DFF, act, gtid, ngt); }
        if (l == DIAG_LAYER) STAMP(16); SEAM(pb + 6); if (l == DIAG_LAYER) STAMP(17);
        if (IN(pb + 7)) for (int rep = 0; rep < NREP(8); ++rep) { LAUNDER(); pg8::Gemm g{act, wdn, M, DM, DFF}; pg8::StaticOrder S; S.init(M, DM, G, bx); EpiResB16 E{hb, (ssq_t*)(ws + WS_SS) + (size_t)(2 * l + 2) * M, DM};
            pg8::gemm_phase<EpiResB16, pg8::StaticOrder, GEMM_ALIGN, GEMM_SP2>(lds, g, S, E); }
        if (l == DIAG_LAYER) STAMP(18); SEAM(pb + 7); if (l == DIAG_LAYER) STAMP(19);
        if (IN(pb + 8) && l + 1 == DEPTH) { LAUNDER(); final_norm_rows(hb, (const ssq_t*)(ws + WS_SS) + (size_t)(2 * l + 2) * M, in_[26], (float*)in_[27], gw, ngw, lane); }
        if (l + 1 == DEPTH) SEAM(pb + 8);
    }
#if defined(DIAG)
    {
        STAMP(30);
        __syncthreads(); if (tid0 < 32) ((unsigned long long*)(ws0 + WS_TS))[(size_t)bx0 * 64 + tid0] = *(volatile LAS unsigned long long*)(lds + MISC_OFF - 256 + 8 * tid0);
        xcd_barrier(bar);
        if (bx0 == 0) { volatile LAS float* red = (volatile LAS float*)lds; const unsigned long long* ts = (const unsigned long long*)(ws0 + WS_TS); float* outp = (float*)a.out;
            float va = 0.f, vb = 0.f;
            if (tid0 < 256) { const int w = tid0; const unsigned long long* t = ts + (size_t)w * 64;
                if (w >= DIAG_LOA && w < DIAG_HIA) va = (float)(long long)(t[DIAG_K2A] - t[DIAG_K1A]) * 0.01f;
                if (w >= DIAG_LOB && w < DIAG_HIB) vb = (float)(long long)(t[DIAG_K2B] - t[DIAG_K1B]) * 0.01f; }
#if defined(DIAG_MIN)
            if (!(tid0 < 256 && tid0 >= DIAG_LOA && tid0 < DIAG_HIA)) va = 1e30f;
            for (int o = 32; o >= 1; o >>= 1) { va = fminf(va, __shfl_xor(va, o)); vb = fmaxf(vb, __shfl_xor(vb, o)); }
#else
            for (int o = 32; o >= 1; o >>= 1) { va = fmaxf(va, __shfl_xor(va, o)); vb = fmaxf(vb, __shfl_xor(vb, o)); }
#endif
            if ((tid0 & 63) == 0) { red[tid0 >> 6] = va; red[8 + (tid0 >> 6)] = vb; }
            __syncthreads();
#if defined(DIAG_MIN)
            va = fminf(fminf(red[0], red[1]), fminf(red[2], red[3]));
#else
            va = fmaxf(fmaxf(red[0], red[1]), fmaxf(red[2], red[3]));
#endif
            vb = fmaxf(fmaxf(red[8], red[9]), fmaxf(red[10], red[11]));
            asm volatile("s_waitcnt vmcnt(0)" ::: "memory");
#if defined(DIAG_ABS)
            (void)vb; if (tid0 == 0) outp[0] = (va - DIAG_OFF) * DIAG_SCALE;
#else
            (void)vb; if (tid0 == 0) outp[0] += (va - DIAG_OFF) * DIAG_SCALE;
#endif
            }
    }
#endif
#undef IN
#undef SEAM
#undef hb
#undef proj
#undef mix
#undef xa
#undef xb
#undef hid
#undef act
#undef stg
#undef ug
#undef decg
#undef HL
#undef PC
#undef CAR
}

extern "C" void kernel_launch(void* const* d_in, const int* in_sizes, int n_in, void* d_out, int out_size, void* d_ws, size_t ws_size, hipStream_t stream) {
    if (n_in != 27 || out_size != M * DM || ws_size < WS_END) { fprintf(stderr, "kernel_launch: unexpected shapes (n_in %d out %d ws %zu need %zu)\n", n_in, out_size, ws_size, (size_t)WS_END); return; }
    static int grid = 0;
    if (grid == 0) {
        int dev = 0, cus = 0, per_cu = 0;
        if (hipGetDevice(&dev) != hipSuccess || hipDeviceGetAttribute(&cus, hipDeviceAttributeMultiprocessorCount, dev) != hipSuccess) { fprintf(stderr, "kernel_launch: device query failed\n"); grid = -1; return; }
        if (hipFuncSetAttribute((const void*)mega, hipFuncAttributeMaxDynamicSharedMemorySize, LDS_BYTES) != hipSuccess) { fprintf(stderr, "kernel_launch: hipFuncSetAttribute(%d B LDS) failed\n", LDS_BYTES); grid = -1; return; }
        if (hipOccupancyMaxActiveBlocksPerMultiprocessor(&per_cu, (const void*)mega, NTHR, LDS_BYTES) != hipSuccess || per_cu < 1) { fprintf(stderr, "kernel_launch: occupancy query says %d blocks/CU\n", per_cu); }
        (void)hipGetLastError();
        grid = cus;
    }
    if (grid < 0) return;
    const float* const* in = (const float* const*)d_in; unsigned char* ws = (unsigned char*)d_ws;
    (void)hipMemsetAsync(ws + WS_CTL, 0, CTL_BYTES, stream);
    Args a{}; for (int i = 0; i < 27; ++i) a.in[i] = in[i]; a.out = (float*)d_out; a.ws = ws; a.pad = 0;
    int li = 0;
    auto launch = [&](int lo, int hi) { a.ph_lo = lo; a.ph_hi = hi; a.li = li++; hipLaunchKernelGGL(mega, dim3(grid), dim3(NTHR), LDS_BYTES, stream, a); };
#if USE_DN && USE_LRU && USE_SG
    launch(0, N_PHASES);
#else
    bf16* proj = (bf16*)(ws + WS_PROJ); bf16* mix = (bf16*)(ws + WS_MIX);
    float *qf = (float*)(ws + WS_QF), *kf = (float*)(ws + WS_KF), *vf = (float*)(ws + WS_VF), *of = (float*)(ws + WS_OF), *la = (float*)(ws + WS_LA), *lif = (float*)(ws + WS_LI), *sv = (float*)(ws + WS_SV), *sy = (float*)(ws + WS_SY);
    float* beta = (float*)(ws + WS_BG); float* gg = beta + M * DNH;
    int cur = 0;
    for (int l = 0; l < DEPTH; ++l) {
        const int pb = 1 + 9 * l;
        launch(cur, pb + 1); cur = pb + 1;
#if !USE_DN
        hipLaunchKernelGGL(k_dn_prep, dim3(M * DNH), dim3(128), 0, stream, (const bf16*)proj, in[3] + (size_t)l * 4 * 3 * DNW, in[4] + l * DNH, in[5] + l * DNH, qf, kf, vf, beta, gg);
        hipLaunchKernelGGL(k_dn_scan, dim3(BATCH * DNH), dim3(128), 0, stream, (const float*)qf, (const float*)kf, (const float*)vf, (const float*)beta, (const float*)gg, of);
        hipLaunchKernelGGL(k_groupnorm, dim3(M * DNH / 4), dim3(256), 0, stream, (const float*)of, DNW, in[6] + l * HD, (const bf16*)proj, mix, 0, 0);
#endif
#if !USE_LRU
        hipLaunchKernelGGL(k_lru_gates, dim3(M * LRB), dim3(128), 0, stream, (const bf16*)proj, in[7] + (size_t)l * 4 * LRW, in[8] + l * LRW, in[9] + (size_t)l * LRB * HD * HD, in[10] + l * LRW, in[11] + (size_t)l * LRB * HD * HD, in[12] + l * LRW, in[13] + l * LRW, la, lif);
        hipLaunchKernelGGL(k_lru_scan, dim3(BATCH * LRW / 64), dim3(64), 0, stream, (const float*)la, lif, (const bf16*)proj);
        hipLaunchKernelGGL(k_groupnorm, dim3(M * LRB / 4), dim3(256), 0, stream, (const float*)lif, LRW, in[14] + l * LRW, (const bf16*)proj, mix, DNW, 1);
#endif
#if !USE_SG
        hipLaunchKernelGGL(k_sg_ln, dim3(M), dim3(256), 0, stream, (const bf16*)proj, in[15] + l * SGW, in[16] + l * SGW, sv);
        hipLaunchKernelGGL(k_sg_mix, dim3(BATCH * (SEQ / 128) * SGG), dim3(128), 0, stream, (const float*)sv, in[17] + (size_t)l * SGG * 128 * 128, in[18] + l * SGG * 128, (const bf16*)proj, sy);
        hipLaunchKernelGGL(k_groupnorm, dim3(M * SGG / 4), dim3(256), 0, stream, (const float*)sy, SGW, in[19] + l * SGW, (const bf16*)proj, mix, DNW + LRW, 1);
#endif
    }
    launch(cur, N_PHASES);
#endif
}
```
